# Optimizing an MI355X kernel written in HIP

```python
import math
import jax, jax.numpy as jnp
from jax import lax
import numpy as np

D_MODEL = 1024
BATCH = 8
SEQ = 2048
DEPTH = 2

HEAD_DIM = 64
DSA_HEADS = 4
DSA_TOPK = 256
IDX_HEADS = 8
IDX_DIM = 32
FOX_HEADS = 6
NSA_HEADS = 6
NSA_KV_GROUPS = 2
NSA_HPG = NSA_HEADS // NSA_KV_GROUPS
NSA_CMP_LEN = 32
NSA_CMP_STRIDE = 16
NSA_SEL_BLOCK = 64
NSA_SEL_N = 16
NSA_WINDOW = 512
NSA_Q_BLOCK = 64

Q_BLOCK = 128
ROPE_THETA = 10000.0
LN_EPS = 1e-5
ALPHA = (2.0 * DEPTH) ** 0.25
BETA = (8.0 * DEPTH) ** -0.25

DSA_W = DSA_HEADS * HEAD_DIM
FOX_W = FOX_HEADS * HEAD_DIM
NSA_W = NSA_HEADS * HEAD_DIM
NSA_KV_W = NSA_KV_GROUPS * HEAD_DIM
MIX_W = DSA_W + FOX_W + NSA_W

IN_SPLITS = (
    ("dsa_q", DSA_W), ("dsa_k", HEAD_DIM), ("dsa_v", HEAD_DIM),
    ("idx_q", IDX_HEADS * IDX_DIM), ("idx_k", IDX_DIM), ("idx_w", IDX_HEADS),
    ("fox_q", FOX_W), ("fox_k", FOX_W), ("fox_v", FOX_W), ("fox_f", FOX_HEADS),
    ("nsa_q", NSA_W),
    ("nsa_kc", NSA_KV_W), ("nsa_vc", NSA_KV_W),
    ("nsa_ks", NSA_KV_W), ("nsa_vs", NSA_KV_W),
    ("nsa_kw", NSA_KV_W), ("nsa_vw", NSA_KV_W),
    ("nsa_g", 3 * NSA_HEADS),
    ("gate", MIX_W),
)
IN_WIDTH = sum(w for _, w in IN_SPLITS)

kernel_name = "hybrid_dsa_fox_nsa_parallel_heads"


def split_cols(h):
    out, off = {}, 0
    for name, w in IN_SPLITS:
        out[name] = h[..., off:off + w]
        off += w
    return out


def layer_norm(x, g, b):
    xf = x.astype(jnp.float32)
    mu = jnp.mean(xf, -1, keepdims=True)
    var = jnp.mean(jnp.square(xf - mu), -1, keepdims=True)
    return ((xf - mu) * lax.rsqrt(var + LN_EPS) * g + b).astype(x.dtype)


def rope(x, pos):
    half = x.shape[-1] // 2
    inv = ROPE_THETA ** (-jnp.arange(half, dtype=jnp.float32) / half)
    ang = pos.astype(jnp.float32)[:, None] * inv[None, :]
    cos = jnp.cos(ang)[:, None, :]
    sin = jnp.sin(ang)[:, None, :]
    x1, x2 = x[..., :half], x[..., half:]
    return jnp.concatenate([x1 * cos - x2 * sin, x1 * sin + x2 * cos], -1).astype(x.dtype)


def masked_softmax(s, mask):
    s = jnp.where(mask, s.astype(jnp.float32), -jnp.inf)
    m = jnp.max(s, -1, keepdims=True)
    m = jnp.where(jnp.isfinite(m), m, 0.0)
    e = jnp.where(mask, jnp.exp(s - m), 0.0)
    return e / jnp.maximum(jnp.sum(e, -1, keepdims=True), 1e-30)


def stack_blocks(out):
    nb, B, T, H, D = out.shape
    return out.transpose(1, 0, 2, 3, 4).reshape(B, nb * T, H, D)


def dsa_mixer(q, k, v, iq, ik, iw):
    B, S, H, D = q.shape
    topk = min(DSA_TOPK, S // 4)
    kpos = jnp.arange(S)
    scale = D ** -0.5
    gather = jax.vmap(lambda kb, ib: kb[ib])

    def block(i):
        t0 = i * Q_BLOCK
        tpos = t0 + jnp.arange(Q_BLOCK)
        qb = lax.dynamic_slice_in_dim(q, t0, Q_BLOCK, 1)
        iqb = lax.dynamic_slice_in_dim(iq, t0, Q_BLOCK, 1)
        iwb = lax.dynamic_slice_in_dim(iw, t0, Q_BLOCK, 1).astype(jnp.float32)
        isc = jnp.einsum("bthd,bsd->bths", iqb, ik).astype(jnp.float32)
        isc = jnp.einsum("bth,bths->bts", iwb, jax.nn.relu(isc))
        causal = kpos[None, :] <= tpos[:, None]
        isc = jnp.where(causal[None], isc, -jnp.inf)
        _, idx = lax.top_k(isc, topk)
        kg = gather(k, idx)
        vg = gather(v, idx)
        valid = idx <= tpos[None, :, None]
        s = jnp.einsum("bthd,btkd->bthk", qb, kg) * scale
        p = masked_softmax(s, valid[:, :, None, :])
        return jnp.einsum("bthk,btkd->bthd", p.astype(v.dtype), vg)

    return stack_blocks(lax.map(block, jnp.arange(S // Q_BLOCK)))


def fox_mixer(q, k, v, logf):
    B, S, H, D = q.shape
    cum = jnp.cumsum(logf.astype(jnp.float32), axis=1).transpose(0, 2, 1)
    kpos = jnp.arange(S)
    scale = D ** -0.5

    def block(i):
        t0 = i * Q_BLOCK
        tpos = t0 + jnp.arange(Q_BLOCK)
        qb = lax.dynamic_slice_in_dim(q, t0, Q_BLOCK, 1)
        cb = lax.dynamic_slice_in_dim(cum, t0, Q_BLOCK, 2)
        s = jnp.einsum("bthd,bshd->bhts", qb, k).astype(jnp.float32) * scale
        s = s + cb[:, :, :, None] - cum[:, :, None, :]
        causal = kpos[None, :] <= tpos[:, None]
        p = masked_softmax(s, causal)
        return jnp.einsum("bhts,bshd->bthd", p.astype(v.dtype), v)

    return stack_blocks(lax.map(block, jnp.arange(S // Q_BLOCK)))


def nsa_compress(kv, pe, w1, w2):
    B, S, G, D = kv.shape
    n_c = (S - NSA_CMP_LEN) // NSA_CMP_STRIDE + 1
    idx = jnp.arange(n_c)[:, None] * NSA_CMP_STRIDE + jnp.arange(NSA_CMP_LEN)[None, :]
    blocks = kv[:, idx] + pe[None, None, :, None, :]
    blocks = blocks.transpose(0, 1, 3, 2, 4).reshape(B, n_c, G, NSA_CMP_LEN * D)
    return jax.nn.silu(blocks @ w1) @ w2


def nsa_mixer(q, q_rot, kc, vc, ks, vs, kw, vw, gates):
    B, S, G, J, D = q.shape
    n_c = kc.shape[1]
    nsb = S // NSA_SEL_BLOCK
    n_sel = min(NSA_SEL_N, nsb)
    scale = D ** -0.5
    cstart = jnp.arange(n_c) * NSA_CMP_STRIDE
    cend = cstart + NSA_CMP_LEN - 1
    bstart = jnp.arange(nsb) * NSA_SEL_BLOCK
    overlap = ((cstart[:, None] < bstart[None, :] + NSA_SEL_BLOCK)
               & (cstart[:, None] + NSA_CMP_LEN > bstart[None, :])).astype(jnp.float32)
    ks_t = ks.transpose(0, 2, 1, 3)
    vs_t = vs.transpose(0, 2, 1, 3)
    pad = ((0, 0), (NSA_WINDOW, 0), (0, 0), (0, 0))
    kw_pad = jnp.pad(kw, pad)
    vw_pad = jnp.pad(vw, pad)
    gather = jax.vmap(jax.vmap(lambda kk, ii: kk[ii]))
    jb = jnp.arange(nsb)
    tok_off = jnp.arange(NSA_SEL_BLOCK)

    def block(i):
        T = NSA_Q_BLOCK
        t0 = i * T
        tpos = t0 + jnp.arange(T)
        qb = lax.dynamic_slice_in_dim(q, t0, T, 1)
        qrb = lax.dynamic_slice_in_dim(q_rot, t0, T, 1)
        gb = lax.dynamic_slice_in_dim(gates, t0, T, 1)
        s = jnp.einsum("btgjd,bcgd->bgjtc", qb, kc) * scale
        p_cmp = masked_softmax(s, cend[None, :] <= tpos[:, None])
        o_cmp = jnp.einsum("bgjtc,bcgd->btgjd", p_cmp.astype(vc.dtype), vc)
        score = jnp.einsum("bgjtc,cn->bgtn", p_cmp, overlap)
        cur = tpos // NSA_SEL_BLOCK
        forced = (jb[None, :] == 0) | (jb[None, :] == cur[:, None]) | (jb[None, :] == cur[:, None] - 1)
        future = bstart[None, :] > tpos[:, None]
        score = jnp.where(forced, jnp.inf, jnp.where(future, -jnp.inf, score))
        _, blk = lax.top_k(score, n_sel)
        tok = (blk[..., None] * NSA_SEL_BLOCK + tok_off).reshape(B, G, T, n_sel * NSA_SEL_BLOCK)
        kg = gather(ks_t, tok)
        vg = gather(vs_t, tok)
        s = jnp.einsum("btgjd,bgtnd->bgjtn", qrb, kg) * scale
        p = masked_softmax(s, (tok <= tpos[None, None, :, None])[:, :, None])
        o_slc = jnp.einsum("bgjtn,bgtnd->btgjd", p.astype(vs.dtype), vg)
        kwb = lax.dynamic_slice_in_dim(kw_pad, t0, NSA_WINDOW + T, 1)
        vwb = lax.dynamic_slice_in_dim(vw_pad, t0, NSA_WINDOW + T, 1)
        kpos = t0 - NSA_WINDOW + jnp.arange(NSA_WINDOW + T)
        wmask = ((kpos[None, :] <= tpos[:, None]) & (kpos[None, :] > tpos[:, None] - NSA_WINDOW)
                 & (kpos[None, :] >= 0))
        s = jnp.einsum("btgjd,bkgd->bgjtk", qrb, kwb) * scale
        p = masked_softmax(s, wmask)
        o_win = jnp.einsum("bgjtk,bkgd->btgjd", p.astype(vw.dtype), vwb)
        o = (gb[:, :, 0, :, :, None] * o_cmp + gb[:, :, 1, :, :, None] * o_slc
             + gb[:, :, 2, :, :, None] * o_win)
        return o.reshape(B, T, G * J, D)

    return stack_blocks(lax.map(block, jnp.arange(S // NSA_Q_BLOCK)))


def hybrid_layer(x, c, w_ada, b_ada, w_in, b_f, cmp_pe, cmp_w1, cmp_w2, w_out, ln_g, ln_b):
    B, S, _ = x.shape
    pos = jnp.arange(S)
    shift, scale, gate = jnp.split(c @ w_ada + b_ada, 3, axis=-1)
    u = x * (1.0 + scale[:, None, :]) + shift[:, None, :]
    h = split_cols(u @ w_in)

    dq = rope(h["dsa_q"].reshape(B, S, DSA_HEADS, HEAD_DIM), pos)
    dk = rope(h["dsa_k"][:, :, None, :], pos)[:, :, 0]
    iq = rope(h["idx_q"].reshape(B, S, IDX_HEADS, IDX_DIM), pos)
    ik = rope(h["idx_k"][:, :, None, :], pos)[:, :, 0]
    iw = h["idx_w"] * (IDX_HEADS ** -0.5)
    o_dsa = dsa_mixer(dq, dk, h["dsa_v"], iq, ik, iw)

    fq = h["fox_q"].reshape(B, S, FOX_HEADS, HEAD_DIM)
    fk = h["fox_k"].reshape(B, S, FOX_HEADS, HEAD_DIM)
    fv = h["fox_v"].reshape(B, S, FOX_HEADS, HEAD_DIM)
    logf = jax.nn.log_sigmoid(h["fox_f"].astype(jnp.float32) + b_f)
    o_fox = fox_mixer(fq, fk, fv, logf)

    kvs = lambda name: h[name].reshape(B, S, NSA_KV_GROUPS, HEAD_DIM)
    nq = h["nsa_q"].reshape(B, S, NSA_HEADS, HEAD_DIM)
    nq_rot = rope(nq, pos)
    kc = nsa_compress(kvs("nsa_kc"), cmp_pe[0], cmp_w1[0], cmp_w2[0])
    vc = nsa_compress(kvs("nsa_vc"), cmp_pe[1], cmp_w1[1], cmp_w2[1])
    ks = rope(kvs("nsa_ks"), pos)
    kw = rope(kvs("nsa_kw"), pos)
    gates = jax.nn.sigmoid(h["nsa_g"].reshape(B, S, 3, NSA_KV_GROUPS, NSA_HPG))
    grp = lambda t: t.reshape(B, S, NSA_KV_GROUPS, NSA_HPG, HEAD_DIM)
    o_nsa = nsa_mixer(grp(nq), grp(nq_rot), kc, vc, ks, kvs("nsa_vs"), kw, kvs("nsa_vw"), gates)

    mix = jnp.concatenate([o_dsa.reshape(B, S, DSA_W), o_fox.reshape(B, S, FOX_W),
                           o_nsa.reshape(B, S, NSA_W)], axis=-1)
    y = (mix * jax.nn.silu(h["gate"])) @ w_out
    return layer_norm(ALPHA * x + (1.0 + gate[:, None, :]) * y, ln_g, ln_b)


def setup_inputs(seed: int = 0) -> dict:
    key = jax.random.key(seed)
    ks = jax.random.split(key, 12)
    D = D_MODEL
    L = NSA_CMP_LEN
    nrm = lambda k, shape, s: jax.random.normal(k, shape, jnp.float32) * s
    return {
        "x": nrm(ks[0], (BATCH, SEQ, D), 1.0),
        "c": nrm(ks[1], (BATCH, D), 1.0),
        "w_ada": nrm(ks[2], (DEPTH, D, 3 * D), 0.1 * D ** -0.5),
        "b_ada": nrm(ks[3], (DEPTH, 3 * D), 0.01),
        "w_in": nrm(ks[4], (DEPTH, D, IN_WIDTH), D ** -0.5),
        "b_f": jax.random.uniform(ks[5], (DEPTH, FOX_HEADS), jnp.float32, 1.0, 4.0),
        "cmp_pe": nrm(ks[6], (DEPTH, 2, L, HEAD_DIM), 0.1),
        "cmp_w1": nrm(ks[7], (DEPTH, 2, L * HEAD_DIM, HEAD_DIM), (L * HEAD_DIM) ** -0.5),
        "cmp_w2": nrm(ks[8], (DEPTH, 2, HEAD_DIM, HEAD_DIM), HEAD_DIM ** -0.5),
        "w_out": nrm(ks[9], (DEPTH, MIX_W, D), BETA * MIX_W ** -0.5),
        "ln_g": 1.0 + nrm(ks[10], (DEPTH, D), 0.01),
        "ln_b": nrm(ks[11], (DEPTH, D), 0.01),
    }


def reference(x, c, w_ada, b_ada, w_in, b_f, cmp_pe, cmp_w1, cmp_w2, w_out, ln_g, ln_b):
    for l in range(DEPTH):
        x = hybrid_layer(x, c, w_ada[l], b_ada[l], w_in[l], b_f[l], cmp_pe[l], cmp_w1[l],
                         cmp_w2[l], w_out[l], ln_g[l], ln_b[l])
    return x
```

```cpp
#include <hip/hip_runtime.h>
#include <hip/hip_cooperative_groups.h>
#include <stdint.h>
#include <stdio.h>
namespace cg = cooperative_groups;

#define DEV __device__ __forceinline__
typedef unsigned short bf16_t;
typedef short bf16x8 __attribute__((ext_vector_type(8)));
typedef short s16x4 __attribute__((ext_vector_type(4)));
typedef float f32x16 __attribute__((ext_vector_type(16)));
typedef float f32x4 __attribute__((ext_vector_type(4)));
typedef float f32x2 __attribute__((ext_vector_type(2)));
typedef unsigned u32x4 __attribute__((ext_vector_type(4)));
typedef unsigned u32x2 __attribute__((ext_vector_type(2)));
typedef short v4i16_t __attribute__((ext_vector_type(4)));
#define LDSAS __attribute__((address_space(3)))

constexpr int NB = 8, S = 2048, DM = 1024, NTOK = NB * S, HP = 4096;
constexpr int C_DSAQ = 0, C_DSAK = 256, C_DSAV = 320, C_IDXQ = 384, C_IDXK = 640, C_MISC = 672, C_FOXQ = 704, C_FOXK = 1088, C_FOXV = 1472,
              C_NSAQ = 1856, C_KC = 2240, C_VC = 2368, C_KS = 2496, C_VS = 2624, C_KW = 2752, C_VW = 2880, C_GATE = 3008;
constexpr float LOG2E = 1.4426950408889634f;
constexpr float QS = 0.125f * LOG2E;
constexpr float ALPHA = 1.4142135623730951f;
constexpr float NEG_INF = -__builtin_huge_valf();

constexpr size_t WS_CTRL = 0;
constexpr size_t WS_MOD = 4096;
constexpr size_t WS_CS64 = WS_MOD + 2 * 8 * 3072 * 4;
constexpr size_t WS_CS32 = WS_CS64 + 2048 * 32 * 8;
constexpr size_t WS_WINT = WS_CS32 + 2048 * 16 * 8;
constexpr size_t WS_WOUTT = WS_WINT + (size_t)2 * 4096 * 1024 * 2;
constexpr size_t WS_W1T = WS_WOUTT + (size_t)2 * 1024 * 1024 * 2;
constexpr size_t WS_U = WS_W1T + (size_t)2 * 2 * 64 * 2048 * 2;
constexpr size_t WS_MIX = WS_U + (size_t)NTOK * 1024 * 2;
constexpr size_t WS_QROT = WS_MIX + (size_t)NTOK * 1024 * 2;
constexpr size_t WS_IW = WS_QROT + (size_t)NTOK * 384 * 2;
constexpr size_t WS_GSIG = WS_IW + (size_t)NTOK * 8 * 4;
constexpr size_t WS_LOGF = WS_GSIG + (size_t)NTOK * 20 * 4;
constexpr size_t WS_KC = WS_LOGF + (size_t)8 * 6 * 2048 * 4;
constexpr size_t WS_VC = WS_KC + (size_t)8 * 2 * 128 * 64 * 2;
constexpr size_t WS_H = WS_VC + (size_t)8 * 2 * 128 * 64 * 2;
constexpr size_t WS_END = WS_H + (size_t)NTOK * HP * 2;
static_assert(WS_END <= (size_t)256 * 1024 * 1024, "workspace");

constexpr int SMEM_BYTES = 75776;

struct Params {
    const float *x, *c, *w_ada, *b_ada, *w_in, *b_f, *cmp_pe, *cmp_w1, *cmp_w2, *w_out, *ln_g, *ln_b;
    float* out; char* ws;
};

#define OPAQUE_V(x) asm volatile("" : "+v"(x))
#define CR(r) (((r) & 3) + 8 * ((r) >> 2))
DEV int crow(int r, int h) { return (r & 3) + 8 * (r >> 2) + 4 * h; }
typedef __bf16 bf16x2_t __attribute__((ext_vector_type(2)));
DEV unsigned cvt_pk(float lo, float hi) { const f32x2 v = {lo, hi}; return __builtin_bit_cast(unsigned, __builtin_convertvector(v, bf16x2_t)); }
DEV float bf_lo(unsigned v) { return __uint_as_float(v << 16); }
DEV float bf_hi(unsigned v) { return __uint_as_float(v & 0xffff0000u); }
DEV f32x16 mfma(bf16x8 a, bf16x8 b, f32x16 c) { return __builtin_amdgcn_mfma_f32_32x32x16_bf16(a, b, c, 0, 0, 0); }
DEV float fexp2(float x) { return __builtin_amdgcn_exp2f(x); }
DEV s16x4 vtr(const char* p) { return __builtin_bit_cast(s16x4, __builtin_amdgcn_ds_read_tr16_b64_v4i16((LDSAS v4i16_t*)p)); }
DEV bf16x8 cat4(s16x4 a, s16x4 b) { bf16x8 r; r[0] = a[0]; r[1] = a[1]; r[2] = a[2]; r[3] = a[3]; r[4] = b[0]; r[5] = b[1]; r[6] = b[2]; r[7] = b[3]; return r; }
DEV u32x4 pack8(const float* v) { u32x4 r; r.x = cvt_pk(v[0], v[1]); r.y = cvt_pk(v[2], v[3]); r.z = cvt_pk(v[4], v[5]); r.w = cvt_pk(v[6], v[7]); return r; }
DEV float sigmoidf_(float v) { return 1.0f / (1.0f + __expf(-v)); }

DEV void sincos_acc(float a, float& sn, float& cs) {
    const float q = rintf(a * 0.6366197723675814f);
    float y = fmaf(-q, 1.5703125f, a); y = fmaf(-q, 4.837512969970703125e-4f, y); y = fmaf(-q, 7.54978995489188216e-8f, y);
    const float z = y * y;
    const float sp = y + y * z * (-1.6666654611e-1f + z * (8.3321608736e-3f + z * (-1.9515295891e-4f)));
    const float cp = 1.0f + z * (-0.5f + z * (4.166664568298827e-2f + z * (-1.388731625493765e-3f + z * 2.443315711809948e-5f)));
    const int qi = ((int)q) & 3;
    sn = (qi == 0) ? sp : (qi == 1) ? cp : (qi == 2) ? -sp : -cp;
    cs = (qi == 0) ? cp : (qi == 1) ? -sp : (qi == 2) ? -cp : sp;
}

DEV int win_srccol(int n) {
    if (n < 672) return n;
    if (n < 704) { const int j = n - 672; return j < 8 ? 672 + j : (j < 14 ? 1832 + (j - 8) : 2990 + (j - 14)); }
    if (n < 1856) return 680 + (n - 704);
    if (n < 3008) return 1838 + (n - 1856);
    if (n < 4032) return n;
    return -1;
}
DEV void transpose_unit(const float* __restrict__ src, int ldsrc, bf16_t* __restrict__ dst, int K, int n0, int k0, bool winmap, char* smem) {
    float* t = (float*)smem;
    int tid_ = threadIdx.x; OPAQUE_V(tid_); const int tid = tid_;
    {
        const int nn = tid & 63, n = n0 + nn; const int sc = winmap ? win_srccol(n) : n;
#pragma unroll
        for (int i = 0; i < 16; ++i) { const int kk = (tid >> 6) + 4 * i; t[kk * 65 + nn] = sc >= 0 ? src[(size_t)(k0 + kk) * ldsrc + sc] : 0.f; }
    }
    __syncthreads();
    {
        const int nn = tid >> 2, kq = tid & 3; float v[16];
#pragma unroll
        for (int j = 0; j < 16; ++j) v[j] = t[(kq * 16 + j) * 65 + nn];
        u32x4* d = (u32x4*)(dst + (size_t)(n0 + nn) * K + k0 + kq * 16);
        d[0] = pack8(v); d[1] = pack8(v + 8);
    }
    __syncthreads();
}
DEV void mod_unit(const Params& p, int L, int cgi, char* smem) {
    float* cs = (float*)smem;
    float* red = (float*)(smem + 32768);
    int tid_ = threadIdx.x; OPAQUE_V(tid_); const int tid = tid_;
#pragma unroll
    for (int i = 0; i < 32; ++i) cs[tid + 256 * i] = p.c[tid + 256 * i];
    __syncthreads();
    const int cc = tid & 31, kk = tid >> 5, col = cgi * 32 + cc;
    float acc[8];
#pragma unroll
    for (int b = 0; b < 8; ++b) acc[b] = 0.f;
    const float* w = p.w_ada + ((size_t)L * 1024 + kk * 128) * 3072 + col;
#pragma unroll 8
    for (int k = 0; k < 128; ++k) {
        const float wv = w[(size_t)k * 3072];
#pragma unroll
        for (int b = 0; b < 8; ++b) acc[b] = fmaf(cs[b * 1024 + kk * 128 + k], wv, acc[b]);
    }
#pragma unroll
    for (int b = 0; b < 8; ++b) red[(kk * 8 + b) * 32 + cc] = acc[b];
    __syncthreads();
    {
        const int b = tid >> 5; float s = p.b_ada[L * 3072 + col];
#pragma unroll
        for (int k2 = 0; k2 < 8; ++k2) s += red[(k2 * 8 + b) * 32 + cc];
        ((float*)(p.ws + WS_MOD))[(L * 8 + b) * 3072 + col] = s;
    }
    __syncthreads();
}
DEV void phase_prep(const Params& p, char* smem) {
    constexpr int N_MOD = 192, N_TAB = 384, N_WIN = 2048, N_WOUT = 512, N_W1 = 128;
    constexpr int TOT = N_MOD + N_TAB + N_WIN + N_WOUT + N_W1;
    for (int u = blockIdx.x; u < TOT; u += gridDim.x) {
        int v = u;
        if (v < N_MOD) { mod_unit(p, v / 96, v % 96, smem); continue; }
        v -= N_MOD;
        if (v < N_TAB) {
            int tx_ = threadIdx.x; OPAQUE_V(tx_); const int idx = v * 256 + tx_;
            if (idx < 65536) {
                const int pos = idx >> 5, i = idx & 31; const float inv = powf(10000.0f, -(float)i / 32.0f);
                float sn, cs; sincos_acc((float)pos * inv, sn, cs);
                ((f32x2*)(p.ws + WS_CS64))[idx] = (f32x2){cs, sn};
            } else {
                const int id2 = idx - 65536; const int pos = id2 >> 4, i = id2 & 15; const float inv = powf(10000.0f, -(float)i / 16.0f);
                float sn, cs; sincos_acc((float)pos * inv, sn, cs);
                ((f32x2*)(p.ws + WS_CS32))[id2] = (f32x2){cs, sn};
            }
            continue;
        }
        v -= N_TAB;
        if (v < N_WIN) { const int L = v >> 10, r = v & 1023, nt = r >> 4, kt = r & 15;
            transpose_unit(p.w_in + (size_t)L * 1024 * 4032, 4032, (bf16_t*)(p.ws + WS_WINT) + (size_t)L * 4096 * 1024, 1024, nt * 64, kt * 64, true, smem); continue; }
        v -= N_WIN;
        if (v < N_WOUT) { const int L = v >> 8, r = v & 255, nt = r >> 4, kt = r & 15;
            transpose_unit(p.w_out + (size_t)L * 1024 * 1024, 1024, (bf16_t*)(p.ws + WS_WOUTT) + (size_t)L * 1024 * 1024, 1024, nt * 64, kt * 64, false, smem); continue; }
        v -= N_WOUT;
        { const int lk = v >> 5, kt = v & 31;
            transpose_unit(p.cmp_w1 + (size_t)lk * 2048 * 64, 64, (bf16_t*)(p.ws + WS_W1T) + (size_t)lk * 64 * 2048, 2048, 0, kt * 64, false, smem); }
    }
}

DEV void phase_u1(const Params& p) {
    const float* mod = (const float*)(p.ws + WS_MOD);
    bf16_t* U = (bf16_t*)(p.ws + WS_U);
    for (int u = blockIdx.x; u < 2048; u += gridDim.x) {
        int tx_ = threadIdx.x; OPAQUE_V(tx_);
#pragma unroll
        for (int i = 0; i < 4; ++i) {
            const int e = tx_ + 256 * i, row = 8 * u + (e >> 7), c8 = (e & 127) * 8, b = row >> 11;
            const f32x4* xp = (const f32x4*)(p.x + (size_t)row * 1024 + c8);
            const f32x4* sh = (const f32x4*)(mod + (size_t)b * 3072 + c8);
            const f32x4* sc = (const f32x4*)(mod + (size_t)b * 3072 + 1024 + c8);
            float v[8];
#pragma unroll
            for (int q = 0; q < 2; ++q) { const f32x4 xv = xp[q], s1 = sc[q], s0 = sh[q];
#pragma unroll
                for (int k = 0; k < 4; ++k) v[4 * q + k] = fmaf(xv[k], 1.0f + s1[k], s0[k]); }
            *(u32x4*)(U + (size_t)row * 1024 + c8) = pack8(v);
        }
    }
}

constexpr int KP = 72, CTP = 132;
DEV void gemm_tile(const bf16_t* __restrict__ X, const bf16_t* __restrict__ W, int K, int m0, int n0, char* smem) {
    bf16_t* Xs = (bf16_t*)smem; bf16_t* Ws = Xs + 128 * KP;
    int tid_ = threadIdx.x; OPAQUE_V(tid_); const int tid = tid_, lane = tid & 63, w = tid >> 6, wm = w >> 1, wn = w & 1, r32 = lane & 31, h = lane >> 5;
    const bf16_t* xg = X + (size_t)(m0 + (tid >> 3)) * K + (tid & 7) * 8;
    const bf16_t* wg = W + (size_t)(n0 + (tid >> 3)) * K + (tid & 7) * 8;
    u32x4 xr[4], wr[4];
#pragma unroll
    for (int i = 0; i < 4; ++i) { xr[i] = *(const u32x4*)(xg + (size_t)i * 32 * K); wr[i] = *(const u32x4*)(wg + (size_t)i * 32 * K); }
    f32x16 acc[2][2];
#pragma unroll
    for (int i = 0; i < 2; ++i)
#pragma unroll
        for (int j = 0; j < 2; ++j)
#pragma unroll
            for (int r = 0; r < 16; ++r) acc[i][j][r] = 0.f;
    const int nk = K / 64;
    for (int kt = 0; kt < nk; ++kt) {
        __syncthreads();
#pragma unroll
        for (int i = 0; i < 4; ++i) { *(u32x4*)(Xs + ((tid >> 3) + 32 * i) * KP + (tid & 7) * 8) = xr[i]; *(u32x4*)(Ws + ((tid >> 3) + 32 * i) * KP + (tid & 7) * 8) = wr[i]; }
        __syncthreads();
        if (kt + 1 < nk) {
#pragma unroll
            for (int i = 0; i < 4; ++i) { xr[i] = *(const u32x4*)(xg + (size_t)i * 32 * K + (kt + 1) * 64); wr[i] = *(const u32x4*)(wg + (size_t)i * 32 * K + (kt + 1) * 64); }
        }
#pragma unroll
        for (int s = 0; s < 4; ++s) {
            bf16x8 a[2], b[2];
#pragma unroll
            for (int i = 0; i < 2; ++i) { a[i] = *(const bf16x8*)(Ws + (wm * 64 + 32 * i + r32) * KP + 16 * s + 8 * h); b[i] = *(const bf16x8*)(Xs + (wn * 64 + 32 * i + r32) * KP + 16 * s + 8 * h); }
#pragma unroll
            for (int i = 0; i < 2; ++i)
#pragma unroll
                for (int j = 0; j < 2; ++j) acc[i][j] = mfma(a[i], b[j], acc[i][j]);
        }
    }
    __syncthreads();
    float* Ct = (float*)smem;
#pragma unroll
    for (int i = 0; i < 2; ++i)
#pragma unroll
        for (int j = 0; j < 2; ++j)
#pragma unroll
            for (int a = 0; a < 4; ++a) {
                f32x4 v = {acc[i][j][4 * a], acc[i][j][4 * a + 1], acc[i][j][4 * a + 2], acc[i][j][4 * a + 3]};
                *(f32x4*)(Ct + (wn * 64 + 32 * j + r32) * CTP + wm * 64 + 32 * i + 8 * a + 4 * h) = v;
            }
    __syncthreads();
}

DEV void ld8(const float* Ct, int row, int col, float* v) { const f32x4 a = *(const f32x4*)(Ct + row * CTP + col), b = *(const f32x4*)(Ct + row * CTP + col + 4);
    v[0] = a[0]; v[1] = a[1]; v[2] = a[2]; v[3] = a[3]; v[4] = b[0]; v[5] = b[1]; v[6] = b[2]; v[7] = b[3]; }
DEV void epi_in_chunk(const Params& p, int L, const float* Ct, int m0, int c64, int lc) {
    bf16_t* H = (bf16_t*)(p.ws + WS_H);
    int tid_ = threadIdx.x; OPAQUE_V(tid_); const int tid = tid_, j = tid & 3;
    if (c64 == 63) return;
#pragma unroll
    for (int it = 0; it < 2; ++it) {
        const int row = (tid >> 2) + 64 * it, token = m0 + row, pos = token & 2047, b = token >> 11;
        bf16_t* hrow = H + (size_t)token * HP + c64 * 64;
        float xa[8], xb[8], oa[8], ob[8];
        if (c64 <= 4 || (c64 >= 29 && c64 <= 34) || c64 == 39 || c64 == 40 || c64 == 43 || c64 == 44) {
            const bool isq = (c64 <= 3) || (c64 >= 29 && c64 <= 34); const float sc = isq ? QS : 1.0f;
            ld8(Ct, row, lc + 8 * j, xa); ld8(Ct, row, lc + 32 + 8 * j, xb);
            const f32x4* cp = (const f32x4*)((const f32x2*)(p.ws + WS_CS64) + pos * 32 + 8 * j);
#pragma unroll
            for (int q = 0; q < 4; ++q) { const f32x4 cv = cp[q];
                oa[2 * q] = (xa[2 * q] * cv[0] - xb[2 * q] * cv[1]) * sc; ob[2 * q] = (xa[2 * q] * cv[1] + xb[2 * q] * cv[0]) * sc;
                oa[2 * q + 1] = (xa[2 * q + 1] * cv[2] - xb[2 * q + 1] * cv[3]) * sc; ob[2 * q + 1] = (xa[2 * q + 1] * cv[3] + xb[2 * q + 1] * cv[2]) * sc; }
            if (c64 >= 29 && c64 <= 34) {
                bf16_t* qr = (bf16_t*)(p.ws + WS_QROT) + (size_t)token * 384 + (c64 - 29) * 64;
                *(u32x4*)(qr + 8 * j) = pack8(oa); *(u32x4*)(qr + 32 + 8 * j) = pack8(ob);
#pragma unroll
                for (int e = 0; e < 8; ++e) { oa[e] = xa[e] * sc; ob[e] = xb[e] * sc; }
            }
            *(u32x4*)(hrow + 8 * j) = pack8(oa); *(u32x4*)(hrow + 32 + 8 * j) = pack8(ob);
        } else if (c64 >= 6 && c64 <= 9) {
            const int hh = j >> 1, part = j & 1, ca = 32 * hh + 8 * part;
            ld8(Ct, row, lc + ca, xa); ld8(Ct, row, lc + ca + 16, xb);
            const f32x4* cp = (const f32x4*)((const f32x2*)(p.ws + WS_CS32) + pos * 16 + 8 * part);
#pragma unroll
            for (int q = 0; q < 4; ++q) { const f32x4 cv = cp[q];
                oa[2 * q] = xa[2 * q] * cv[0] - xb[2 * q] * cv[1]; ob[2 * q] = xa[2 * q] * cv[1] + xb[2 * q] * cv[0];
                oa[2 * q + 1] = xa[2 * q + 1] * cv[2] - xb[2 * q + 1] * cv[3]; ob[2 * q + 1] = xa[2 * q + 1] * cv[3] + xb[2 * q + 1] * cv[2]; }
            *(u32x4*)(hrow + ca) = pack8(oa); *(u32x4*)(hrow + ca + 16) = pack8(ob);
        } else if (c64 == 10) {
            if (j < 2) {
                ld8(Ct, row, lc + 8 * j, xa); ld8(Ct, row, lc + 16 + 8 * j, xb);
                const f32x4* cp = (const f32x4*)((const f32x2*)(p.ws + WS_CS32) + pos * 16 + 8 * j);
#pragma unroll
                for (int q = 0; q < 4; ++q) { const f32x4 cv = cp[q];
                    oa[2 * q] = xa[2 * q] * cv[0] - xb[2 * q] * cv[1]; ob[2 * q] = xa[2 * q] * cv[1] + xb[2 * q] * cv[0];
                    oa[2 * q + 1] = xa[2 * q + 1] * cv[2] - xb[2 * q + 1] * cv[3]; ob[2 * q + 1] = xa[2 * q + 1] * cv[3] + xb[2 * q + 1] * cv[2]; }
                *(u32x4*)(hrow + 8 * j) = pack8(oa); *(u32x4*)(hrow + 16 + 8 * j) = pack8(ob);
            } else if (j == 2) {
                ld8(Ct, row, lc + 32, xa);
                float* iw = (float*)(p.ws + WS_IW) + (size_t)token * 8;
                *(f32x4*)iw = (f32x4){xa[0], xa[1], xa[2], xa[3]} * 0.35355339059327373f; *(f32x4*)(iw + 4) = (f32x4){xa[4], xa[5], xa[6], xa[7]} * 0.35355339059327373f;
            } else {
                float* lf = (float*)(p.ws + WS_LOGF); float* gs = (float*)(p.ws + WS_GSIG) + (size_t)token * 20;
#pragma unroll
                for (int e = 0; e < 6; ++e) { const float v = Ct[row * CTP + lc + 40 + e] + p.b_f[L * 6 + e];
                    lf[((size_t)b * 6 + e) * 2048 + pos] = fminf(v, 0.f) - log1pf(expf(-fabsf(v))); }
#pragma unroll
                for (int e = 0; e < 18; ++e) gs[e] = 1.0f / (1.0f + expf(-Ct[row * CTP + lc + 46 + e]));
            }
        } else {
            const bool isq = (c64 >= 11 && c64 <= 16); const bool silu = c64 >= 47; const float sc = isq ? QS : 1.0f;
            ld8(Ct, row, lc + 8 * j, xa); ld8(Ct, row, lc + 32 + 8 * j, xb);
#pragma unroll
            for (int e = 0; e < 8; ++e) {
                float a = xa[e] * sc, bb = xb[e] * sc;
                if (silu) { a = a / (1.0f + __expf(-a)); bb = bb / (1.0f + __expf(-bb)); }
                oa[e] = a; ob[e] = bb;
            }
            *(u32x4*)(hrow + 8 * j) = pack8(oa); *(u32x4*)(hrow + 32 + 8 * j) = pack8(ob);
        }
    }
}
DEV void phase_gemm_in(const Params& p, int L, char* smem) {
    const bf16_t* U = (const bf16_t*)(p.ws + WS_U);
    const bf16_t* W = (const bf16_t*)(p.ws + WS_WINT) + (size_t)L * 4096 * 1024;
    for (int u = blockIdx.x; u < 4096; u += gridDim.x) {
        const int mt = u >> 5, nt = u & 31;
        gemm_tile(U, W, 1024, mt * 128, nt * 128, smem);
        epi_in_chunk(p, L, (const float*)smem, mt * 128, nt * 2, 0);
        epi_in_chunk(p, L, (const float*)smem, mt * 128, nt * 2 + 1, 64);
        __syncthreads();
    }
}
DEV void phase_out(const Params& p, int L, char* smem) {
    const bf16_t* A = (const bf16_t*)(p.ws + WS_MIX);
    const bf16_t* W = (const bf16_t*)(p.ws + WS_WOUTT) + (size_t)L * 1024 * 1024;
    const float* xin = L == 0 ? p.x : p.out;
    float* Z = (float*)(p.ws + WS_H);
    const float* mod = (const float*)(p.ws + WS_MOD) + (size_t)L * 8 * 3072;
    for (int u = blockIdx.x; u < 1024; u += gridDim.x) {
        const int mt = u >> 3, nt = u & 7, m0 = mt * 128, n0 = nt * 128;
        gemm_tile(A, W, 1024, m0, n0, smem);
        const float* Ct = (const float*)smem;
        int tx_ = threadIdx.x; OPAQUE_V(tx_);
#pragma unroll
        for (int i = 0; i < 16; ++i) {
            const int item = tx_ + 256 * i, row = item >> 5, c4 = (item & 31) * 4, token = m0 + row, b = token >> 11;
            const f32x4 y = *(const f32x4*)(Ct + row * CTP + c4);
            const f32x4 xv = *(const f32x4*)(xin + (size_t)token * 1024 + n0 + c4);
            const f32x4 g = *(const f32x4*)(mod + (size_t)b * 3072 + 2048 + n0 + c4);
            f32x4 z;
#pragma unroll
            for (int k = 0; k < 4; ++k) z[k] = fmaf(1.0f + g[k], y[k], ALPHA * xv[k]);
            *(f32x4*)(Z + (size_t)token * 1024 + n0 + c4) = z;
        }
        __syncthreads();
    }
}
DEV void phase_ln(const Params& p, int L) {
    const float* Z = (const float*)(p.ws + WS_H);
    const float* mod = (const float*)(p.ws + WS_MOD) + (size_t)8 * 3072;
    bf16_t* U = (bf16_t*)(p.ws + WS_U);
    for (int u = blockIdx.x; u < 1024; u += gridDim.x) {
        int tx_ = threadIdx.x; OPAQUE_V(tx_);
        const int lane = tx_ & 63, w = tx_ >> 6;
        for (int rr = 0; rr < 4; ++rr) {
            const int row = u * 16 + w * 4 + rr, b = row >> 11;
            f32x4 v[4]; float s = 0.f;
#pragma unroll
            for (int i = 0; i < 4; ++i) { v[i] = *(const f32x4*)(Z + (size_t)row * 1024 + 256 * i + 4 * lane); s += (v[i][0] + v[i][1]) + (v[i][2] + v[i][3]); }
#pragma unroll
            for (int o = 32; o >= 1; o >>= 1) s += __shfl_xor(s, o);
            const float mean = s * (1.0f / 1024.0f); float q = 0.f;
#pragma unroll
            for (int i = 0; i < 4; ++i)
#pragma unroll
                for (int k = 0; k < 4; ++k) { const float d = v[i][k] - mean; q = fmaf(d, d, q); }
#pragma unroll
            for (int o = 32; o >= 1; o >>= 1) q += __shfl_xor(q, o);
            const float rstd = rsqrtf(q * (1.0f / 1024.0f) + 1e-5f);
#pragma unroll
            for (int i = 0; i < 4; ++i) {
                const int col = 256 * i + 4 * lane;
                const f32x4 g = *(const f32x4*)(p.ln_g + L * 1024 + col), bb = *(const f32x4*)(p.ln_b + L * 1024 + col);
                f32x4 o;
#pragma unroll
                for (int k = 0; k < 4; ++k) o[k] = (v[i][k] - mean) * rstd * g[k] + bb[k];
                *(f32x4*)(p.out + (size_t)row * 1024 + col) = o;
                if (L == 0) {
                    const f32x4 sh = *(const f32x4*)(mod + (size_t)b * 3072 + col), sc = *(const f32x4*)(mod + (size_t)b * 3072 + 1024 + col);
                    u32x2 pk; pk.x = cvt_pk(fmaf(o[0], 1.0f + sc[0], sh[0]), fmaf(o[1], 1.0f + sc[1], sh[1])); pk.y = cvt_pk(fmaf(o[2], 1.0f + sc[2], sh[2]), fmaf(o[3], 1.0f + sc[3], sh[3]));
                    *(u32x2*)(U + (size_t)row * 1024 + col) = pk;
                }
            }
        }
    }
}

constexpr int KT_BYTES = 64 * KP * 2, VT_BYTES = 8192;
DEV void stage_kv(const bf16_t* __restrict__ kg, const bf16_t* __restrict__ vg, size_t pitch, char* ksm, char* vsm) {
    int tid_ = threadIdx.x; OPAQUE_V(tid_); const int tid = tid_;
    u32x4 kr[2], vr[2];
#pragma unroll
    for (int i = 0; i < 2; ++i) { const int c = tid + 256 * i, row = c >> 3, ch = c & 7;
        kr[i] = *(const u32x4*)(kg + (size_t)row * pitch + ch * 8); vr[i] = *(const u32x4*)(vg + (size_t)row * pitch + ch * 8); }
#pragma unroll
    for (int i = 0; i < 2; ++i) { const int c = tid + 256 * i, row = c >> 3, ch = c & 7;
        *(u32x4*)(ksm + (row * KP + ch * 8) * 2) = kr[i];
        *(u32x4*)(vsm + (ch >> 2) * 4096 + row * 64 + (ch & 3) * 16) = vr[i]; }
}
DEV void load_qf(const bf16_t* q  , int h, bf16x8* qf) {
#pragma unroll
    for (int s = 0; s < 4; ++s) qf[s] = *(const bf16x8*)(q + 16 * s + 8 * h);
}
DEV void qk_tile(const char* ksm, const bf16x8* qf, int r32, int h, f32x16& s0, f32x16& s1) {
#pragma unroll
    for (int r = 0; r < 16; ++r) { s0[r] = 0.f; s1[r] = 0.f; }
#pragma unroll
    for (int s = 0; s < 4; ++s) {
        const bf16x8 a0 = *(const bf16x8*)(ksm + (r32 * KP + 16 * s + 8 * h) * 2);
        const bf16x8 a1 = *(const bf16x8*)(ksm + ((32 + r32) * KP + 16 * s + 8 * h) * 2);
        s0 = mfma(a0, qf[s], s0); s1 = mfma(a1, qf[s], s1);
    }
}
DEV void pv_tile(const char* vsm, int kofs, const f32x16& pt, int lane, f32x16& o0, f32x16& o1) {
    const int h = lane >> 5;
    const char* vb = vsm + ((lane >> 4) & 1) * 32 + (lane & 3) * 8 + (4 * h + ((lane & 15) >> 2) + kofs) * 64;
#pragma unroll
    for (int sp = 0; sp < 2; ++sp) {
        bf16x8 pb;
        { u32x4 t; t.x = cvt_pk(pt[8 * sp], pt[8 * sp + 1]); t.y = cvt_pk(pt[8 * sp + 2], pt[8 * sp + 3]); t.z = cvt_pk(pt[8 * sp + 4], pt[8 * sp + 5]); t.w = cvt_pk(pt[8 * sp + 6], pt[8 * sp + 7]); pb = __builtin_bit_cast(bf16x8, t); }
        const bf16x8 a0 = cat4(vtr(vb + (16 * sp) * 64), vtr(vb + (16 * sp + 8) * 64));
        const bf16x8 a1 = cat4(vtr(vb + 4096 + (16 * sp) * 64), vtr(vb + 4096 + (16 * sp + 8) * 64));
        o0 = mfma(a0, pb, o0); o1 = mfma(a1, pb, o1);
    }
}
DEV void flash_update(f32x16& s0, f32x16& s1, float& m, float& l, f32x16& o0, f32x16& o1, const char* vsm, int lane) {
    float mx = NEG_INF;
#pragma unroll
    for (int r = 0; r < 16; ++r) mx = fmaxf(mx, fmaxf(s0[r], s1[r]));
    mx = fmaxf(mx, __shfl_xor(mx, 32));
    const float mn = fmaxf(m, mx), mu = (mn == NEG_INF) ? 0.f : mn;
    const float alpha = fexp2(m - mu);
    m = mn;
    float ps = 0.f;
#pragma unroll
    for (int r = 0; r < 16; ++r) { s0[r] = fexp2(s0[r] - mu); s1[r] = fexp2(s1[r] - mu); ps += s0[r] + s1[r]; }
    l = fmaf(l, alpha, ps);
#pragma unroll
    for (int r = 0; r < 16; ++r) { o0[r] *= alpha; o1[r] *= alpha; }
    pv_tile(vsm, 0, s0, lane, o0, o1);
    pv_tile(vsm, 32, s1, lane, o0, o1);
}
DEV f32x16 qk32(const char* kbase, const bf16x8* qf, int r32, int h) {
    f32x16 s;
#pragma unroll
    for (int r = 0; r < 16; ++r) s[r] = 0.f;
#pragma unroll
    for (int k = 0; k < 4; ++k) { const bf16x8 a = *(const bf16x8*)(kbase + (r32 * KP + 16 * k + 8 * h) * 2); s = mfma(a, qf[k], s); }
    return s;
}
DEV void flash_update32(f32x16& s, float& m, float& l, f32x16& o0, f32x16& o1, const char* vsm, int kofs, int hstride, int lane) {
    float mx = NEG_INF;
#pragma unroll
    for (int r = 0; r < 16; ++r) mx = fmaxf(mx, s[r]);
    mx = fmaxf(mx, __shfl_xor(mx, 32));
    const float mn = fmaxf(m, mx), mu = (mn == NEG_INF) ? 0.f : mn;
    const float alpha = fexp2(m - mu);
    m = mn;
    float ps = 0.f;
#pragma unroll
    for (int r = 0; r < 16; ++r) { s[r] = fexp2(s[r] - mu); ps += s[r]; }
    l = fmaf(l, alpha, ps);
#pragma unroll
    for (int r = 0; r < 16; ++r) { o0[r] *= alpha; o1[r] *= alpha; }
    const int h = lane >> 5;
    const char* vb = vsm + ((lane >> 4) & 1) * 32 + (lane & 3) * 8 + (4 * h + ((lane & 15) >> 2) + kofs) * 64;
#pragma unroll
    for (int sp = 0; sp < 2; ++sp) {
        u32x4 t; t.x = cvt_pk(s[8 * sp], s[8 * sp + 1]); t.y = cvt_pk(s[8 * sp + 2], s[8 * sp + 3]); t.z = cvt_pk(s[8 * sp + 4], s[8 * sp + 5]); t.w = cvt_pk(s[8 * sp + 6], s[8 * sp + 7]);
        const bf16x8 pb = __builtin_bit_cast(bf16x8, t);
        const bf16x8 a0 = cat4(vtr(vb + (16 * sp) * 64), vtr(vb + (16 * sp + 8) * 64));
        const bf16x8 a1 = cat4(vtr(vb + hstride + (16 * sp) * 64), vtr(vb + hstride + (16 * sp + 8) * 64));
        o0 = mfma(a0, pb, o0); o1 = mfma(a1, pb, o1);
    }
}
DEV void write_mix(const Params& p, size_t token, int mixcol0, const f32x16& o0, const f32x16& o1, int h) {
    const bf16_t* G = (const bf16_t*)(p.ws + WS_H) + token * HP + C_GATE + mixcol0;
    bf16_t* M = (bf16_t*)(p.ws + WS_MIX) + token * 1024 + mixcol0;
#pragma unroll
    for (int dt = 0; dt < 2; ++dt)
#pragma unroll
        for (int a = 0; a < 4; ++a) {
            const int d = 32 * dt + 8 * a + 4 * h;
            const u32x2 g = *(const u32x2*)(G + d);
            const f32x16& o = dt ? o1 : o0;
            u32x2 r; r.x = cvt_pk(o[4 * a] * bf_lo(g.x), o[4 * a + 1] * bf_hi(g.x)); r.y = cvt_pk(o[4 * a + 2] * bf_lo(g.y), o[4 * a + 3] * bf_hi(g.y));
            *(u32x2*)(M + d) = r;
        }
}

DEV void fox_unit(const Params& p, int b, int hh, int qb, char* smem) {
    char* ksm = smem; char* vsm = smem + KT_BYTES; float* cum = (float*)(smem + KT_BYTES + VT_BYTES);
    float* wtot = cum + 2048;
    int tid_ = threadIdx.x; OPAQUE_V(tid_); const int tid = tid_, lane = tid & 63, w = tid >> 6, r32 = lane & 31, h = lane >> 5;
    const int q0 = qb * 128, nneed = q0 + 128;
    const bf16_t* H = (const bf16_t*)(p.ws + WS_H) + (size_t)b * S * HP;
    {
        const float* lf = (const float*)(p.ws + WS_LOGF) + ((size_t)b * 6 + hh) * 2048;
        float v[8]; float s = 0.f;
        if (tid * 8 < nneed) { const f32x4 a = *(const f32x4*)(lf + tid * 8), c = *(const f32x4*)(lf + tid * 8 + 4);
            v[0] = a[0]; v[1] = a[1]; v[2] = a[2]; v[3] = a[3]; v[4] = c[0]; v[5] = c[1]; v[6] = c[2]; v[7] = c[3]; }
        else {
#pragma unroll
            for (int e = 0; e < 8; ++e) v[e] = 0.f; }
#pragma unroll
        for (int e = 0; e < 8; ++e) { s += v[e]; v[e] = s; }
        float inc = s;
#pragma unroll
        for (int o = 1; o < 64; o <<= 1) { const float t = __shfl_up(inc, o); if (lane >= o) inc += t; }
        if (lane == 63) wtot[w] = inc;
        __syncthreads();
        float base = inc - s;
        for (int k = 0; k < w; ++k) base += wtot[k];
        if (tid * 8 < nneed) {
#pragma unroll
            for (int e = 0; e < 8; ++e) cum[tid * 8 + e] = (base + v[e]) * LOG2E; }
        __syncthreads();
    }
    const int tq = q0 + 32 * w + r32;
    bf16x8 qf[4]; load_qf(H + (size_t)tq * HP + C_FOXQ + 64 * hh, h, qf);
    const float cb = cum[tq];
    float m = NEG_INF, l = 0.f; f32x16 o0, o1;
#pragma unroll
    for (int r = 0; r < 16; ++r) { o0[r] = 0.f; o1[r] = 0.f; }
    const int ntiles = nneed / 64, mylast = (q0 + 32 * w + 31) >> 6;
    for (int kt = 0; kt < ntiles; ++kt) {
        __syncthreads();
        stage_kv(H + (size_t)kt * 64 * HP + C_FOXK + 64 * hh, H + (size_t)kt * 64 * HP + C_FOXV + 64 * hh, HP, ksm, vsm);
        __syncthreads();
        if (kt <= mylast) {
            f32x16 s0, s1; qk_tile(ksm, qf, r32, h, s0, s1);
            int lim = tq - 64 * kt - 4 * h; OPAQUE_V(lim);
#pragma unroll
            for (int a = 0; a < 4; ++a) {
                const f32x4 c0 = *(const f32x4*)(cum + kt * 64 + 8 * a + 4 * h), c1 = *(const f32x4*)(cum + kt * 64 + 32 + 8 * a + 4 * h);
#pragma unroll
                for (int k = 0; k < 4; ++k) {
                    s0[4 * a + k] = (8 * a + k) <= lim ? s0[4 * a + k] + (cb - c0[k]) : NEG_INF;
                    s1[4 * a + k] = (8 * a + k + 32) <= lim ? s1[4 * a + k] + (cb - c1[k]) : NEG_INF;
                }
            }
            flash_update(s0, s1, m, l, o0, o1, vsm, lane);
        }
    }
    l += __shfl_xor(l, 32);
    const float inv = 1.0f / l;
#pragma unroll
    for (int r = 0; r < 16; ++r) { o0[r] *= inv; o1[r] *= inv; }
    write_mix(p, (size_t)b * S + tq, 256 + 64 * hh, o0, o1, h);
    __syncthreads();
}

constexpr int BMP = 65;
DEV unsigned ford(float f) { const unsigned u = __float_as_uint(f); return u ^ ((u >> 31) ? 0xffffffffu : 0x80000000u); }
DEV void topk_row(const float* sc, int n, unsigned* bmrow, int lane) {
    const int nch = (n + 63) >> 6;
    if (n <= 256) {
        for (int i = 0; i < 32; ++i) {
            const int lo = 64 * i; unsigned long long msk = 0ull;
            if (lo < n) { const int c = n - lo; msk = c >= 64 ? ~0ull : ((1ull << c) - 1ull); }
            if (lane == 0) { bmrow[2 * i] = (unsigned)msk; bmrow[2 * i + 1] = (unsigned)(msk >> 32); }
        }
        return;
    }
    unsigned u[32];
#pragma unroll
    for (int i = 0; i < 32; ++i) { const int idx = 64 * i + lane; u[i] = (i < nch && idx < n) ? ford(sc[idx]) : 0u; }
    unsigned T = 0u;
    for (int bit = 31; bit >= 0; --bit) {
        const unsigned cand = T | (1u << bit); int cnt = 0;
#pragma unroll
        for (int i = 0; i < 32; ++i) if (i < nch) cnt += __popcll(__ballot(u[i] >= cand));
        if (cnt >= 256) T = cand;
    }
    int ngt = 0;
#pragma unroll
    for (int i = 0; i < 32; ++i) if (i < nch) ngt += __popcll(__ballot(u[i] > T));
    const int need = 256 - ngt; int running = 0;
    const unsigned long long lt = (1ull << lane) - 1ull;
#pragma unroll
    for (int i = 0; i < 32; ++i) {
        unsigned long long sm = 0ull;
        if (i < nch) {
            const bool eq = u[i] == T; const unsigned long long bal = __ballot(eq);
            const int pre = running + __popcll(bal & lt);
            const bool sel = (u[i] > T) || (eq && pre < need);
            running += __popcll(bal);
            sm = __ballot(sel);
        }
        if (lane == 0) { bmrow[2 * i] = (unsigned)sm; bmrow[2 * i + 1] = (unsigned)(sm >> 32); }
    }
}
DEV void dsa_unit(const Params& p, int b, int qb, char* smem) {
    float* sc = (float*)smem;
    unsigned* bm = (unsigned*)(smem + 65536);
    char* ksm = smem; char* vsm = smem + KT_BYTES;
    int tid_ = threadIdx.x; OPAQUE_V(tid_); const int tid = tid_, lane = tid & 63, w = tid >> 6, r32 = lane & 31, h = lane >> 5;
    const int t0 = qb * 32;
    const bf16_t* H = (const bf16_t*)(p.ws + WS_H) + (size_t)b * S * HP;
    const float* IW = (const float*)(p.ws + WS_IW) + (size_t)b * S * 8;
    for (int sb = 0; sb < 4; ++sb) {
        const int ts = t0 + 8 * sb, nkeys = ts + 8, nkt = (nkeys + 31) >> 5;
        const int tl = 2 * ((r32 >> 2) & 1) + (r32 >> 4), head = ((r32 >> 3) & 1) * 4 + (r32 & 3);
        bf16x8 af[2][2]; f32x4 wv[2][4];
#pragma unroll
        for (int mt = 0; mt < 2; ++mt) {
#pragma unroll
            for (int ks = 0; ks < 2; ++ks) af[mt][ks] = *(const bf16x8*)(H + (size_t)(ts + 4 * mt + tl) * HP + C_IDXQ + 32 * head + 16 * ks + 8 * h);
#pragma unroll
            for (int a = 0; a < 4; ++a) wv[mt][a] = *(const f32x4*)(IW + (size_t)(ts + 4 * mt + 2 * h + (a >> 1)) * 8 + (a & 1) * 4);
        }
        for (int kt = w; kt < nkt; kt += 4) {
            const int key = 32 * kt + r32;
            bf16x8 bf[2];
#pragma unroll
            for (int ks = 0; ks < 2; ++ks) bf[ks] = *(const bf16x8*)(H + (size_t)key * HP + C_IDXK + 16 * ks + 8 * h);
#pragma unroll
            for (int mt = 0; mt < 2; ++mt) {
                f32x16 acc;
#pragma unroll
                for (int r = 0; r < 16; ++r) acc[r] = 0.f;
                acc = mfma(af[mt][0], bf[0], acc); acc = mfma(af[mt][1], bf[1], acc);
                float sA = 0.f, sB = 0.f;
#pragma unroll
                for (int a = 0; a < 2; ++a)
#pragma unroll
                    for (int k = 0; k < 4; ++k) { sA = fmaf(wv[mt][a][k], fmaxf(acc[4 * a + k], 0.f), sA); sB = fmaf(wv[mt][a + 2][k], fmaxf(acc[4 * (a + 2) + k], 0.f), sB); }
                const int rowA = 4 * mt + 2 * h, tokA = ts + rowA;
                sc[rowA * 2048 + key] = key <= tokA ? sA : NEG_INF;
                sc[(rowA + 1) * 2048 + key] = key <= tokA + 1 ? sB : NEG_INF;
            }
        }
        __syncthreads();
#pragma unroll 1
        for (int rr = 0; rr < 2; ++rr) { const int row = 2 * w + rr; topk_row(sc + row * 2048, ts + row + 1, bm + (8 * sb + row) * BMP, lane); }
        __syncthreads();
    }
    const int tq = t0 + r32;
    bf16x8 qf[4]; load_qf(H + (size_t)tq * HP + C_DSAQ + 64 * w, h, qf);
    float m = NEG_INF, l = 0.f; f32x16 o0, o1;
#pragma unroll
    for (int r = 0; r < 16; ++r) { o0[r] = 0.f; o1[r] = 0.f; }
    const int ntiles = ((t0 + 31) >> 6) + 1;
    for (int kt = 0; kt < ntiles; ++kt) {
        __syncthreads();
        stage_kv(H + (size_t)kt * 64 * HP + C_DSAK, H + (size_t)kt * 64 * HP + C_DSAV, HP, ksm, vsm);
        __syncthreads();
        f32x16 s0, s1; qk_tile(ksm, qf, r32, h, s0, s1);
        const unsigned w0 = bm[r32 * BMP + 2 * kt] >> (4 * h), w1 = bm[r32 * BMP + 2 * kt + 1] >> (4 * h);
#pragma unroll
        for (int r = 0; r < 16; ++r) { const int bit = (r & 3) + 8 * (r >> 2);
            s0[r] = ((w0 >> bit) & 1u) ? s0[r] : NEG_INF; s1[r] = ((w1 >> bit) & 1u) ? s1[r] : NEG_INF; }
        flash_update(s0, s1, m, l, o0, o1, vsm, lane);
    }
    l += __shfl_xor(l, 32);
    const float inv = l > 0.f ? 1.0f / l : 0.f;
#pragma unroll
    for (int r = 0; r < 16; ++r) { o0[r] *= inv; o1[r] *= inv; }
    write_mix(p, (size_t)b * S + tq, 64 * w, o0, o1, h);
    __syncthreads();
}

DEV void cmp_unit(const Params& p, int L, int kv, int b, int g, int cc, char* smem) {
    float* red = (float*)smem;
    float* hid = (float*)(smem + 32768);
    int tid_ = threadIdx.x; OPAQUE_V(tid_); const int tid = tid_, lane = tid & 63, w = tid >> 6, r32 = lane & 31, h = lane >> 5;
    const bf16_t* H = (const bf16_t*)(p.ws + WS_H) + (size_t)b * S * HP + (kv ? C_VC : C_KC) + 64 * g;
    const bf16_t* W1 = (const bf16_t*)(p.ws + WS_W1T) + (size_t)(L * 2 + kv) * 64 * 2048;
    const float* pe = p.cmp_pe + (size_t)(L * 2 + kv) * 32 * 64;
    int c = cc * 32 + r32; if (c > 126) c = 126;
    f32x16 acc[2];
#pragma unroll
    for (int r = 0; r < 16; ++r) { acc[0][r] = 0.f; acc[1][r] = 0.f; }
#pragma unroll 4
    for (int ks = w * 32; ks < w * 32 + 32; ++ks) {
        const int li = ks >> 2, d0 = (ks & 3) * 16 + 8 * h;
        const u32x4 raw = *(const u32x4*)(H + (size_t)(16 * c + li) * HP + d0);
        const f32x4 p0 = *(const f32x4*)(pe + li * 64 + d0), p1 = *(const f32x4*)(pe + li * 64 + d0 + 4);
        u32x4 t; t.x = cvt_pk(bf_lo(raw.x) + p0[0], bf_hi(raw.x) + p0[1]); t.y = cvt_pk(bf_lo(raw.y) + p0[2], bf_hi(raw.y) + p0[3]);
        t.z = cvt_pk(bf_lo(raw.z) + p1[0], bf_hi(raw.z) + p1[1]); t.w = cvt_pk(bf_lo(raw.w) + p1[2], bf_hi(raw.w) + p1[3]);
        const bf16x8 a = __builtin_bit_cast(bf16x8, t);
#pragma unroll
        for (int nt = 0; nt < 2; ++nt) { const bf16x8 bw = *(const bf16x8*)(W1 + (size_t)(32 * nt + r32) * 2048 + 16 * ks + 8 * h); acc[nt] = mfma(a, bw, acc[nt]); }
    }
#pragma unroll
    for (int nt = 0; nt < 2; ++nt)
#pragma unroll
        for (int r = 0; r < 16; ++r) red[(w * 32 + crow(r, h)) * 64 + 32 * nt + r32] = acc[nt][r];
    __syncthreads();
#pragma unroll
    for (int i = 0; i < 8; ++i) { const int e = tid + 256 * i; const float v = red[e] + red[2048 + e] + red[4096 + e] + red[6144 + e]; hid[e] = v / (1.0f + __expf(-v)); }
    __syncthreads();
    {
        const int cl = tid >> 3, n2 = (tid & 7) * 8; const float* w2 = p.cmp_w2 + (size_t)(L * 2 + kv) * 64 * 64;
        float o[8];
#pragma unroll
        for (int e = 0; e < 8; ++e) o[e] = 0.f;
        for (int n = 0; n < 64; ++n) { const float hv = hid[cl * 64 + n]; const f32x4 wa = *(const f32x4*)(w2 + n * 64 + n2), wb = *(const f32x4*)(w2 + n * 64 + n2 + 4);
#pragma unroll
            for (int e = 0; e < 4; ++e) { o[e] = fmaf(hv, wa[e], o[e]); o[4 + e] = fmaf(hv, wb[e], o[4 + e]); } }
        const int cg_ = cc * 32 + cl;
        if (cg_ >= 127) {
#pragma unroll
            for (int e = 0; e < 8; ++e) o[e] = 0.f; }
        bf16_t* dst = (bf16_t*)(p.ws + (kv ? WS_VC : WS_KC)) + ((size_t)(b * 2 + g) * 128 + cg_) * 64 + n2;
        *(u32x4*)dst = pack8(o);
    }
    __syncthreads();
}

constexpr int KC_BYTES = 128 * KP * 2;
DEV void nsa_unit(const Params& p, int b, int g, int qb, int j, char* smem) {
    char* kcs = smem;
    char* vcs = smem + KC_BYTES;
    char* ksm = smem + KC_BYTES + 16384;
    char* vsm = ksm + KT_BYTES;
    float* scr = (float*)(vsm + VT_BYTES);
    unsigned* uni = (unsigned*)(scr + 4 * 32 * 33);
    int tid_ = threadIdx.x; OPAQUE_V(tid_); const int tid = tid_, lane = tid & 63, w = tid >> 6, r32 = lane & 31, h = lane >> 5;
    const int q0 = qb * 128, tq = q0 + 32 * w + r32;
    const bf16_t* H = (const bf16_t*)(p.ws + WS_H) + (size_t)b * S * HP;
    {
        const bf16_t* kc = (const bf16_t*)(p.ws + WS_KC) + (size_t)(b * 2 + g) * 128 * 64;
        const bf16_t* vc = (const bf16_t*)(p.ws + WS_VC) + (size_t)(b * 2 + g) * 128 * 64;
#pragma unroll
        for (int i = 0; i < 4; ++i) { const int c = tid + 256 * i, row = c >> 3, ch = c & 7;
            *(u32x4*)(kcs + (row * KP + ch * 8) * 2) = *(const u32x4*)(kc + row * 64 + ch * 8);
            *(u32x4*)(vcs + (ch >> 2) * 8192 + row * 64 + (ch & 3) * 16) = *(const u32x4*)(vc + row * 64 + ch * 8); }
    }
    __syncthreads();
    const int clim_ = tq >= 31 ? ((tq - 31) >> 4) : -1;
    const int climh = (clim_ > 126 ? 126 : clim_) - 4 * h;
    float B4[16], E[16];
#pragma unroll
    for (int i = 0; i < 16; ++i) { B4[i] = 0.f; E[i] = 0.f; }
#pragma unroll 1
    for (int jj = 0; jj < 3; ++jj) {
        bf16x8 qf[4]; load_qf(H + (size_t)tq * HP + C_NSAQ + 64 * (3 * g + jj), h, qf);
        float mrun = NEG_INF, lrun = 0.f;
#pragma unroll
        for (int n = 0; n < 4; ++n) {
            f32x16 st = qk32(kcs + n * 32 * KP * 2, qf, r32, h);
            float mx = NEG_INF;
            int lim = climh; OPAQUE_V(lim);
#pragma unroll
            for (int r = 0; r < 16; ++r) { st[r] = (32 * n + CR(r)) <= lim ? st[r] : NEG_INF; mx = fmaxf(mx, st[r]); }
            const float mn = fmaxf(mrun, mx), mu = mn == NEG_INF ? 0.f : mn;
            float ps = 0.f;
#pragma unroll
            for (int r = 0; r < 16; ++r) ps += fexp2(st[r] - mu);
            lrun = fmaf(lrun, fexp2(mrun - mu), ps); mrun = mn;
            __builtin_amdgcn_sched_barrier(0);
        }
        const float mo = __shfl_xor(mrun, 32), lo = __shfl_xor(lrun, 32);
        const float M = fmaxf(mrun, mo), Mu = M == NEG_INF ? 0.f : M;
        const float Lt = lrun * fexp2(mrun - Mu) + lo * fexp2(mo - Mu);
        const float inv = 1.0f / fmaxf(Lt, 1e-30f);
#pragma unroll
        for (int n = 0; n < 4; ++n) {
            f32x16 st = qk32(kcs + n * 32 * KP * 2, qf, r32, h);
            int lim = climh; OPAQUE_V(lim);
#pragma unroll
            for (int a = 0; a < 4; ++a) {
                float pr[4];
#pragma unroll
                for (int k = 0; k < 4; ++k) pr[k] = (32 * n + 8 * a + k) <= lim ? fexp2(st[4 * a + k] - Mu) * inv : 0.f;
                B4[4 * n + a] += (pr[0] + pr[1]) + (pr[2] + pr[3]); E[4 * n + a] += pr[3];
            }
            __builtin_amdgcn_sched_barrier(0);
        }
    }
    {
        float* my = scr + (w * 32 + r32) * 33;
#pragma unroll
        for (int i = 0; i < 16; ++i) { const float eo = __shfl_xor(E[i], 32); E[i] = eo; }
#pragma unroll
        for (int i = 0; i < 16; ++i) { const float prev = h ? E[i] : (i > 0 ? E[i - 1] : 0.f); my[2 * i + h] = B4[i] + prev; }
    }
    __builtin_amdgcn_wave_barrier();
    unsigned sel;
    {
        const float* my = scr + (w * 32 + r32) * 33; const int cur = tq >> 6;
        float v[32];
#pragma unroll
        for (int n = 0; n < 32; ++n) { float s_ = my[n]; const bool forced = (n == 0) || (n == cur) || (n == cur - 1); const bool fut = 64 * n > tq;
            v[n] = forced ? __builtin_huge_valf() : (fut ? NEG_INF : s_); }
        unsigned mk = 0u;
#pragma unroll
        for (int i = 0; i < 32; ++i) {
            int rank = 0;
#pragma unroll
            for (int n = 0; n < 32; ++n) { if (n < i) rank += (v[n] >= v[i]) ? 1 : 0; else if (n > i) rank += (v[n] > v[i]) ? 1 : 0; }
            if (rank < 16 && 64 * i <= tq) mk |= 1u << i;
        }
        sel = mk;
    }
    unsigned wsel = sel;
#pragma unroll
    for (int o = 16; o >= 1; o >>= 1) wsel |= __shfl_xor(wsel, o);
    if (lane == 0) uni[w] = wsel;
    __syncthreads();
    const unsigned bsel = uni[0] | uni[1] | uni[2] | uni[3];
    const float* gs = (const float*)(p.ws + WS_GSIG) + ((size_t)b * S + tq) * 20;
    const float g0 = gs[0 * 6 + g * 3 + j], g1 = gs[1 * 6 + g * 3 + j], g2 = gs[2 * 6 + g * 3 + j];
    f32x16 ot0, ot1;
    {
        bf16x8 qf[4]; load_qf(H + (size_t)tq * HP + C_NSAQ + 64 * (3 * g + j), h, qf);
        float m = NEG_INF, l = 0.f; f32x16 o0, o1;
#pragma unroll
        for (int r = 0; r < 16; ++r) { o0[r] = 0.f; o1[r] = 0.f; }
#pragma unroll 1
        for (int n = 0; n < 4; ++n) {
            f32x16 st = qk32(kcs + n * 32 * KP * 2, qf, r32, h);
            int lim = climh - 32 * n; OPAQUE_V(lim);
#pragma unroll
            for (int r = 0; r < 16; ++r) st[r] = CR(r) <= lim ? st[r] : NEG_INF;
            flash_update32(st, m, l, o0, o1, vcs, 32 * n, 8192, lane);
        }
        l += __shfl_xor(l, 32);
        const float sc_ = l > 0.f ? g0 / l : 0.f;
#pragma unroll
        for (int r = 0; r < 16; ++r) { ot0[r] = o0[r] * sc_; ot1[r] = o1[r] * sc_; }
    }
    bf16x8 qr[4]; load_qf((const bf16_t*)(p.ws + WS_QROT) + ((size_t)b * S + tq) * 384 + 64 * (3 * g + j), h, qr);
    {
        float m = NEG_INF, l = 0.f; f32x16 o0, o1;
#pragma unroll
        for (int r = 0; r < 16; ++r) { o0[r] = 0.f; o1[r] = 0.f; }
        const int nlast = (q0 + 127) >> 6;
        for (int nb = 0; nb <= nlast; ++nb) {
            if (!((bsel >> nb) & 1u)) continue;
            __syncthreads();
            stage_kv(H + (size_t)nb * 64 * HP + C_KS + 64 * g, H + (size_t)nb * 64 * HP + C_VS + 64 * g, HP, ksm, vsm);
            __syncthreads();
            if ((wsel >> nb) & 1u) {
                f32x16 s0, s1; qk_tile(ksm, qr, r32, h, s0, s1);
                int lim = ((sel >> nb) & 1u) ? tq - 64 * nb - 4 * h : -1; OPAQUE_V(lim);
#pragma unroll
                for (int r = 0; r < 16; ++r) { s0[r] = CR(r) <= lim ? s0[r] : NEG_INF; s1[r] = (CR(r) + 32) <= lim ? s1[r] : NEG_INF; }
                flash_update(s0, s1, m, l, o0, o1, vsm, lane);
            }
        }
        l += __shfl_xor(l, 32);
        const float sc_ = l > 0.f ? g1 / l : 0.f;
#pragma unroll
        for (int r = 0; r < 16; ++r) { ot0[r] = fmaf(o0[r], sc_, ot0[r]); ot1[r] = fmaf(o1[r], sc_, ot1[r]); }
    }
    {
        float m = NEG_INF, l = 0.f; f32x16 o0, o1;
#pragma unroll
        for (int r = 0; r < 16; ++r) { o0[r] = 0.f; o1[r] = 0.f; }
        const int kfirst = q0 >= 512 ? (q0 - 512) >> 6 : 0, klast = (q0 + 127) >> 6;
        const int wt0 = q0 + 32 * w;
        const int wfirst = wt0 >= 511 ? (wt0 - 511) >> 6 : 0, wlast = (wt0 + 31) >> 6;
        for (int kt = kfirst; kt <= klast; ++kt) {
            __syncthreads();
            stage_kv(H + (size_t)kt * 64 * HP + C_KW + 64 * g, H + (size_t)kt * 64 * HP + C_VW + 64 * g, HP, ksm, vsm);
            __syncthreads();
            if (kt >= wfirst && kt <= wlast) {
                f32x16 s0, s1; qk_tile(ksm, qr, r32, h, s0, s1);
                int lim = tq - 64 * kt - 4 * h; OPAQUE_V(lim);
#pragma unroll
                for (int r = 0; r < 16; ++r) { s0[r] = (unsigned)(lim - CR(r)) < 512u ? s0[r] : NEG_INF; s1[r] = (unsigned)(lim - CR(r) - 32) < 512u ? s1[r] : NEG_INF; }
                flash_update(s0, s1, m, l, o0, o1, vsm, lane);
            }
        }
        l += __shfl_xor(l, 32);
        const float sc_ = l > 0.f ? g2 / l : 0.f;
#pragma unroll
        for (int r = 0; r < 16; ++r) { ot0[r] = fmaf(o0[r], sc_, ot0[r]); ot1[r] = fmaf(o1[r], sc_, ot1[r]); }
    }
    write_mix(p, (size_t)b * S + tq, 640 + 64 * (3 * g + j), ot0, ot1, h);
    __syncthreads();
}

DEV void phase_mid(const Params& p, int L, char* smem) {
    constexpr int N_DSA = 512, N_FOX = 768, N_CMP = 128;
    for (int u = blockIdx.x; u < N_DSA + N_FOX + N_CMP; u += gridDim.x) {
        int v = u;
        if (v < N_DSA) { const int qb = 63 - (v >> 3), b = v & 7; dsa_unit(p, b, qb, smem); continue; }
        v -= N_DSA;
        if (v < N_FOX) { const int qb = 15 - v / 48, r = v % 48, b = r / 6, hh = r % 6; fox_unit(p, b, hh, qb, smem); continue; }
        v -= N_FOX;
        { const int kv = v & 1, g = (v >> 1) & 1, cc = (v >> 2) & 3, b = v >> 4; cmp_unit(p, L, kv, b, g, cc, smem); }
    }
}
DEV void phase_nsa(const Params& p, char* smem) {
    for (int u = blockIdx.x; u < 768; u += gridDim.x) {
        const int qb = 15 - u / 48, r = u % 48, b = r / 6, g = (r % 6) / 3, j = r % 3;
        nsa_unit(p, b, g, qb, j, smem);
    }
}
#ifndef PHASE_MASK
#define PHASE_MASK 0xffff
#endif
DEV void run_phase(const Params& p, int ph, char* smem) {
    if (ph == 0) { if (PHASE_MASK & 1) phase_prep(p, smem); return; }
    if (ph == 1) { if (PHASE_MASK & 2) phase_u1(p); return; }
    const int L = (ph - 2) / 5, k = (ph - 2) % 5;
    if (k == 0) { if (PHASE_MASK & 4) phase_gemm_in(p, L, smem); }
    else if (k == 1) { if (PHASE_MASK & 8) phase_mid(p, L, smem); }
    else if (k == 2) { if (PHASE_MASK & 16) phase_nsa(p, smem); }
    else if (k == 3) { if (PHASE_MASK & 32) phase_out(p, L, smem); }
    else { if (PHASE_MASK & 64) phase_ln(p, L); }
}
constexpr int N_PHASES = 12;

template <bool COOP>
__global__ void __launch_bounds__(256, 2) mega(Params p, int ph_lo, int ph_hi) {
    extern __shared__ __attribute__((aligned(16))) char smem[];
    for (int ph = ph_lo; ph < ph_hi; ++ph) {
        run_phase(p, ph, smem);
        if (COOP) { if (ph + 1 < ph_hi) cg::this_grid().sync(); }
    }
}

#ifndef N_LAUNCH_MODE
#define N_LAUNCH_MODE 1
#endif

extern "C" void kernel_launch(void* const* d_in, const int* in_sizes, int n_in, void* d_out, int out_size, void* d_ws, size_t ws_size, hipStream_t stream) {
    static int grid = 0;
    if (grid == 0) {
        int dev = 0, cus = 0, per_cu = 0;
        hipGetDevice(&dev);
        hipDeviceGetAttribute(&cus, hipDeviceAttributeMultiprocessorCount, dev);
        hipFuncSetAttribute((const void*)mega<true>, hipFuncAttributeMaxDynamicSharedMemorySize, SMEM_BYTES);
        hipFuncSetAttribute((const void*)mega<false>, hipFuncAttributeMaxDynamicSharedMemorySize, SMEM_BYTES);
        hipOccupancyMaxActiveBlocksPerMultiprocessor(&per_cu, (const void*)mega<true>, 256, SMEM_BYTES);
        if (per_cu < 1) per_cu = 1;
        if (per_cu > 2) per_cu = 2;
        grid = cus * per_cu;
        if (ws_size < WS_END) { fprintf(stderr, "workspace too small: %zu < %zu\n", ws_size, (size_t)WS_END); grid = -1; }
    }
    if (grid < 0) return;
    Params p{};
    p.x = (const float*)d_in[0]; p.c = (const float*)d_in[1]; p.w_ada = (const float*)d_in[2]; p.b_ada = (const float*)d_in[3];
    p.w_in = (const float*)d_in[4]; p.b_f = (const float*)d_in[5]; p.cmp_pe = (const float*)d_in[6]; p.cmp_w1 = (const float*)d_in[7];
    p.cmp_w2 = (const float*)d_in[8]; p.w_out = (const float*)d_in[9]; p.ln_g = (const float*)d_in[10]; p.ln_b = (const float*)d_in[11];
    p.out = (float*)d_out; p.ws = (char*)d_ws;
#if N_LAUNCH_MODE == 1
    int lo = 0, hi = N_PHASES;
    void* args[] = {&p, &lo, &hi};
    hipError_t e = hipLaunchCooperativeKernel((const void*)mega<true>, dim3(grid), dim3(256), args, SMEM_BYTES, stream);
    if (e != hipSuccess) fprintf(stderr, "cooperative launch failed: %s (grid %d)\n", hipGetErrorString(e), grid);
#else
    for (int ph = 0; ph < N_PHASES; ++ph) hipLaunchKernelGGL(mega<false>, dim3(grid), dim3(256), SMEM_BYTES, stream, p, ph, ph + 1);
#endif
}
```

```cpp
#include <hip/hip_runtime.h>
#include <hip/hip_cooperative_groups.h>
#include <stdint.h>
#include <stdio.h>
namespace cg = cooperative_groups;

#define DEV __device__ __forceinline__
typedef unsigned short bf16_t;
typedef short bf16x8 __attribute__((ext_vector_type(8)));
typedef short s16x4 __attribute__((ext_vector_type(4)));
typedef float f32x16 __attribute__((ext_vector_type(16)));
typedef float f32x4 __attribute__((ext_vector_type(4)));
typedef float f32x2 __attribute__((ext_vector_type(2)));
typedef unsigned u32x4 __attribute__((ext_vector_type(4)));
typedef unsigned u32x2 __attribute__((ext_vector_type(2)));
typedef short v4i16_t __attribute__((ext_vector_type(4)));
#define LDSAS __attribute__((address_space(3)))

constexpr int NB = 8, S = 2048, DM = 1024, NTOK = NB * S, HP = 4096;
constexpr int C_DSAQ = 0, C_DSAK = 256, C_DSAV = 320, C_IDXQ = 384, C_IDXK = 640, C_MISC = 672, C_FOXQ = 704, C_FOXK = 1088, C_FOXV = 1472,
              C_NSAQ = 1856, C_KC = 2240, C_VC = 2368, C_KS = 2496, C_VS = 2624, C_KW = 2752, C_VW = 2880, C_GATE = 3008;
constexpr float LOG2E = 1.4426950408889634f;
constexpr float QS = 0.125f * LOG2E;
constexpr float ALPHA = 1.4142135623730951f;
constexpr float NEG_INF = -__builtin_huge_valf();

constexpr size_t WS_CTRL = 0;
constexpr size_t WS_MOD = 16384;
constexpr size_t WS_CS64 = WS_MOD + 2 * 8 * 3072 * 4;
constexpr size_t WS_CS32 = WS_CS64 + 2048 * 32 * 8;
constexpr size_t WS_WINT = WS_CS32 + 2048 * 16 * 8;
constexpr size_t WS_WOUTT = WS_WINT + (size_t)2 * 4096 * 1024 * 2;
constexpr size_t WS_W1T = WS_WOUTT + (size_t)2 * 1024 * 1024 * 2;
constexpr size_t WS_U = WS_W1T + (size_t)2 * 2 * 64 * 2048 * 2;
constexpr size_t WS_MIX = WS_U + (size_t)NTOK * 1024 * 2;
constexpr size_t WS_QROT = WS_MIX + (size_t)NTOK * 1024 * 2;
constexpr size_t WS_IW = WS_QROT + (size_t)NTOK * 384 * 2;
constexpr size_t WS_GSIG = WS_IW + (size_t)NTOK * 8 * 4;
constexpr size_t WS_LOGF = WS_GSIG + (size_t)NTOK * 20 * 4;
constexpr size_t WS_KC = WS_LOGF + (size_t)8 * 6 * 2048 * 4;
constexpr size_t WS_VC = WS_KC + (size_t)8 * 2 * 128 * 64 * 2;
constexpr size_t WS_H = WS_VC + (size_t)8 * 2 * 128 * 64 * 2;
constexpr size_t WS_END = WS_H + (size_t)NTOK * HP * 2;
static_assert(WS_END <= (size_t)256 * 1024 * 1024, "workspace");

constexpr int SMEM_BYTES = 75776;

struct Params {
    const float *x, *c, *w_ada, *b_ada, *w_in, *b_f, *cmp_pe, *cmp_w1, *cmp_w2, *w_out, *ln_g, *ln_b;
    float* out; char* ws;
};

#define OPAQUE_V(x) asm volatile("" : "+v"(x))
#define CR(r) (((r) & 3) + 8 * ((r) >> 2))
DEV int crow(int r, int h) { return (r & 3) + 8 * (r >> 2) + 4 * h; }
typedef __bf16 bf16x2_t __attribute__((ext_vector_type(2)));
DEV unsigned cvt_pk(float lo, float hi) { const f32x2 v = {lo, hi}; return __builtin_bit_cast(unsigned, __builtin_convertvector(v, bf16x2_t)); }
DEV float bf_lo(unsigned v) { return __uint_as_float(v << 16); }
DEV float bf_hi(unsigned v) { return __uint_as_float(v & 0xffff0000u); }
DEV f32x16 mfma(bf16x8 a, bf16x8 b, f32x16 c) { return __builtin_amdgcn_mfma_f32_32x32x16_bf16(a, b, c, 0, 0, 0); }
DEV float fexp2(float x) { return __builtin_amdgcn_exp2f(x); }
DEV s16x4 vtr(const char* p) { return __builtin_bit_cast(s16x4, __builtin_amdgcn_ds_read_tr16_b64_v4i16((LDSAS v4i16_t*)p)); }
DEV bf16x8 cat4(s16x4 a, s16x4 b) { bf16x8 r; r[0] = a[0]; r[1] = a[1]; r[2] = a[2]; r[3] = a[3]; r[4] = b[0]; r[5] = b[1]; r[6] = b[2]; r[7] = b[3]; return r; }
DEV u32x4 pack8(const float* v) { u32x4 r; r.x = cvt_pk(v[0], v[1]); r.y = cvt_pk(v[2], v[3]); r.z = cvt_pk(v[4], v[5]); r.w = cvt_pk(v[6], v[7]); return r; }
DEV float sigmoidf_(float v) { return 1.0f / (1.0f + __expf(-v)); }

DEV void sincos_acc(float a, float& sn, float& cs) {
    const float q = rintf(a * 0.6366197723675814f);
    float y = fmaf(-q, 1.5703125f, a); y = fmaf(-q, 4.837512969970703125e-4f, y); y = fmaf(-q, 7.54978995489188216e-8f, y);
    const float z = y * y;
    const float sp = y + y * z * (-1.6666654611e-1f + z * (8.3321608736e-3f + z * (-1.9515295891e-4f)));
    const float cp = 1.0f + z * (-0.5f + z * (4.166664568298827e-2f + z * (-1.388731625493765e-3f + z * 2.443315711809948e-5f)));
    const int qi = ((int)q) & 3;
    sn = (qi == 0) ? sp : (qi == 1) ? cp : (qi == 2) ? -sp : -cp;
    cs = (qi == 0) ? cp : (qi == 1) ? -sp : (qi == 2) ? -cp : sp;
}

DEV int win_srccol(int n) {
    if (n < 672) return n;
    if (n < 704) { const int j = n - 672; return j < 8 ? 672 + j : (j < 14 ? 1832 + (j - 8) : 2990 + (j - 14)); }
    if (n < 1856) return 680 + (n - 704);
    if (n < 3008) return 1838 + (n - 1856);
    if (n < 4032) return n;
    return -1;
}
DEV void transpose_unit(const float* __restrict__ src, int ldsrc, bf16_t* __restrict__ dst, int K, int n0, int k0, bool winmap, char* smem) {
    float* t = (float*)smem;
    int tid_ = threadIdx.x; OPAQUE_V(tid_); const int tid = tid_;
    {
        const int nn = tid & 63, n = n0 + nn; const int sc = winmap ? win_srccol(n) : n;
#pragma unroll
        for (int i = 0; i < 16; ++i) { const int kk = (tid >> 6) + 4 * i; t[kk * 65 + nn] = sc >= 0 ? src[(size_t)(k0 + kk) * ldsrc + sc] : 0.f; }
    }
    __syncthreads();
    {
        const int nn = tid >> 2, kq = tid & 3; float v[16];
#pragma unroll
        for (int j = 0; j < 16; ++j) v[j] = t[(kq * 16 + j) * 65 + nn];
        u32x4* d = (u32x4*)(dst + (size_t)(n0 + nn) * K + k0 + kq * 16);
        d[0] = pack8(v); d[1] = pack8(v + 8);
    }
    __syncthreads();
}
DEV void mod_unit(const Params& p, int L, int cgi, char* smem) {
    float* cs = (float*)smem;
    float* red = (float*)(smem + 32768);
    int tid_ = threadIdx.x; OPAQUE_V(tid_); const int tid = tid_;
#pragma unroll
    for (int i = 0; i < 32; ++i) cs[tid + 256 * i] = p.c[tid + 256 * i];
    __syncthreads();
    const int cc = tid & 31, kk = tid >> 5, col = cgi * 32 + cc;
    float acc[8];
#pragma unroll
    for (int b = 0; b < 8; ++b) acc[b] = 0.f;
    const float* w = p.w_ada + ((size_t)L * 1024 + kk * 128) * 3072 + col;
#pragma unroll 8
    for (int k = 0; k < 128; ++k) {
        const float wv = w[(size_t)k * 3072];
#pragma unroll
        for (int b = 0; b < 8; ++b) acc[b] = fmaf(cs[b * 1024 + kk * 128 + k], wv, acc[b]);
    }
#pragma unroll
    for (int b = 0; b < 8; ++b) red[(kk * 8 + b) * 32 + cc] = acc[b];
    __syncthreads();
    {
        const int b = tid >> 5; float s = p.b_ada[L * 3072 + col];
#pragma unroll
        for (int k2 = 0; k2 < 8; ++k2) s += red[(k2 * 8 + b) * 32 + cc];
        ((float*)(p.ws + WS_MOD))[(L * 8 + b) * 3072 + col] = s;
    }
    __syncthreads();
}
DEV void phase_prep(const Params& p, char* smem) {
    constexpr int N_MOD = 192, N_TAB = 384, N_WIN = 2048, N_WOUT = 512, N_W1 = 128;
    constexpr int TOT = N_MOD + N_TAB + N_WIN + N_WOUT + N_W1;
    for (int u = blockIdx.x; u < TOT; u += gridDim.x) {
        int v = u;
        if (v < N_MOD) { mod_unit(p, v / 96, v % 96, smem); continue; }
        v -= N_MOD;
        if (v < N_TAB) {
            int tx_ = threadIdx.x; OPAQUE_V(tx_); const int idx = v * 256 + tx_;
            if (idx < 65536) {
                const int pos = idx >> 5, i = idx & 31; const float inv = powf(10000.0f, -(float)i / 32.0f);
                float sn, cs; sincos_acc((float)pos * inv, sn, cs);
                ((f32x2*)(p.ws + WS_CS64))[idx] = (f32x2){cs, sn};
            } else {
                const int id2 = idx - 65536; const int pos = id2 >> 4, i = id2 & 15; const float inv = powf(10000.0f, -(float)i / 16.0f);
                float sn, cs; sincos_acc((float)pos * inv, sn, cs);
                ((f32x2*)(p.ws + WS_CS32))[id2] = (f32x2){cs, sn};
            }
            continue;
        }
        v -= N_TAB;
        if (v < N_WIN) { const int L = v >> 10, r = v & 1023, nt = r >> 4, kt = r & 15;
            transpose_unit(p.w_in + (size_t)L * 1024 * 4032, 4032, (bf16_t*)(p.ws + WS_WINT) + (size_t)L * 4096 * 1024, 1024, nt * 64, kt * 64, true, smem); continue; }
        v -= N_WIN;
        if (v < N_WOUT) { const int L = v >> 8, r = v & 255, nt = r >> 4, kt = r & 15;
            transpose_unit(p.w_out + (size_t)L * 1024 * 1024, 1024, (bf16_t*)(p.ws + WS_WOUTT) + (size_t)L * 1024 * 1024, 1024, nt * 64, kt * 64, false, smem); continue; }
        v -= N_WOUT;
        { const int lk = v >> 5, kt = v & 31;
            transpose_unit(p.cmp_w1 + (size_t)lk * 2048 * 64, 64, (bf16_t*)(p.ws + WS_W1T) + (size_t)lk * 64 * 2048, 2048, 0, kt * 64, false, smem); }
    }
}

DEV void phase_u1(const Params& p) {
    const float* mod = (const float*)(p.ws + WS_MOD);
    bf16_t* U = (bf16_t*)(p.ws + WS_U);
    for (int u = blockIdx.x; u < 2048; u += gridDim.x) {
        int tx_ = threadIdx.x; OPAQUE_V(tx_);
#pragma unroll
        for (int i = 0; i < 4; ++i) {
            const int e = tx_ + 256 * i, row = 8 * u + (e >> 7), c8 = (e & 127) * 8, b = row >> 11;
            const f32x4* xp = (const f32x4*)(p.x + (size_t)row * 1024 + c8);
            const f32x4* sh = (const f32x4*)(mod + (size_t)b * 3072 + c8);
            const f32x4* sc = (const f32x4*)(mod + (size_t)b * 3072 + 1024 + c8);
            float v[8];
#pragma unroll
            for (int q = 0; q < 2; ++q) { const f32x4 xv = xp[q], s1 = sc[q], s0 = sh[q];
#pragma unroll
                for (int k = 0; k < 4; ++k) v[4 * q + k] = fmaf(xv[k], 1.0f + s1[k], s0[k]); }
            *(u32x4*)(U + (size_t)row * 1024 + c8) = pack8(v);
        }
    }
}

constexpr int KP = 72, CTP = 132;
DEV void gemm_tile(const bf16_t* __restrict__ X, const bf16_t* __restrict__ W, int K, int m0, int n0, char* smem) {
    bf16_t* Xs = (bf16_t*)smem; bf16_t* Ws = Xs + 128 * KP;
    int tid_ = threadIdx.x; OPAQUE_V(tid_); const int tid = tid_, lane = tid & 63, w = tid >> 6, wm = w >> 1, wn = w & 1, r32 = lane & 31, h = lane >> 5;
    const bf16_t* xg = X + (size_t)(m0 + (tid >> 3)) * K + (tid & 7) * 8;
    const bf16_t* wg = W + (size_t)(n0 + (tid >> 3)) * K + (tid & 7) * 8;
    u32x4 xr[4], wr[4];
#pragma unroll
    for (int i = 0; i < 4; ++i) { xr[i] = *(const u32x4*)(xg + (size_t)i * 32 * K); wr[i] = *(const u32x4*)(wg + (size_t)i * 32 * K); }
    f32x16 acc[2][2];
#pragma unroll
    for (int i = 0; i < 2; ++i)
#pragma unroll
        for (int j = 0; j < 2; ++j)
#pragma unroll
            for (int r = 0; r < 16; ++r) acc[i][j][r] = 0.f;
    const int nk = K / 64;
    for (int kt = 0; kt < nk; ++kt) {
        __syncthreads();
#pragma unroll
        for (int i = 0; i < 4; ++i) { *(u32x4*)(Xs + ((tid >> 3) + 32 * i) * KP + (tid & 7) * 8) = xr[i]; *(u32x4*)(Ws + ((tid >> 3) + 32 * i) * KP + (tid & 7) * 8) = wr[i]; }
        __syncthreads();
        if (kt + 1 < nk) {
#pragma unroll
            for (int i = 0; i < 4; ++i) { xr[i] = *(const u32x4*)(xg + (size_t)i * 32 * K + (kt + 1) * 64); wr[i] = *(const u32x4*)(wg + (size_t)i * 32 * K + (kt + 1) * 64); }
        }
#pragma unroll
        for (int s = 0; s < 4; ++s) {
            bf16x8 a[2], b[2];
#pragma unroll
            for (int i = 0; i < 2; ++i) { a[i] = *(const bf16x8*)(Ws + (wm * 64 + 32 * i + r32) * KP + 16 * s + 8 * h); b[i] = *(const bf16x8*)(Xs + (wn * 64 + 32 * i + r32) * KP + 16 * s + 8 * h); }
#pragma unroll
            for (int i = 0; i < 2; ++i)
#pragma unroll
                for (int j = 0; j < 2; ++j) acc[i][j] = mfma(a[i], b[j], acc[i][j]);
        }
    }
    __syncthreads();
    float* Ct = (float*)smem;
#pragma unroll
    for (int i = 0; i < 2; ++i)
#pragma unroll
        for (int j = 0; j < 2; ++j)
#pragma unroll
            for (int a = 0; a < 4; ++a) {
                f32x4 v = {acc[i][j][4 * a], acc[i][j][4 * a + 1], acc[i][j][4 * a + 2], acc[i][j][4 * a + 3]};
                *(f32x4*)(Ct + (wn * 64 + 32 * j + r32) * CTP + wm * 64 + 32 * i + 8 * a + 4 * h) = v;
            }
    __syncthreads();
}

DEV void ld8(const float* Ct, int row, int col, float* v) { const f32x4 a = *(const f32x4*)(Ct + row * CTP + col), b = *(const f32x4*)(Ct + row * CTP + col + 4);
    v[0] = a[0]; v[1] = a[1]; v[2] = a[2]; v[3] = a[3]; v[4] = b[0]; v[5] = b[1]; v[6] = b[2]; v[7] = b[3]; }
DEV void epi_in_chunk(const Params& p, int L, const float* Ct, int m0, int c64, int lc) {
    bf16_t* H = (bf16_t*)(p.ws + WS_H);
    int tid_ = threadIdx.x; OPAQUE_V(tid_); const int tid = tid_, j = tid & 3;
    if (c64 == 63) return;
#pragma unroll
    for (int it = 0; it < 2; ++it) {
        const int row = (tid >> 2) + 64 * it, token = m0 + row, pos = token & 2047, b = token >> 11;
        bf16_t* hrow = H + (size_t)token * HP + c64 * 64;
        float xa[8], xb[8], oa[8], ob[8];
        if (c64 <= 4 || (c64 >= 29 && c64 <= 34) || c64 == 39 || c64 == 40 || c64 == 43 || c64 == 44) {
            const bool isq = (c64 <= 3) || (c64 >= 29 && c64 <= 34); const float sc = isq ? QS : 1.0f;
            ld8(Ct, row, lc + 8 * j, xa); ld8(Ct, row, lc + 32 + 8 * j, xb);
            const f32x4* cp = (const f32x4*)((const f32x2*)(p.ws + WS_CS64) + pos * 32 + 8 * j);
#pragma unroll
            for (int q = 0; q < 4; ++q) { const f32x4 cv = cp[q];
                oa[2 * q] = (xa[2 * q] * cv[0] - xb[2 * q] * cv[1]) * sc; ob[2 * q] = (xa[2 * q] * cv[1] + xb[2 * q] * cv[0]) * sc;
                oa[2 * q + 1] = (xa[2 * q + 1] * cv[2] - xb[2 * q + 1] * cv[3]) * sc; ob[2 * q + 1] = (xa[2 * q + 1] * cv[3] + xb[2 * q + 1] * cv[2]) * sc; }
            if (c64 >= 29 && c64 <= 34) {
                bf16_t* qr = (bf16_t*)(p.ws + WS_QROT) + (size_t)token * 384 + (c64 - 29) * 64;
                *(u32x4*)(qr + 8 * j) = pack8(oa); *(u32x4*)(qr + 32 + 8 * j) = pack8(ob);
#pragma unroll
                for (int e = 0; e < 8; ++e) { oa[e] = xa[e] * sc; ob[e] = xb[e] * sc; }
            }
            *(u32x4*)(hrow + 8 * j) = pack8(oa); *(u32x4*)(hrow + 32 + 8 * j) = pack8(ob);
        } else if (c64 >= 6 && c64 <= 9) {
            const int hh = j >> 1, part = j & 1, ca = 32 * hh + 8 * part;
            ld8(Ct, row, lc + ca, xa); ld8(Ct, row, lc + ca + 16, xb);
            const f32x4* cp = (const f32x4*)((const f32x2*)(p.ws + WS_CS32) + pos * 16 + 8 * part);
#pragma unroll
            for (int q = 0; q < 4; ++q) { const f32x4 cv = cp[q];
                oa[2 * q] = xa[2 * q] * cv[0] - xb[2 * q] * cv[1]; ob[2 * q] = xa[2 * q] * cv[1] + xb[2 * q] * cv[0];
                oa[2 * q + 1] = xa[2 * q + 1] * cv[2] - xb[2 * q + 1] * cv[3]; ob[2 * q + 1] = xa[2 * q + 1] * cv[3] + xb[2 * q + 1] * cv[2]; }
            *(u32x4*)(hrow + ca) = pack8(oa); *(u32x4*)(hrow + ca + 16) = pack8(ob);
        } else if (c64 == 10) {
            if (j < 2) {
                ld8(Ct, row, lc + 8 * j, xa); ld8(Ct, row, lc + 16 + 8 * j, xb);
                const f32x4* cp = (const f32x4*)((const f32x2*)(p.ws + WS_CS32) + pos * 16 + 8 * j);
#pragma unroll
                for (int q = 0; q < 4; ++q) { const f32x4 cv = cp[q];
                    oa[2 * q] = xa[2 * q] * cv[0] - xb[2 * q] * cv[1]; ob[2 * q] = xa[2 * q] * cv[1] + xb[2 * q] * cv[0];
                    oa[2 * q + 1] = xa[2 * q + 1] * cv[2] - xb[2 * q + 1] * cv[3]; ob[2 * q + 1] = xa[2 * q + 1] * cv[3] + xb[2 * q + 1] * cv[2]; }
                *(u32x4*)(hrow + 8 * j) = pack8(oa); *(u32x4*)(hrow + 16 + 8 * j) = pack8(ob);
            } else if (j == 2) {
                ld8(Ct, row, lc + 32, xa);
                float* iw = (float*)(p.ws + WS_IW) + (size_t)token * 8;
                *(f32x4*)iw = (f32x4){xa[0], xa[1], xa[2], xa[3]} * 0.35355339059327373f; *(f32x4*)(iw + 4) = (f32x4){xa[4], xa[5], xa[6], xa[7]} * 0.35355339059327373f;
            } else {
                float* lf = (float*)(p.ws + WS_LOGF); float* gs = (float*)(p.ws + WS_GSIG) + (size_t)token * 20;
#pragma unroll
                for (int e = 0; e < 6; ++e) { const float v = Ct[row * CTP + lc + 40 + e] + p.b_f[L * 6 + e];
                    lf[((size_t)b * 6 + e) * 2048 + pos] = fminf(v, 0.f) - log1pf(expf(-fabsf(v))); }
#pragma unroll
                for (int e = 0; e < 18; ++e) gs[e] = 1.0f / (1.0f + expf(-Ct[row * CTP + lc + 46 + e]));
            }
        } else {
            const bool isq = (c64 >= 11 && c64 <= 16); const bool silu = c64 >= 47; const float sc = isq ? QS : 1.0f;
            ld8(Ct, row, lc + 8 * j, xa); ld8(Ct, row, lc + 32 + 8 * j, xb);
#pragma unroll
            for (int e = 0; e < 8; ++e) {
                float a = xa[e] * sc, bb = xb[e] * sc;
                if (silu) { a = a / (1.0f + __expf(-a)); bb = bb / (1.0f + __expf(-bb)); }
                oa[e] = a; ob[e] = bb;
            }
            *(u32x4*)(hrow + 8 * j) = pack8(oa); *(u32x4*)(hrow + 32 + 8 * j) = pack8(ob);
        }
    }
}
DEV void phase_gemm_in(const Params& p, int L, char* smem) {
    const bf16_t* U = (const bf16_t*)(p.ws + WS_U);
    const bf16_t* W = (const bf16_t*)(p.ws + WS_WINT) + (size_t)L * 4096 * 1024;
    for (int u = blockIdx.x; u < 4096; u += gridDim.x) {
        const int mt = u >> 5, nt = u & 31;
        gemm_tile(U, W, 1024, mt * 128, nt * 128, smem);
        epi_in_chunk(p, L, (const float*)smem, mt * 128, nt * 2, 0);
        epi_in_chunk(p, L, (const float*)smem, mt * 128, nt * 2 + 1, 64);
        __syncthreads();
    }
}
DEV void phase_out(const Params& p, int L, char* smem) {
    const bf16_t* A = (const bf16_t*)(p.ws + WS_MIX);
    const bf16_t* W = (const bf16_t*)(p.ws + WS_WOUTT) + (size_t)L * 1024 * 1024;
    const float* xin = L == 0 ? p.x : p.out;
    float* Z = (float*)(p.ws + WS_H);
    const float* mod = (const float*)(p.ws + WS_MOD) + (size_t)L * 8 * 3072;
    for (int u = blockIdx.x; u < 1024; u += gridDim.x) {
        const int mt = u >> 3, nt = u & 7, m0 = mt * 128, n0 = nt * 128;
        gemm_tile(A, W, 1024, m0, n0, smem);
        const float* Ct = (const float*)smem;
        int tx_ = threadIdx.x; OPAQUE_V(tx_);
#pragma unroll
        for (int i = 0; i < 16; ++i) {
            const int item = tx_ + 256 * i, row = item >> 5, c4 = (item & 31) * 4, token = m0 + row, b = token >> 11;
            const f32x4 y = *(const f32x4*)(Ct + row * CTP + c4);
            const f32x4 xv = *(const f32x4*)(xin + (size_t)token * 1024 + n0 + c4);
            const f32x4 g = *(const f32x4*)(mod + (size_t)b * 3072 + 2048 + n0 + c4);
            f32x4 z;
#pragma unroll
            for (int k = 0; k < 4; ++k) z[k] = fmaf(1.0f + g[k], y[k], ALPHA * xv[k]);
            *(f32x4*)(Z + (size_t)token * 1024 + n0 + c4) = z;
        }
        __syncthreads();
    }
}
DEV void phase_ln(const Params& p, int L) {
    const float* Z = (const float*)(p.ws + WS_H);
    const float* mod = (const float*)(p.ws + WS_MOD) + (size_t)8 * 3072;
    bf16_t* U = (bf16_t*)(p.ws + WS_U);
    for (int u = blockIdx.x; u < 1024; u += gridDim.x) {
        int tx_ = threadIdx.x; OPAQUE_V(tx_);
        const int lane = tx_ & 63, w = tx_ >> 6;
        for (int rr = 0; rr < 4; ++rr) {
            const int row = u * 16 + w * 4 + rr, b = row >> 11;
            f32x4 v[4]; float s = 0.f;
#pragma unroll
            for (int i = 0; i < 4; ++i) { v[i] = *(const f32x4*)(Z + (size_t)row * 1024 + 256 * i + 4 * lane); s += (v[i][0] + v[i][1]) + (v[i][2] + v[i][3]); }
#pragma unroll
            for (int o = 32; o >= 1; o >>= 1) s += __shfl_xor(s, o);
            const float mean = s * (1.0f / 1024.0f); float q = 0.f;
#pragma unroll
            for (int i = 0; i < 4; ++i)
#pragma unroll
                for (int k = 0; k < 4; ++k) { const float d = v[i][k] - mean; q = fmaf(d, d, q); }
#pragma unroll
            for (int o = 32; o >= 1; o >>= 1) q += __shfl_xor(q, o);
            const float rstd = rsqrtf(q * (1.0f / 1024.0f) + 1e-5f);
#pragma unroll
            for (int i = 0; i < 4; ++i) {
                const int col = 256 * i + 4 * lane;
                const f32x4 g = *(const f32x4*)(p.ln_g + L * 1024 + col), bb = *(const f32x4*)(p.ln_b + L * 1024 + col);
                f32x4 o;
#pragma unroll
                for (int k = 0; k < 4; ++k) o[k] = (v[i][k] - mean) * rstd * g[k] + bb[k];
                *(f32x4*)(p.out + (size_t)row * 1024 + col) = o;
                if (L == 0) {
                    const f32x4 sh = *(const f32x4*)(mod + (size_t)b * 3072 + col), sc = *(const f32x4*)(mod + (size_t)b * 3072 + 1024 + col);
                    u32x2 pk; pk.x = cvt_pk(fmaf(o[0], 1.0f + sc[0], sh[0]), fmaf(o[1], 1.0f + sc[1], sh[1])); pk.y = cvt_pk(fmaf(o[2], 1.0f + sc[2], sh[2]), fmaf(o[3], 1.0f + sc[3], sh[3]));
                    *(u32x2*)(U + (size_t)row * 1024 + col) = pk;
                }
            }
        }
    }
}

constexpr int KT_BYTES = 64 * KP * 2, VT_BYTES = 8192;
DEV void stage_kv(const bf16_t* __restrict__ kg, const bf16_t* __restrict__ vg, size_t pitch, char* ksm, char* vsm) {
    int tid_ = threadIdx.x; OPAQUE_V(tid_); const int tid = tid_;
    u32x4 kr[2], vr[2];
#pragma unroll
    for (int i = 0; i < 2; ++i) { const int c = tid + 256 * i, row = c >> 3, ch = c & 7;
        kr[i] = *(const u32x4*)(kg + (size_t)row * pitch + ch * 8); vr[i] = *(const u32x4*)(vg + (size_t)row * pitch + ch * 8); }
#pragma unroll
    for (int i = 0; i < 2; ++i) { const int c = tid + 256 * i, row = c >> 3, ch = c & 7;
        *(u32x4*)(ksm + (row * KP + ch * 8) * 2) = kr[i];
        *(u32x4*)(vsm + (ch >> 2) * 4096 + row * 64 + (ch & 3) * 16) = vr[i]; }
}
DEV void load_qf(const bf16_t* q  , int h, bf16x8* qf) {
#pragma unroll
    for (int s = 0; s < 4; ++s) qf[s] = *(const bf16x8*)(q + 16 * s + 8 * h);
}
DEV void qk_tile(const char* ksm, const bf16x8* qf, int r32, int h, f32x16& s0, f32x16& s1) {
#pragma unroll
    for (int r = 0; r < 16; ++r) { s0[r] = 0.f; s1[r] = 0.f; }
#pragma unroll
    for (int s = 0; s < 4; ++s) {
        const bf16x8 a0 = *(const bf16x8*)(ksm + (r32 * KP + 16 * s + 8 * h) * 2);
        const bf16x8 a1 = *(const bf16x8*)(ksm + ((32 + r32) * KP + 16 * s + 8 * h) * 2);
        s0 = mfma(a0, qf[s], s0); s1 = mfma(a1, qf[s], s1);
    }
}
DEV void pv_tile(const char* vsm, int kofs, const f32x16& pt, int lane, f32x16& o0, f32x16& o1) {
    const int h = lane >> 5;
    const char* vb = vsm + ((lane >> 4) & 1) * 32 + (lane & 3) * 8 + (4 * h + ((lane & 15) >> 2) + kofs) * 64;
#pragma unroll
    for (int sp = 0; sp < 2; ++sp) {
        bf16x8 pb;
        { u32x4 t; t.x = cvt_pk(pt[8 * sp], pt[8 * sp + 1]); t.y = cvt_pk(pt[8 * sp + 2], pt[8 * sp + 3]); t.z = cvt_pk(pt[8 * sp + 4], pt[8 * sp + 5]); t.w = cvt_pk(pt[8 * sp + 6], pt[8 * sp + 7]); pb = __builtin_bit_cast(bf16x8, t); }
        const bf16x8 a0 = cat4(vtr(vb + (16 * sp) * 64), vtr(vb + (16 * sp + 8) * 64));
        const bf16x8 a1 = cat4(vtr(vb + 4096 + (16 * sp) * 64), vtr(vb + 4096 + (16 * sp + 8) * 64));
        o0 = mfma(a0, pb, o0); o1 = mfma(a1, pb, o1);
    }
}
DEV void flash_update(f32x16& s0, f32x16& s1, float& m, float& l, f32x16& o0, f32x16& o1, const char* vsm, int lane) {
    float mx = NEG_INF;
#pragma unroll
    for (int r = 0; r < 16; ++r) mx = fmaxf(mx, fmaxf(s0[r], s1[r]));
    mx = fmaxf(mx, __shfl_xor(mx, 32));
    const float mn = fmaxf(m, mx), mu = (mn == NEG_INF) ? 0.f : mn;
    const float alpha = fexp2(m - mu);
    m = mn;
    float ps = 0.f;
#pragma unroll
    for (int r = 0; r < 16; ++r) { s0[r] = fexp2(s0[r] - mu); s1[r] = fexp2(s1[r] - mu); ps += s0[r] + s1[r]; }
    l = fmaf(l, alpha, ps);
#pragma unroll
    for (int r = 0; r < 16; ++r) { o0[r] *= alpha; o1[r] *= alpha; }
    pv_tile(vsm, 0, s0, lane, o0, o1);
    pv_tile(vsm, 32, s1, lane, o0, o1);
}
DEV f32x16 qk32(const char* kbase, const bf16x8* qf, int r32, int h) {
    f32x16 s;
#pragma unroll
    for (int r = 0; r < 16; ++r) s[r] = 0.f;
#pragma unroll
    for (int k = 0; k < 4; ++k) { const bf16x8 a = *(const bf16x8*)(kbase + (r32 * KP + 16 * k + 8 * h) * 2); s = mfma(a, qf[k], s); }
    return s;
}
DEV void flash_update32(f32x16& s, float& m, float& l, f32x16& o0, f32x16& o1, const char* vsm, int kofs, int hstride, int lane) {
    float mx = NEG_INF;
#pragma unroll
    for (int r = 0; r < 16; ++r) mx = fmaxf(mx, s[r]);
    mx = fmaxf(mx, __shfl_xor(mx, 32));
    const float mn = fmaxf(m, mx), mu = (mn == NEG_INF) ? 0.f : mn;
    const float alpha = fexp2(m - mu);
    m = mn;
    float ps = 0.f;
#pragma unroll
    for (int r = 0; r < 16; ++r) { s[r] = fexp2(s[r] - mu); ps += s[r]; }
    l = fmaf(l, alpha, ps);
#pragma unroll
    for (int r = 0; r < 16; ++r) { o0[r] *= alpha; o1[r] *= alpha; }
    const int h = lane >> 5;
    const char* vb = vsm + ((lane >> 4) & 1) * 32 + (lane & 3) * 8 + (4 * h + ((lane & 15) >> 2) + kofs) * 64;
#pragma unroll
    for (int sp = 0; sp < 2; ++sp) {
        u32x4 t; t.x = cvt_pk(s[8 * sp], s[8 * sp + 1]); t.y = cvt_pk(s[8 * sp + 2], s[8 * sp + 3]); t.z = cvt_pk(s[8 * sp + 4], s[8 * sp + 5]); t.w = cvt_pk(s[8 * sp + 6], s[8 * sp + 7]);
        const bf16x8 pb = __builtin_bit_cast(bf16x8, t);
        const bf16x8 a0 = cat4(vtr(vb + (16 * sp) * 64), vtr(vb + (16 * sp + 8) * 64));
        const bf16x8 a1 = cat4(vtr(vb + hstride + (16 * sp) * 64), vtr(vb + hstride + (16 * sp + 8) * 64));
        o0 = mfma(a0, pb, o0); o1 = mfma(a1, pb, o1);
    }
}
DEV void write_mix(const Params& p, size_t token, int mixcol0, const f32x16& o0, const f32x16& o1, int h) {
    const bf16_t* G = (const bf16_t*)(p.ws + WS_H) + token * HP + C_GATE + mixcol0;
    bf16_t* M = (bf16_t*)(p.ws + WS_MIX) + token * 1024 + mixcol0;
#pragma unroll
    for (int dt = 0; dt < 2; ++dt)
#pragma unroll
        for (int a = 0; a < 4; ++a) {
            const int d = 32 * dt + 8 * a + 4 * h;
            const u32x2 g = *(const u32x2*)(G + d);
            const f32x16& o = dt ? o1 : o0;
            u32x2 r; r.x = cvt_pk(o[4 * a] * bf_lo(g.x), o[4 * a + 1] * bf_hi(g.x)); r.y = cvt_pk(o[4 * a + 2] * bf_lo(g.y), o[4 * a + 3] * bf_hi(g.y));
            *(u32x2*)(M + d) = r;
        }
}

DEV void fox_unit(const Params& p, int b, int hh, int qb, char* smem) {
    char* ksm = smem; char* vsm = smem + KT_BYTES; float* cum = (float*)(smem + KT_BYTES + VT_BYTES);
    float* wtot = cum + 2048;
    int tid_ = threadIdx.x; OPAQUE_V(tid_); const int tid = tid_, lane = tid & 63, w = tid >> 6, r32 = lane & 31, h = lane >> 5;
    const int q0 = qb * 128, nneed = q0 + 128;
    const bf16_t* H = (const bf16_t*)(p.ws + WS_H) + (size_t)b * S * HP;
    {
        const float* lf = (const float*)(p.ws + WS_LOGF) + ((size_t)b * 6 + hh) * 2048;
        float v[8]; float s = 0.f;
        if (tid * 8 < nneed) { const f32x4 a = *(const f32x4*)(lf + tid * 8), c = *(const f32x4*)(lf + tid * 8 + 4);
            v[0] = a[0]; v[1] = a[1]; v[2] = a[2]; v[3] = a[3]; v[4] = c[0]; v[5] = c[1]; v[6] = c[2]; v[7] = c[3]; }
        else {
#pragma unroll
            for (int e = 0; e < 8; ++e) v[e] = 0.f; }
#pragma unroll
        for (int e = 0; e < 8; ++e) { s += v[e]; v[e] = s; }
        float inc = s;
#pragma unroll
        for (int o = 1; o < 64; o <<= 1) { const float t = __shfl_up(inc, o); if (lane >= o) inc += t; }
        if (lane == 63) wtot[w] = inc;
        __syncthreads();
        float base = inc - s;
        for (int k = 0; k < w; ++k) base += wtot[k];
        if (tid * 8 < nneed) {
#pragma unroll
            for (int e = 0; e < 8; ++e) cum[tid * 8 + e] = (base + v[e]) * LOG2E; }
        __syncthreads();
    }
    const int tq = q0 + 32 * w + r32;
    bf16x8 qf[4]; load_qf(H + (size_t)tq * HP + C_FOXQ + 64 * hh, h, qf);
    const float cb = cum[tq];
    float m = NEG_INF, l = 0.f; f32x16 o0, o1;
#pragma unroll
    for (int r = 0; r < 16; ++r) { o0[r] = 0.f; o1[r] = 0.f; }
    const int ntiles = nneed / 64, mylast = (q0 + 32 * w + 31) >> 6;
    for (int kt = 0; kt < ntiles; ++kt) {
        __syncthreads();
        stage_kv(H + (size_t)kt * 64 * HP + C_FOXK + 64 * hh, H + (size_t)kt * 64 * HP + C_FOXV + 64 * hh, HP, ksm, vsm);
        __syncthreads();
        if (kt <= mylast) {
            f32x16 s0, s1; qk_tile(ksm, qf, r32, h, s0, s1);
            int lim = tq - 64 * kt - 4 * h; OPAQUE_V(lim);
#pragma unroll
            for (int a = 0; a < 4; ++a) {
                const f32x4 c0 = *(const f32x4*)(cum + kt * 64 + 8 * a + 4 * h), c1 = *(const f32x4*)(cum + kt * 64 + 32 + 8 * a + 4 * h);
#pragma unroll
                for (int k = 0; k < 4; ++k) {
                    s0[4 * a + k] = (8 * a + k) <= lim ? s0[4 * a + k] + (cb - c0[k]) : NEG_INF;
                    s1[4 * a + k] = (8 * a + k + 32) <= lim ? s1[4 * a + k] + (cb - c1[k]) : NEG_INF;
                }
            }
            flash_update(s0, s1, m, l, o0, o1, vsm, lane);
        }
    }
    l += __shfl_xor(l, 32);
    const float inv = 1.0f / l;
#pragma unroll
    for (int r = 0; r < 16; ++r) { o0[r] *= inv; o1[r] *= inv; }
    write_mix(p, (size_t)b * S + tq, 256 + 64 * hh, o0, o1, h);
    __syncthreads();
}

constexpr int BMP = 65;
DEV unsigned ford(float f) { const unsigned u = __float_as_uint(f); return u ^ ((u >> 31) ? 0xffffffffu : 0x80000000u); }
DEV void topk_row(const float* sc, int n, unsigned* bmrow, int lane) {
    const int nch = (n + 63) >> 6;
    if (n <= 256) {
        for (int i = 0; i < 32; ++i) {
            const int lo = 64 * i; unsigned long long msk = 0ull;
            if (lo < n) { const int c = n - lo; msk = c >= 64 ? ~0ull : ((1ull << c) - 1ull); }
            if (lane == 0) { bmrow[2 * i] = (unsigned)msk; bmrow[2 * i + 1] = (unsigned)(msk >> 32); }
        }
        return;
    }
    unsigned u[32];
#pragma unroll
    for (int i = 0; i < 32; ++i) { const int idx = 64 * i + lane; u[i] = (i < nch && idx < n) ? ford(sc[idx]) : 0u; }
    unsigned T = 0u;
    for (int bit = 31; bit >= 0; --bit) {
        const unsigned cand = T | (1u << bit); int cnt = 0;
#pragma unroll
        for (int i = 0; i < 32; ++i) if (i < nch) cnt += __popcll(__ballot(u[i] >= cand));
        if (cnt >= 256) T = cand;
    }
    int ngt = 0;
#pragma unroll
    for (int i = 0; i < 32; ++i) if (i < nch) ngt += __popcll(__ballot(u[i] > T));
    const int need = 256 - ngt; int running = 0;
    const unsigned long long lt = (1ull << lane) - 1ull;
#pragma unroll
    for (int i = 0; i < 32; ++i) {
        unsigned long long sm = 0ull;
        if (i < nch) {
            const bool eq = u[i] == T; const unsigned long long bal = __ballot(eq);
            const int pre = running + __popcll(bal & lt);
            const bool sel = (u[i] > T) || (eq && pre < need);
            running += __popcll(bal);
            sm = __ballot(sel);
        }
        if (lane == 0) { bmrow[2 * i] = (unsigned)sm; bmrow[2 * i + 1] = (unsigned)(sm >> 32); }
    }
}
DEV void dsa_unit(const Params& p, int b, int qb, char* smem) {
    float* sc = (float*)smem;
    unsigned* bm = (unsigned*)(smem + 65536);
    char* ksm = smem; char* vsm = smem + KT_BYTES;
    int tid_ = threadIdx.x; OPAQUE_V(tid_); const int tid = tid_, lane = tid & 63, w = tid >> 6, r32 = lane & 31, h = lane >> 5;
    const int t0 = qb * 32;
    const bf16_t* H = (const bf16_t*)(p.ws + WS_H) + (size_t)b * S * HP;
    const float* IW = (const float*)(p.ws + WS_IW) + (size_t)b * S * 8;
    for (int sb = 0; sb < 4; ++sb) {
        const int ts = t0 + 8 * sb, nkeys = ts + 8, nkt = (nkeys + 31) >> 5;
        const int tl = 2 * ((r32 >> 2) & 1) + (r32 >> 4), head = ((r32 >> 3) & 1) * 4 + (r32 & 3);
        bf16x8 af[2][2]; f32x4 wv[2][4];
#pragma unroll
        for (int mt = 0; mt < 2; ++mt) {
#pragma unroll
            for (int ks = 0; ks < 2; ++ks) af[mt][ks] = *(const bf16x8*)(H + (size_t)(ts + 4 * mt + tl) * HP + C_IDXQ + 32 * head + 16 * ks + 8 * h);
#pragma unroll
            for (int a = 0; a < 4; ++a) wv[mt][a] = *(const f32x4*)(IW + (size_t)(ts + 4 * mt + 2 * h + (a >> 1)) * 8 + (a & 1) * 4);
        }
        for (int kt = w; kt < nkt; kt += 4) {
            const int key = 32 * kt + r32;
            bf16x8 bf[2];
#pragma unroll
            for (int ks = 0; ks < 2; ++ks) bf[ks] = *(const bf16x8*)(H + (size_t)key * HP + C_IDXK + 16 * ks + 8 * h);
#pragma unroll
            for (int mt = 0; mt < 2; ++mt) {
                f32x16 acc;
#pragma unroll
                for (int r = 0; r < 16; ++r) acc[r] = 0.f;
                acc = mfma(af[mt][0], bf[0], acc); acc = mfma(af[mt][1], bf[1], acc);
                float sA = 0.f, sB = 0.f;
#pragma unroll
                for (int a = 0; a < 2; ++a)
#pragma unroll
                    for (int k = 0; k < 4; ++k) { sA = fmaf(wv[mt][a][k], fmaxf(acc[4 * a + k], 0.f), sA); sB = fmaf(wv[mt][a + 2][k], fmaxf(acc[4 * (a + 2) + k], 0.f), sB); }
                const int rowA = 4 * mt + 2 * h, tokA = ts + rowA;
                sc[rowA * 2048 + key] = key <= tokA ? sA : NEG_INF;
                sc[(rowA + 1) * 2048 + key] = key <= tokA + 1 ? sB : NEG_INF;
            }
        }
        __syncthreads();
#pragma unroll 1
        for (int rr = 0; rr < 2; ++rr) { const int row = 2 * w + rr; topk_row(sc + row * 2048, ts + row + 1, bm + (8 * sb + row) * BMP, lane); }
        __syncthreads();
    }
    const int tq = t0 + r32;
    bf16x8 qf[4]; load_qf(H + (size_t)tq * HP + C_DSAQ + 64 * w, h, qf);
    float m = NEG_INF, l = 0.f; f32x16 o0, o1;
#pragma unroll
    for (int r = 0; r < 16; ++r) { o0[r] = 0.f; o1[r] = 0.f; }
    const int ntiles = ((t0 + 31) >> 6) + 1;
    for (int kt = 0; kt < ntiles; ++kt) {
        __syncthreads();
        stage_kv(H + (size_t)kt * 64 * HP + C_DSAK, H + (size_t)kt * 64 * HP + C_DSAV, HP, ksm, vsm);
        __syncthreads();
        f32x16 s0, s1; qk_tile(ksm, qf, r32, h, s0, s1);
        const unsigned w0 = bm[r32 * BMP + 2 * kt] >> (4 * h), w1 = bm[r32 * BMP + 2 * kt + 1] >> (4 * h);
#pragma unroll
        for (int r = 0; r < 16; ++r) { const int bit = (r & 3) + 8 * (r >> 2);
            s0[r] = ((w0 >> bit) & 1u) ? s0[r] : NEG_INF; s1[r] = ((w1 >> bit) & 1u) ? s1[r] : NEG_INF; }
        flash_update(s0, s1, m, l, o0, o1, vsm, lane);
    }
    l += __shfl_xor(l, 32);
    const float inv = l > 0.f ? 1.0f / l : 0.f;
#pragma unroll
    for (int r = 0; r < 16; ++r) { o0[r] *= inv; o1[r] *= inv; }
    write_mix(p, (size_t)b * S + tq, 64 * w, o0, o1, h);
    __syncthreads();
}

DEV void cmp_unit(const Params& p, int L, int kv, int b, int g, int cc, char* smem) {
    float* red = (float*)smem;
    float* hid = (float*)(smem + 32768);
    int tid_ = threadIdx.x; OPAQUE_V(tid_); const int tid = tid_, lane = tid & 63, w = tid >> 6, r32 = lane & 31, h = lane >> 5;
    const bf16_t* H = (const bf16_t*)(p.ws + WS_H) + (size_t)b * S * HP + (kv ? C_VC : C_KC) + 64 * g;
    const bf16_t* W1 = (const bf16_t*)(p.ws + WS_W1T) + (size_t)(L * 2 + kv) * 64 * 2048;
    const float* pe = p.cmp_pe + (size_t)(L * 2 + kv) * 32 * 64;
    int c = cc * 32 + r32; if (c > 126) c = 126;
    f32x16 acc[2];
#pragma unroll
    for (int r = 0; r < 16; ++r) { acc[0][r] = 0.f; acc[1][r] = 0.f; }
#pragma unroll 4
    for (int ks = w * 32; ks < w * 32 + 32; ++ks) {
        const int li = ks >> 2, d0 = (ks & 3) * 16 + 8 * h;
        const u32x4 raw = *(const u32x4*)(H + (size_t)(16 * c + li) * HP + d0);
        const f32x4 p0 = *(const f32x4*)(pe + li * 64 + d0), p1 = *(const f32x4*)(pe + li * 64 + d0 + 4);
        u32x4 t; t.x = cvt_pk(bf_lo(raw.x) + p0[0], bf_hi(raw.x) + p0[1]); t.y = cvt_pk(bf_lo(raw.y) + p0[2], bf_hi(raw.y) + p0[3]);
        t.z = cvt_pk(bf_lo(raw.z) + p1[0], bf_hi(raw.z) + p1[1]); t.w = cvt_pk(bf_lo(raw.w) + p1[2], bf_hi(raw.w) + p1[3]);
        const bf16x8 a = __builtin_bit_cast(bf16x8, t);
#pragma unroll
        for (int nt = 0; nt < 2; ++nt) { const bf16x8 bw = *(const bf16x8*)(W1 + (size_t)(32 * nt + r32) * 2048 + 16 * ks + 8 * h); acc[nt] = mfma(a, bw, acc[nt]); }
    }
#pragma unroll
    for (int nt = 0; nt < 2; ++nt)
#pragma unroll
        for (int r = 0; r < 16; ++r) red[(w * 32 + crow(r, h)) * 64 + 32 * nt + r32] = acc[nt][r];
    __syncthreads();
#pragma unroll
    for (int i = 0; i < 8; ++i) { const int e = tid + 256 * i; const float v = red[e] + red[2048 + e] + red[4096 + e] + red[6144 + e]; hid[e] = v / (1.0f + __expf(-v)); }
    __syncthreads();
    {
        const int cl = tid >> 3, n2 = (tid & 7) * 8; const float* w2 = p.cmp_w2 + (size_t)(L * 2 + kv) * 64 * 64;
        float o[8];
#pragma unroll
        for (int e = 0; e < 8; ++e) o[e] = 0.f;
        for (int n = 0; n < 64; ++n) { const float hv = hid[cl * 64 + n]; const f32x4 wa = *(const f32x4*)(w2 + n * 64 + n2), wb = *(const f32x4*)(w2 + n * 64 + n2 + 4);
#pragma unroll
            for (int e = 0; e < 4; ++e) { o[e] = fmaf(hv, wa[e], o[e]); o[4 + e] = fmaf(hv, wb[e], o[4 + e]); } }
        const int cg_ = cc * 32 + cl;
        if (cg_ >= 127) {
#pragma unroll
            for (int e = 0; e < 8; ++e) o[e] = 0.f; }
        bf16_t* dst = (bf16_t*)(p.ws + (kv ? WS_VC : WS_KC)) + ((size_t)(b * 2 + g) * 128 + cg_) * 64 + n2;
        *(u32x4*)dst = pack8(o);
    }
    __syncthreads();
}

constexpr int KC_BYTES = 128 * KP * 2;
DEV void nsa_unit(const Params& p, int b, int g, int qb, int j, char* smem) {
    char* kcs = smem;
    char* vcs = smem + KC_BYTES;
    char* ksm = smem + KC_BYTES + 16384;
    char* vsm = ksm + KT_BYTES;
    float* scr = (float*)(vsm + VT_BYTES);
    unsigned* uni = (unsigned*)(scr + 4 * 32 * 33);
    int tid_ = threadIdx.x; OPAQUE_V(tid_); const int tid = tid_, lane = tid & 63, w = tid >> 6, r32 = lane & 31, h = lane >> 5;
    const int q0 = qb * 128, tq = q0 + 32 * w + r32;
    const bf16_t* H = (const bf16_t*)(p.ws + WS_H) + (size_t)b * S * HP;
    {
        const bf16_t* kc = (const bf16_t*)(p.ws + WS_KC) + (size_t)(b * 2 + g) * 128 * 64;
        const bf16_t* vc = (const bf16_t*)(p.ws + WS_VC) + (size_t)(b * 2 + g) * 128 * 64;
#pragma unroll
        for (int i = 0; i < 4; ++i) { const int c = tid + 256 * i, row = c >> 3, ch = c & 7;
            *(u32x4*)(kcs + (row * KP + ch * 8) * 2) = *(const u32x4*)(kc + row * 64 + ch * 8);
            *(u32x4*)(vcs + (ch >> 2) * 8192 + row * 64 + (ch & 3) * 16) = *(const u32x4*)(vc + row * 64 + ch * 8); }
    }
    __syncthreads();
    const int clim_ = tq >= 31 ? ((tq - 31) >> 4) : -1;
    const int climh = (clim_ > 126 ? 126 : clim_) - 4 * h;
    float B4[16], E[16];
#pragma unroll
    for (int i = 0; i < 16; ++i) { B4[i] = 0.f; E[i] = 0.f; }
#pragma unroll 1
    for (int jj = 0; jj < 3; ++jj) {
        bf16x8 qf[4]; load_qf(H + (size_t)tq * HP + C_NSAQ + 64 * (3 * g + jj), h, qf);
        float mrun = NEG_INF, lrun = 0.f;
#pragma unroll
        for (int n = 0; n < 4; ++n) {
            f32x16 st = qk32(kcs + n * 32 * KP * 2, qf, r32, h);
            float mx = NEG_INF;
            int lim = climh; OPAQUE_V(lim);
#pragma unroll
            for (int r = 0; r < 16; ++r) { st[r] = (32 * n + CR(r)) <= lim ? st[r] : NEG_INF; mx = fmaxf(mx, st[r]); }
            const float mn = fmaxf(mrun, mx), mu = mn == NEG_INF ? 0.f : mn;
            float ps = 0.f;
#pragma unroll
            for (int r = 0; r < 16; ++r) ps += fexp2(st[r] - mu);
            lrun = fmaf(lrun, fexp2(mrun - mu), ps); mrun = mn;
            __builtin_amdgcn_sched_barrier(0);
        }
        const float mo = __shfl_xor(mrun, 32), lo = __shfl_xor(lrun, 32);
        const float M = fmaxf(mrun, mo), Mu = M == NEG_INF ? 0.f : M;
        const float Lt = lrun * fexp2(mrun - Mu) + lo * fexp2(mo - Mu);
        const float inv = 1.0f / fmaxf(Lt, 1e-30f);
#pragma unroll
        for (int n = 0; n < 4; ++n) {
            f32x16 st = qk32(kcs + n * 32 * KP * 2, qf, r32, h);
            int lim = climh; OPAQUE_V(lim);
#pragma unroll
            for (int a = 0; a < 4; ++a) {
                float pr[4];
#pragma unroll
                for (int k = 0; k < 4; ++k) pr[k] = (32 * n + 8 * a + k) <= lim ? fexp2(st[4 * a + k] - Mu) * inv : 0.f;
                B4[4 * n + a] += (pr[0] + pr[1]) + (pr[2] + pr[3]); E[4 * n + a] += pr[3];
            }
            __builtin_amdgcn_sched_barrier(0);
        }
    }
    {
        float* my = scr + (w * 32 + r32) * 33;
#pragma unroll
        for (int i = 0; i < 16; ++i) { const float eo = __shfl_xor(E[i], 32); E[i] = eo; }
#pragma unroll
        for (int i = 0; i < 16; ++i) { const float prev = h ? E[i] : (i > 0 ? E[i - 1] : 0.f); my[2 * i + h] = B4[i] + prev; }
    }
    __builtin_amdgcn_wave_barrier();
    unsigned sel;
    {
        const float* my = scr + (w * 32 + r32) * 33; const int cur = tq >> 6;
        float v[32];
#pragma unroll
        for (int n = 0; n < 32; ++n) { float s_ = my[n]; const bool forced = (n == 0) || (n == cur) || (n == cur - 1); const bool fut = 64 * n > tq;
            v[n] = forced ? __builtin_huge_valf() : (fut ? NEG_INF : s_); }
        unsigned mk = 0u;
#pragma unroll
        for (int i = 0; i < 32; ++i) {
            int rank = 0;
#pragma unroll
            for (int n = 0; n < 32; ++n) { if (n < i) rank += (v[n] >= v[i]) ? 1 : 0; else if (n > i) rank += (v[n] > v[i]) ? 1 : 0; }
            if (rank < 16 && 64 * i <= tq) mk |= 1u << i;
        }
        sel = mk;
    }
    unsigned wsel = sel;
#pragma unroll
    for (int o = 16; o >= 1; o >>= 1) wsel |= __shfl_xor(wsel, o);
    if (lane == 0) uni[w] = wsel;
    __syncthreads();
    const unsigned bsel = uni[0] | uni[1] | uni[2] | uni[3];
    const float* gs = (const float*)(p.ws + WS_GSIG) + ((size_t)b * S + tq) * 20;
    const float g0 = gs[0 * 6 + g * 3 + j], g1 = gs[1 * 6 + g * 3 + j], g2 = gs[2 * 6 + g * 3 + j];
    f32x16 ot0, ot1;
    {
        bf16x8 qf[4]; load_qf(H + (size_t)tq * HP + C_NSAQ + 64 * (3 * g + j), h, qf);
        float m = NEG_INF, l = 0.f; f32x16 o0, o1;
#pragma unroll
        for (int r = 0; r < 16; ++r) { o0[r] = 0.f; o1[r] = 0.f; }
#pragma unroll 1
        for (int n = 0; n < 4; ++n) {
            f32x16 st = qk32(kcs + n * 32 * KP * 2, qf, r32, h);
            int lim = climh - 32 * n; OPAQUE_V(lim);
#pragma unroll
            for (int r = 0; r < 16; ++r) st[r] = CR(r) <= lim ? st[r] : NEG_INF;
            flash_update32(st, m, l, o0, o1, vcs, 32 * n, 8192, lane);
        }
        l += __shfl_xor(l, 32);
        const float sc_ = l > 0.f ? g0 / l : 0.f;
#pragma unroll
        for (int r = 0; r < 16; ++r) { ot0[r] = o0[r] * sc_; ot1[r] = o1[r] * sc_; }
    }
    bf16x8 qr[4]; load_qf((const bf16_t*)(p.ws + WS_QROT) + ((size_t)b * S + tq) * 384 + 64 * (3 * g + j), h, qr);
    {
        float m = NEG_INF, l = 0.f; f32x16 o0, o1;
#pragma unroll
        for (int r = 0; r < 16; ++r) { o0[r] = 0.f; o1[r] = 0.f; }
        const int nlast = (q0 + 127) >> 6;
        for (int nb = 0; nb <= nlast; ++nb) {
            if (!((bsel >> nb) & 1u)) continue;
            __syncthreads();
            stage_kv(H + (size_t)nb * 64 * HP + C_KS + 64 * g, H + (size_t)nb * 64 * HP + C_VS + 64 * g, HP, ksm, vsm);
            __syncthreads();
            if ((wsel >> nb) & 1u) {
                f32x16 s0, s1; qk_tile(ksm, qr, r32, h, s0, s1);
                int lim = ((sel >> nb) & 1u) ? tq - 64 * nb - 4 * h : -1; OPAQUE_V(lim);
#pragma unroll
                for (int r = 0; r < 16; ++r) { s0[r] = CR(r) <= lim ? s0[r] : NEG_INF; s1[r] = (CR(r) + 32) <= lim ? s1[r] : NEG_INF; }
                flash_update(s0, s1, m, l, o0, o1, vsm, lane);
            }
        }
        l += __shfl_xor(l, 32);
        const float sc_ = l > 0.f ? g1 / l : 0.f;
#pragma unroll
        for (int r = 0; r < 16; ++r) { ot0[r] = fmaf(o0[r], sc_, ot0[r]); ot1[r] = fmaf(o1[r], sc_, ot1[r]); }
    }
    {
        float m = NEG_INF, l = 0.f; f32x16 o0, o1;
#pragma unroll
        for (int r = 0; r < 16; ++r) { o0[r] = 0.f; o1[r] = 0.f; }
        const int kfirst = q0 >= 512 ? (q0 - 512) >> 6 : 0, klast = (q0 + 127) >> 6;
        const int wt0 = q0 + 32 * w;
        const int wfirst = wt0 >= 511 ? (wt0 - 511) >> 6 : 0, wlast = (wt0 + 31) >> 6;
        for (int kt = kfirst; kt <= klast; ++kt) {
            __syncthreads();
            stage_kv(H + (size_t)kt * 64 * HP + C_KW + 64 * g, H + (size_t)kt * 64 * HP + C_VW + 64 * g, HP, ksm, vsm);
            __syncthreads();
            if (kt >= wfirst && kt <= wlast) {
                f32x16 s0, s1; qk_tile(ksm, qr, r32, h, s0, s1);
                int lim = tq - 64 * kt - 4 * h; OPAQUE_V(lim);
#pragma unroll
                for (int r = 0; r < 16; ++r) { s0[r] = (unsigned)(lim - CR(r)) < 512u ? s0[r] : NEG_INF; s1[r] = (unsigned)(lim - CR(r) - 32) < 512u ? s1[r] : NEG_INF; }
                flash_update(s0, s1, m, l, o0, o1, vsm, lane);
            }
        }
        l += __shfl_xor(l, 32);
        const float sc_ = l > 0.f ? g2 / l : 0.f;
#pragma unroll
        for (int r = 0; r < 16; ++r) { ot0[r] = fmaf(o0[r], sc_, ot0[r]); ot1[r] = fmaf(o1[r], sc_, ot1[r]); }
    }
    write_mix(p, (size_t)b * S + tq, 640 + 64 * (3 * g + j), ot0, ot1, h);
    __syncthreads();
}


#define XB_TMO      128
#define XB_XCNT(j)  (256  + 64 * (j))
#define XB_XSUB(j)  (1280 + 64 * (j))
#define XB_XGEN(j)  (2304 + 64 * (j))
#define XB_TOP      3328
#define XB_TOPGEN   3392
#define XCD_BAR_WORDS 3456
#define XB_SPIN_CAP (1u << 22)
DEV unsigned xb_ld(unsigned* p) { return __hip_atomic_load(p, __ATOMIC_RELAXED, __HIP_MEMORY_SCOPE_AGENT); }
DEV unsigned xb_add(unsigned* p, unsigned v) { return __hip_atomic_fetch_add(p, v, __ATOMIC_RELAXED, __HIP_MEMORY_SCOPE_AGENT); }
DEV unsigned xb_xcc_id() { return (unsigned)__builtin_amdgcn_s_getreg((3 << 11) | 20) & 0xFu; }
#define XB_SPIN(cond, bar) do { unsigned _sp = 0; while (cond) { __builtin_amdgcn_s_sleep(1); \
    if ((++_sp & 255u) == 0u) { if (xb_ld(&(bar)[XB_TMO])) break; if (_sp > XB_SPIN_CAP) { atomicAdd(&(bar)[XB_TMO], 1u); break; } } } } while (0)
struct XcdBarrier { unsigned* bar; unsigned x; volatile LDSAS unsigned* st; };
DEV XcdBarrier xcd_barrier_post(unsigned* bar, volatile LDSAS unsigned* st) {
    XcdBarrier b; b.bar = bar; b.x = xb_xcc_id(); b.st = st;
    if (threadIdx.x == 0) (void)xb_add(&bar[XB_XCNT(b.x)], 1u);
    return b;
}
DEV void xcd_barrier_complete(unsigned* bar, unsigned x, unsigned& nloc, unsigned& nx) {
    const unsigned G = gridDim.x * gridDim.y * gridDim.z;
    unsigned sum, cnt, mine, sp = 0u;
    for (;;) {
        sum = 0u; cnt = 0u; mine = 0u;
#pragma unroll
        for (unsigned j = 0; j < 16; ++j) { const unsigned c = xb_ld(&bar[XB_XCNT(j)]); sum += c; cnt += (c > 0u) ? 1u : 0u; mine = (j == x) ? c : mine; }
        if (sum == G) break;
        __builtin_amdgcn_s_sleep(1);
        if ((++sp & 255u) == 0u) { if (xb_ld(&bar[XB_TMO])) break; if (sp > XB_SPIN_CAP) { atomicAdd(&bar[XB_TMO], 1u); break; } }
    }
    nloc = mine > 0u ? mine : 1u; nx = cnt > 0u ? cnt : 1u;
}
DEV void xcd_barrier(const XcdBarrier& b) {
    asm volatile("s_waitcnt vmcnt(0)" ::: "memory");
    __syncthreads();
    if (threadIdx.x == 0) {
        unsigned* bar = b.bar;
        __builtin_amdgcn_s_waitcnt(0);
        unsigned nloc = b.st[0], nx = b.st[1];
        if (nloc == 0u) { xcd_barrier_complete(bar, b.x, nloc, nx); b.st[0] = nloc; b.st[1] = nx; }
        const unsigned old = xb_add(&bar[XB_XSUB(b.x)], 1u);
        const unsigned gen = old / nloc;
        if (old + 1u == (gen + 1u) * nloc) {
            __builtin_amdgcn_fence(__ATOMIC_RELEASE, "agent");
            asm volatile("s_waitcnt vmcnt(0)" ::: "memory");
            const unsigned og = xb_add(&bar[XB_TOP], 1u);
            const unsigned tg = og / nx;
            if (og + 1u == (tg + 1u) * nx) xb_add(&bar[XB_TOPGEN], 1u);
            else XB_SPIN(xb_ld(&bar[XB_TOPGEN]) == tg, bar);
            __builtin_amdgcn_fence(__ATOMIC_ACQUIRE, "agent");
            xb_add(&bar[XB_XGEN(b.x)], 1u);
            asm volatile("s_waitcnt vmcnt(0)" ::: "memory");
        } else {
            XB_SPIN(xb_ld(&bar[XB_XGEN(b.x)]) == gen, bar);
            __builtin_amdgcn_fence(__ATOMIC_ACQUIRE, "agent");
            asm volatile("s_waitcnt vmcnt(0)" ::: "memory");
        }
    }
    __syncthreads();
}
DEV void phase_mid(const Params& p, int L, char* smem) {
    constexpr int N_DSA = 512, N_FOX = 768, N_CMP = 128;
    for (int u = blockIdx.x; u < N_DSA + N_FOX + N_CMP; u += gridDim.x) {
        int v = u;
        if (v < N_DSA) { const int qb = 63 - (v >> 3), b = v & 7; dsa_unit(p, b, qb, smem); continue; }
        v -= N_DSA;
        if (v < N_FOX) { const int qb = 15 - v / 48, r = v % 48, b = r / 6, hh = r % 6; fox_unit(p, b, hh, qb, smem); continue; }
        v -= N_FOX;
        { const int kv = v & 1, g = (v >> 1) & 1, cc = (v >> 2) & 3, b = v >> 4; cmp_unit(p, L, kv, b, g, cc, smem); }
    }
}
DEV void phase_nsa(const Params& p, char* smem) {
    for (int u = blockIdx.x; u < 768; u += gridDim.x) {
        const int qb = 15 - u / 48, r = u % 48, b = r / 6, g = (r % 6) / 3, j = r % 3;
        nsa_unit(p, b, g, qb, j, smem);
    }
}
#ifndef PHASE_MASK
#define PHASE_MASK 0xffff
#endif
DEV void run_phase(const Params& p, int ph, char* smem) {
    if (ph == 0) { if (PHASE_MASK & 1) phase_prep(p, smem); return; }
    if (ph == 1) { if (PHASE_MASK & 2) phase_u1(p); return; }
    const int L = (ph - 2) / 5, k = (ph - 2) % 5;
    if (k == 0) { if (PHASE_MASK & 4) phase_gemm_in(p, L, smem); }
    else if (k == 1) { if (PHASE_MASK & 8) phase_mid(p, L, smem); }
    else if (k == 2) { if (PHASE_MASK & 16) phase_nsa(p, smem); }
    else if (k == 3) { if (PHASE_MASK & 32) phase_out(p, L, smem); }
    else { if (PHASE_MASK & 64) phase_ln(p, L); }
}
constexpr int N_PHASES = 12;

#ifndef REPEAT_KIND
#define REPEAT_KIND -1
#endif
DEV int phase_kind(int ph) { return ph < 2 ? ph : 2 + (ph - 2) % 5; }
template <bool COOP>
__global__ void __launch_bounds__(256, 2) mega(Params p, int ph_lo, int ph_hi) {
    extern __shared__ __attribute__((aligned(16))) char smem[];
    volatile LDSAS unsigned* st = (volatile LDSAS unsigned*)(smem + SMEM_BYTES - 16);
    XcdBarrier xb;
    if (COOP) {
        if (threadIdx.x == 0) { st[0] = 0u; st[1] = 0u; }
        __syncthreads();
        xb = xcd_barrier_post((unsigned*)(p.ws + WS_CTRL), st);
    }
    for (int ph = ph_lo; ph < ph_hi; ++ph) {
        run_phase(p, ph, smem);
        if (COOP) {
            if (REPEAT_KIND >= 0 && phase_kind(ph) == REPEAT_KIND) { xcd_barrier(xb); run_phase(p, ph, smem); }
            if (ph + 1 < ph_hi) xcd_barrier(xb);
        }
    }
}

#ifndef N_LAUNCH_MODE
#define N_LAUNCH_MODE 1
#endif

extern "C" void kernel_launch(void* const* d_in, const int* in_sizes, int n_in, void* d_out, int out_size, void* d_ws, size_t ws_size, hipStream_t stream) {
    static int grid = 0;
    if (grid == 0) {
        int dev = 0, cus = 0, per_cu = 0;
        hipGetDevice(&dev);
        hipDeviceGetAttribute(&cus, hipDeviceAttributeMultiprocessorCount, dev);
        hipFuncSetAttribute((const void*)mega<true>, hipFuncAttributeMaxDynamicSharedMemorySize, SMEM_BYTES);
        hipFuncSetAttribute((const void*)mega<false>, hipFuncAttributeMaxDynamicSharedMemorySize, SMEM_BYTES);
        hipOccupancyMaxActiveBlocksPerMultiprocessor(&per_cu, (const void*)mega<true>, 256, SMEM_BYTES);
        if (per_cu < 1) per_cu = 1;
        if (per_cu > 2) per_cu = 2;
        grid = cus * per_cu;
        if (ws_size < WS_END) { fprintf(stderr, "workspace too small: %zu < %zu\n", ws_size, (size_t)WS_END); grid = -1; }
    }
    if (grid < 0) return;
    Params p{};
    p.x = (const float*)d_in[0]; p.c = (const float*)d_in[1]; p.w_ada = (const float*)d_in[2]; p.b_ada = (const float*)d_in[3];
    p.w_in = (const float*)d_in[4]; p.b_f = (const float*)d_in[5]; p.cmp_pe = (const float*)d_in[6]; p.cmp_w1 = (const float*)d_in[7];
    p.cmp_w2 = (const float*)d_in[8]; p.w_out = (const float*)d_in[9]; p.ln_g = (const float*)d_in[10]; p.ln_b = (const float*)d_in[11];
    p.out = (float*)d_out; p.ws = (char*)d_ws;
#if N_LAUNCH_MODE == 1
    (void)hipMemsetAsync((char*)d_ws + WS_CTRL, 0, XCD_BAR_WORDS * 4, stream);
    hipLaunchKernelGGL(mega<true>, dim3(grid), dim3(256), SMEM_BYTES, stream, p, 0, N_PHASES);
#else
    for (int ph = 0; ph < N_PHASES; ++ph) hipLaunchKernelGGL(mega<false>, dim3(grid), dim3(256), SMEM_BYTES, stream, p, ph, ph + 1);
#endif
}
```

```cpp
#include <hip/hip_runtime.h>
#include <hip/hip_cooperative_groups.h>
#include <stdint.h>
#include <stdio.h>
namespace cg = cooperative_groups;

#define DEV __device__ __forceinline__
typedef unsigned short bf16_t;
typedef short bf16x8 __attribute__((ext_vector_type(8)));
typedef short s16x4 __attribute__((ext_vector_type(4)));
typedef float f32x16 __attribute__((ext_vector_type(16)));
typedef float f32x4 __attribute__((ext_vector_type(4)));
typedef float f32x2 __attribute__((ext_vector_type(2)));
typedef unsigned u32x4 __attribute__((ext_vector_type(4)));
typedef unsigned u32x2 __attribute__((ext_vector_type(2)));
typedef short v4i16_t __attribute__((ext_vector_type(4)));
#define LDSAS __attribute__((address_space(3)))

constexpr int NB = 8, S = 2048, DM = 1024, NTOK = NB * S, HP = 4096;
constexpr int C_DSAQ = 0, C_DSAK = 256, C_DSAV = 320, C_IDXQ = 384, C_IDXK = 640, C_MISC = 672, C_FOXQ = 704, C_FOXK = 1088, C_FOXV = 1472,
              C_NSAQ = 1856, C_KC = 2240, C_VC = 2368, C_KS = 2496, C_VS = 2624, C_KW = 2752, C_VW = 2880, C_GATE = 3008;
constexpr float LOG2E = 1.4426950408889634f;
constexpr float QS = 0.125f * LOG2E;
constexpr float ALPHA = 1.4142135623730951f;
constexpr float NEG_INF = -__builtin_huge_valf();

constexpr size_t WS_CTRL = 0;
constexpr size_t WS_MOD = 16384;
constexpr size_t WS_CS64 = WS_MOD + 2 * 8 * 3072 * 4;
constexpr size_t WS_CS32 = WS_CS64 + 2048 * 32 * 8;
constexpr size_t WS_WINT = WS_CS32 + 2048 * 16 * 8;
constexpr size_t WS_WOUTT = WS_WINT + (size_t)2 * 4096 * 1024 * 2;
constexpr size_t WS_W1T = WS_WOUTT + (size_t)2 * 1024 * 1024 * 2;
constexpr size_t WS_U = WS_W1T + (size_t)2 * 2 * 64 * 2048 * 2;
constexpr size_t WS_MIX = WS_U + (size_t)NTOK * 1024 * 2;
constexpr size_t WS_QROT = WS_MIX + (size_t)NTOK * 1024 * 2;
constexpr size_t WS_IW = WS_QROT + (size_t)NTOK * 384 * 2;
constexpr size_t WS_GSIG = WS_IW + (size_t)NTOK * 8 * 4;
constexpr size_t WS_LOGF = WS_GSIG + (size_t)NTOK * 20 * 4;
constexpr size_t WS_KC = WS_LOGF + (size_t)8 * 6 * 2048 * 4;
constexpr size_t WS_VC = WS_KC + (size_t)8 * 2 * 128 * 64 * 2;
constexpr size_t WS_H = WS_VC + (size_t)8 * 2 * 128 * 64 * 2;
constexpr size_t WS_END = WS_H + (size_t)NTOK * HP * 2;
static_assert(WS_END <= (size_t)256 * 1024 * 1024, "workspace");

constexpr int SMEM_BYTES = 78848;

struct Params {
    const float *x, *c, *w_ada, *b_ada, *w_in, *b_f, *cmp_pe, *cmp_w1, *cmp_w2, *w_out, *ln_g, *ln_b;
    float* out; char* ws;
};

#define OPAQUE_V(x) asm volatile("" : "+v"(x))
#define CR(r) (((r) & 3) + 8 * ((r) >> 2))
DEV int crow(int r, int h) { return (r & 3) + 8 * (r >> 2) + 4 * h; }
typedef __bf16 bf16x2_t __attribute__((ext_vector_type(2)));
DEV unsigned cvt_pk(float lo, float hi) { const f32x2 v = {lo, hi}; return __builtin_bit_cast(unsigned, __builtin_convertvector(v, bf16x2_t)); }
DEV float bf_lo(unsigned v) { return __uint_as_float(v << 16); }
DEV float bf_hi(unsigned v) { return __uint_as_float(v & 0xffff0000u); }
DEV f32x16 mfma(bf16x8 a, bf16x8 b, f32x16 c) { return __builtin_amdgcn_mfma_f32_32x32x16_bf16(a, b, c, 0, 0, 0); }
DEV float fexp2(float x) { return __builtin_amdgcn_exp2f(x); }
DEV s16x4 vtr(const char* p) { return __builtin_bit_cast(s16x4, __builtin_amdgcn_ds_read_tr16_b64_v4i16((LDSAS v4i16_t*)p)); }
DEV bf16x8 cat4(s16x4 a, s16x4 b) { bf16x8 r; r[0] = a[0]; r[1] = a[1]; r[2] = a[2]; r[3] = a[3]; r[4] = b[0]; r[5] = b[1]; r[6] = b[2]; r[7] = b[3]; return r; }
DEV u32x4 pack8(const float* v) { u32x4 r; r.x = cvt_pk(v[0], v[1]); r.y = cvt_pk(v[2], v[3]); r.z = cvt_pk(v[4], v[5]); r.w = cvt_pk(v[6], v[7]); return r; }
DEV float sigmoidf_(float v) { return 1.0f / (1.0f + __expf(-v)); }

DEV void sincos_acc(float a, float& sn, float& cs) {
    const float q = rintf(a * 0.6366197723675814f);
    float y = fmaf(-q, 1.5703125f, a); y = fmaf(-q, 4.837512969970703125e-4f, y); y = fmaf(-q, 7.54978995489188216e-8f, y);
    const float z = y * y;
    const float sp = y + y * z * (-1.6666654611e-1f + z * (8.3321608736e-3f + z * (-1.9515295891e-4f)));
    const float cp = 1.0f + z * (-0.5f + z * (4.166664568298827e-2f + z * (-1.388731625493765e-3f + z * 2.443315711809948e-5f)));
    const int qi = ((int)q) & 3;
    sn = (qi == 0) ? sp : (qi == 1) ? cp : (qi == 2) ? -sp : -cp;
    cs = (qi == 0) ? cp : (qi == 1) ? -sp : (qi == 2) ? -cp : sp;
}

DEV int win_srccol(int n) {
    if (n < 672) return n;
    if (n < 704) { const int j = n - 672; return j < 8 ? 672 + j : (j < 14 ? 1832 + (j - 8) : 2990 + (j - 14)); }
    if (n < 1856) return 680 + (n - 704);
    if (n < 3008) return 1838 + (n - 1856);
    if (n < 4032) return n;
    return -1;
}
DEV void transpose_unit(const float* __restrict__ src, int ldsrc, bf16_t* __restrict__ dst, int K, int n0, int k0, bool winmap, char* smem) {
    float* t = (float*)smem;
    int tid_ = threadIdx.x; OPAQUE_V(tid_); const int tid = tid_;
    {
        const int nn = tid & 63, n = n0 + nn; const int sc = winmap ? win_srccol(n) : n;
#pragma unroll
        for (int i = 0; i < 16; ++i) { const int kk = (tid >> 6) + 4 * i; t[kk * 65 + nn] = sc >= 0 ? src[(size_t)(k0 + kk) * ldsrc + sc] : 0.f; }
    }
    __syncthreads();
    {
        const int nn = tid >> 2, kq = tid & 3; float v[16];
#pragma unroll
        for (int j = 0; j < 16; ++j) v[j] = t[(kq * 16 + j) * 65 + nn];
        u32x4* d = (u32x4*)(dst + (size_t)(n0 + nn) * K + k0 + kq * 16);
        d[0] = pack8(v); d[1] = pack8(v + 8);
    }
    __syncthreads();
}
DEV void mod_unit(const Params& p, int L, int cgi, char* smem) {
    float* cs = (float*)smem;
    float* red = (float*)(smem + 32768);
    int tid_ = threadIdx.x; OPAQUE_V(tid_); const int tid = tid_;
#pragma unroll
    for (int i = 0; i < 32; ++i) cs[tid + 256 * i] = p.c[tid + 256 * i];
    __syncthreads();
    const int cc = tid & 31, kk = tid >> 5, col = cgi * 32 + cc;
    float acc[8];
#pragma unroll
    for (int b = 0; b < 8; ++b) acc[b] = 0.f;
    const float* w = p.w_ada + ((size_t)L * 1024 + kk * 128) * 3072 + col;
#pragma unroll 8
    for (int k = 0; k < 128; ++k) {
        const float wv = w[(size_t)k * 3072];
#pragma unroll
        for (int b = 0; b < 8; ++b) acc[b] = fmaf(cs[b * 1024 + kk * 128 + k], wv, acc[b]);
    }
#pragma unroll
    for (int b = 0; b < 8; ++b) red[(kk * 8 + b) * 32 + cc] = acc[b];
    __syncthreads();
    {
        const int b = tid >> 5; float s = p.b_ada[L * 3072 + col];
#pragma unroll
        for (int k2 = 0; k2 < 8; ++k2) s += red[(k2 * 8 + b) * 32 + cc];
        ((float*)(p.ws + WS_MOD))[(L * 8 + b) * 3072 + col] = s;
    }
    __syncthreads();
}
DEV void phase_prep(const Params& p, char* smem) {
    constexpr int N_MOD = 192, N_TAB = 384, N_WIN = 2048, N_WOUT = 512, N_W1 = 128;
    constexpr int TOT = N_MOD + N_TAB + N_WIN + N_WOUT + N_W1;
    for (int u = blockIdx.x; u < TOT; u += gridDim.x) {
        int v = u;
        if (v < N_MOD) { mod_unit(p, v / 96, v % 96, smem); continue; }
        v -= N_MOD;
        if (v < N_TAB) {
            int tx_ = threadIdx.x; OPAQUE_V(tx_); const int idx = v * 256 + tx_;
            if (idx < 65536) {
                const int pos = idx >> 5, i = idx & 31; const float inv = powf(10000.0f, -(float)i / 32.0f);
                float sn, cs; sincos_acc((float)pos * inv, sn, cs);
                ((f32x2*)(p.ws + WS_CS64))[idx] = (f32x2){cs, sn};
            } else {
                const int id2 = idx - 65536; const int pos = id2 >> 4, i = id2 & 15; const float inv = powf(10000.0f, -(float)i / 16.0f);
                float sn, cs; sincos_acc((float)pos * inv, sn, cs);
                ((f32x2*)(p.ws + WS_CS32))[id2] = (f32x2){cs, sn};
            }
            continue;
        }
        v -= N_TAB;
        if (v < N_WIN) { const int L = v >> 10, r = v & 1023, nt = r >> 4, kt = r & 15;
            transpose_unit(p.w_in + (size_t)L * 1024 * 4032, 4032, (bf16_t*)(p.ws + WS_WINT) + (size_t)L * 4096 * 1024, 1024, nt * 64, kt * 64, true, smem); continue; }
        v -= N_WIN;
        if (v < N_WOUT) { const int L = v >> 8, r = v & 255, nt = r >> 4, kt = r & 15;
            transpose_unit(p.w_out + (size_t)L * 1024 * 1024, 1024, (bf16_t*)(p.ws + WS_WOUTT) + (size_t)L * 1024 * 1024, 1024, nt * 64, kt * 64, false, smem); continue; }
        v -= N_WOUT;
        { const int lk = v >> 5, kt = v & 31;
            transpose_unit(p.cmp_w1 + (size_t)lk * 2048 * 64, 64, (bf16_t*)(p.ws + WS_W1T) + (size_t)lk * 64 * 2048, 2048, 0, kt * 64, false, smem); }
    }
}

DEV void phase_u1(const Params& p) {
    const float* mod = (const float*)(p.ws + WS_MOD);
    bf16_t* U = (bf16_t*)(p.ws + WS_U);
    for (int u = blockIdx.x; u < 2048; u += gridDim.x) {
        int tx_ = threadIdx.x; OPAQUE_V(tx_);
#pragma unroll
        for (int i = 0; i < 4; ++i) {
            const int e = tx_ + 256 * i, row = 8 * u + (e >> 7), c8 = (e & 127) * 8, b = row >> 11;
            const f32x4* xp = (const f32x4*)(p.x + (size_t)row * 1024 + c8);
            const f32x4* sh = (const f32x4*)(mod + (size_t)b * 3072 + c8);
            const f32x4* sc = (const f32x4*)(mod + (size_t)b * 3072 + 1024 + c8);
            float v[8];
#pragma unroll
            for (int q = 0; q < 2; ++q) { const f32x4 xv = xp[q], s1 = sc[q], s0 = sh[q];
#pragma unroll
                for (int k = 0; k < 4; ++k) v[4 * q + k] = fmaf(xv[k], 1.0f + s1[k], s0[k]); }
            *(u32x4*)(U + (size_t)row * 1024 + c8) = pack8(v);
        }
    }
}

constexpr int KP = 72, CTP = 132;
DEV void gemm_tile(const bf16_t* __restrict__ X, const bf16_t* __restrict__ W, int K, int m0, int n0, char* smem) {
    int tid_ = threadIdx.x; OPAQUE_V(tid_); const int tid = tid_;
    const int lane = tid & 63, w = __builtin_amdgcn_readfirstlane(tid >> 6), wm = w >> 1, wn = w & 1, r32 = lane & 31, h = lane >> 5;
    const int srow = 8 * w + (lane >> 3), sslot = lane & 7;
    const bf16_t* xg[4]; const bf16_t* wg[4];
#pragma unroll
    for (int i = 0; i < 4; ++i) { const int row = 32 * i + srow, kc = sslot ^ ((row >> 1) & 7);
        xg[i] = X + (size_t)(m0 + row) * K + kc * 8; wg[i] = W + (size_t)(n0 + row) * K + kc * 8; }
#define GEMM_STAGE(buf, kt) do { _Pragma("unroll") for (int i = 0; i < 4; ++i) { \
        __builtin_amdgcn_global_load_lds((const unsigned*)(xg[i] + (kt) * 64), (LDSAS unsigned*)(smem + (buf) * 32768 + (4 * i + w) * 1024), 16, 0, 0); \
        __builtin_amdgcn_global_load_lds((const unsigned*)(wg[i] + (kt) * 64), (LDSAS unsigned*)(smem + (buf) * 32768 + 16384 + (4 * i + w) * 1024), 16, 0, 0); } } while (0)
    f32x16 acc[2][2];
#pragma unroll
    for (int i = 0; i < 2; ++i)
#pragma unroll
        for (int j = 0; j < 2; ++j)
#pragma unroll
            for (int r = 0; r < 16; ++r) acc[i][j][r] = 0.f;
    const int nk = K / 64;
    int offA[2], offB[2];
#pragma unroll
    for (int i = 0; i < 2; ++i) { const int ra = wm * 64 + 32 * i + r32, rb = wn * 64 + 32 * i + r32;
        offA[i] = ra * 128 + ((h ^ ((ra >> 1) & 7)) << 4); offB[i] = rb * 128 + ((h ^ ((rb >> 1) & 7)) << 4); }
    GEMM_STAGE(0, 0);
    asm volatile("s_waitcnt vmcnt(0)" ::: "memory"); __syncthreads();
    for (int kt = 0; kt < nk; ++kt) {
        const int cur = kt & 1;
        if (kt + 1 < nk) GEMM_STAGE(cur ^ 1, kt + 1);
        const char* xs = smem + cur * 32768; const char* ws = xs + 16384;
#pragma unroll
        for (int s = 0; s < 4; ++s) {
            bf16x8 a[2], b[2];
#pragma unroll
            for (int i = 0; i < 2; ++i) { a[i] = *(const bf16x8*)(ws + (offA[i] ^ (s << 5))); b[i] = *(const bf16x8*)(xs + (offB[i] ^ (s << 5))); }
#pragma unroll
            for (int i = 0; i < 2; ++i)
#pragma unroll
                for (int j = 0; j < 2; ++j) acc[i][j] = mfma(a[i], b[j], acc[i][j]);
        }
        asm volatile("s_waitcnt vmcnt(0)" ::: "memory"); __syncthreads();
    }
#undef GEMM_STAGE
    float* Ct = (float*)smem;
#pragma unroll
    for (int i = 0; i < 2; ++i)
#pragma unroll
        for (int j = 0; j < 2; ++j)
#pragma unroll
            for (int a = 0; a < 4; ++a) {
                f32x4 v = {acc[i][j][4 * a], acc[i][j][4 * a + 1], acc[i][j][4 * a + 2], acc[i][j][4 * a + 3]};
                *(f32x4*)(Ct + (wn * 64 + 32 * j + r32) * CTP + wm * 64 + 32 * i + 8 * a + 4 * h) = v;
            }
    __syncthreads();
}

DEV void ld8(const float* Ct, int row, int col, float* v) { const f32x4 a = *(const f32x4*)(Ct + row * CTP + col), b = *(const f32x4*)(Ct + row * CTP + col + 4);
    v[0] = a[0]; v[1] = a[1]; v[2] = a[2]; v[3] = a[3]; v[4] = b[0]; v[5] = b[1]; v[6] = b[2]; v[7] = b[3]; }
DEV void epi_in_chunk(const Params& p, int L, const float* Ct, int m0, int c64, int lc) {
    bf16_t* H = (bf16_t*)(p.ws + WS_H);
    int tid_ = threadIdx.x; OPAQUE_V(tid_); const int tid = tid_, j = tid & 3;
    if (c64 == 63) return;
#pragma unroll
    for (int it = 0; it < 2; ++it) {
        const int row = (tid >> 2) + 64 * it, token = m0 + row, pos = token & 2047, b = token >> 11;
        bf16_t* hrow = H + (size_t)token * HP + c64 * 64;
        float xa[8], xb[8], oa[8], ob[8];
        if (c64 <= 4 || (c64 >= 29 && c64 <= 34) || c64 == 39 || c64 == 40 || c64 == 43 || c64 == 44) {
            const bool isq = (c64 <= 3) || (c64 >= 29 && c64 <= 34); const float sc = isq ? QS : 1.0f;
            ld8(Ct, row, lc + 8 * j, xa); ld8(Ct, row, lc + 32 + 8 * j, xb);
            const f32x4* cp = (const f32x4*)((const f32x2*)(p.ws + WS_CS64) + pos * 32 + 8 * j);
#pragma unroll
            for (int q = 0; q < 4; ++q) { const f32x4 cv = cp[q];
                oa[2 * q] = (xa[2 * q] * cv[0] - xb[2 * q] * cv[1]) * sc; ob[2 * q] = (xa[2 * q] * cv[1] + xb[2 * q] * cv[0]) * sc;
                oa[2 * q + 1] = (xa[2 * q + 1] * cv[2] - xb[2 * q + 1] * cv[3]) * sc; ob[2 * q + 1] = (xa[2 * q + 1] * cv[3] + xb[2 * q + 1] * cv[2]) * sc; }
            if (c64 >= 29 && c64 <= 34) {
                bf16_t* qr = (bf16_t*)(p.ws + WS_QROT) + (size_t)token * 384 + (c64 - 29) * 64;
                *(u32x4*)(qr + 8 * j) = pack8(oa); *(u32x4*)(qr + 32 + 8 * j) = pack8(ob);
#pragma unroll
                for (int e = 0; e < 8; ++e) { oa[e] = xa[e] * sc; ob[e] = xb[e] * sc; }
            }
            *(u32x4*)(hrow + 8 * j) = pack8(oa); *(u32x4*)(hrow + 32 + 8 * j) = pack8(ob);
        } else if (c64 >= 6 && c64 <= 9) {
            const int hh = j >> 1, part = j & 1, ca = 32 * hh + 8 * part;
            ld8(Ct, row, lc + ca, xa); ld8(Ct, row, lc + ca + 16, xb);
            const f32x4* cp = (const f32x4*)((const f32x2*)(p.ws + WS_CS32) + pos * 16 + 8 * part);
#pragma unroll
            for (int q = 0; q < 4; ++q) { const f32x4 cv = cp[q];
                oa[2 * q] = xa[2 * q] * cv[0] - xb[2 * q] * cv[1]; ob[2 * q] = xa[2 * q] * cv[1] + xb[2 * q] * cv[0];
                oa[2 * q + 1] = xa[2 * q + 1] * cv[2] - xb[2 * q + 1] * cv[3]; ob[2 * q + 1] = xa[2 * q + 1] * cv[3] + xb[2 * q + 1] * cv[2]; }
            *(u32x4*)(hrow + ca) = pack8(oa); *(u32x4*)(hrow + ca + 16) = pack8(ob);
        } else if (c64 == 10) {
            if (j < 2) {
                ld8(Ct, row, lc + 8 * j, xa); ld8(Ct, row, lc + 16 + 8 * j, xb);
                const f32x4* cp = (const f32x4*)((const f32x2*)(p.ws + WS_CS32) + pos * 16 + 8 * j);
#pragma unroll
                for (int q = 0; q < 4; ++q) { const f32x4 cv = cp[q];
                    oa[2 * q] = xa[2 * q] * cv[0] - xb[2 * q] * cv[1]; ob[2 * q] = xa[2 * q] * cv[1] + xb[2 * q] * cv[0];
                    oa[2 * q + 1] = xa[2 * q + 1] * cv[2] - xb[2 * q + 1] * cv[3]; ob[2 * q + 1] = xa[2 * q + 1] * cv[3] + xb[2 * q + 1] * cv[2]; }
                *(u32x4*)(hrow + 8 * j) = pack8(oa); *(u32x4*)(hrow + 16 + 8 * j) = pack8(ob);
            } else if (j == 2) {
                ld8(Ct, row, lc + 32, xa);
                float* iw = (float*)(p.ws + WS_IW) + (size_t)token * 8;
                *(f32x4*)iw = (f32x4){xa[0], xa[1], xa[2], xa[3]} * 0.35355339059327373f; *(f32x4*)(iw + 4) = (f32x4){xa[4], xa[5], xa[6], xa[7]} * 0.35355339059327373f;
            } else {
                float* lf = (float*)(p.ws + WS_LOGF); float* gs = (float*)(p.ws + WS_GSIG) + (size_t)token * 20;
#pragma unroll
                for (int e = 0; e < 6; ++e) { const float v = Ct[row * CTP + lc + 40 + e] + p.b_f[L * 6 + e];
                    lf[((size_t)b * 6 + e) * 2048 + pos] = fminf(v, 0.f) - log1pf(expf(-fabsf(v))); }
#pragma unroll
                for (int e = 0; e < 18; ++e) gs[e] = 1.0f / (1.0f + expf(-Ct[row * CTP + lc + 46 + e]));
            }
        } else {
            const bool isq = (c64 >= 11 && c64 <= 16); const bool silu = c64 >= 47; const float sc = isq ? QS : 1.0f;
            ld8(Ct, row, lc + 8 * j, xa); ld8(Ct, row, lc + 32 + 8 * j, xb);
#pragma unroll
            for (int e = 0; e < 8; ++e) {
                float a = xa[e] * sc, bb = xb[e] * sc;
                if (silu) { a = a / (1.0f + __expf(-a)); bb = bb / (1.0f + __expf(-bb)); }
                oa[e] = a; ob[e] = bb;
            }
            *(u32x4*)(hrow + 8 * j) = pack8(oa); *(u32x4*)(hrow + 32 + 8 * j) = pack8(ob);
        }
    }
}
DEV void phase_gemm_in(const Params& p, int L, char* smem) {
    const bf16_t* U = (const bf16_t*)(p.ws + WS_U);
    const bf16_t* W = (const bf16_t*)(p.ws + WS_WINT) + (size_t)L * 4096 * 1024;
    for (int u = blockIdx.x; u < 4096; u += gridDim.x) {
        const int mt = u >> 5, nt = u & 31;
        gemm_tile(U, W, 1024, mt * 128, nt * 128, smem);
        epi_in_chunk(p, L, (const float*)smem, mt * 128, nt * 2, 0);
        epi_in_chunk(p, L, (const float*)smem, mt * 128, nt * 2 + 1, 64);
        __syncthreads();
    }
}
DEV void phase_out(const Params& p, int L, char* smem) {
    const bf16_t* A = (const bf16_t*)(p.ws + WS_MIX);
    const bf16_t* W = (const bf16_t*)(p.ws + WS_WOUTT) + (size_t)L * 1024 * 1024;
    const float* xin = L == 0 ? p.x : p.out;
    float* Z = (float*)(p.ws + WS_H);
    const float* mod = (const float*)(p.ws + WS_MOD) + (size_t)L * 8 * 3072;
    for (int u = blockIdx.x; u < 1024; u += gridDim.x) {
        const int mt = u >> 3, nt = u & 7, m0 = mt * 128, n0 = nt * 128;
        gemm_tile(A, W, 1024, m0, n0, smem);
        const float* Ct = (const float*)smem;
        int tx_ = threadIdx.x; OPAQUE_V(tx_);
#pragma unroll
        for (int i = 0; i < 16; ++i) {
            const int item = tx_ + 256 * i, row = item >> 5, c4 = (item & 31) * 4, token = m0 + row, b = token >> 11;
            const f32x4 y = *(const f32x4*)(Ct + row * CTP + c4);
            const f32x4 xv = *(const f32x4*)(xin + (size_t)token * 1024 + n0 + c4);
            const f32x4 g = *(const f32x4*)(mod + (size_t)b * 3072 + 2048 + n0 + c4);
            f32x4 z;
#pragma unroll
            for (int k = 0; k < 4; ++k) z[k] = fmaf(1.0f + g[k], y[k], ALPHA * xv[k]);
            *(f32x4*)(Z + (size_t)token * 1024 + n0 + c4) = z;
        }
        __syncthreads();
    }
}
DEV void phase_ln(const Params& p, int L) {
    const float* Z = (const float*)(p.ws + WS_H);
    const float* mod = (const float*)(p.ws + WS_MOD) + (size_t)8 * 3072;
    bf16_t* U = (bf16_t*)(p.ws + WS_U);
    for (int u = blockIdx.x; u < 1024; u += gridDim.x) {
        int tx_ = threadIdx.x; OPAQUE_V(tx_);
        const int lane = tx_ & 63, w = tx_ >> 6;
        for (int rr = 0; rr < 4; ++rr) {
            const int row = u * 16 + w * 4 + rr, b = row >> 11;
            f32x4 v[4]; float s = 0.f;
#pragma unroll
            for (int i = 0; i < 4; ++i) { v[i] = *(const f32x4*)(Z + (size_t)row * 1024 + 256 * i + 4 * lane); s += (v[i][0] + v[i][1]) + (v[i][2] + v[i][3]); }
#pragma unroll
            for (int o = 32; o >= 1; o >>= 1) s += __shfl_xor(s, o);
            const float mean = s * (1.0f / 1024.0f); float q = 0.f;
#pragma unroll
            for (int i = 0; i < 4; ++i)
#pragma unroll
                for (int k = 0; k < 4; ++k) { const float d = v[i][k] - mean; q = fmaf(d, d, q); }
#pragma unroll
            for (int o = 32; o >= 1; o >>= 1) q += __shfl_xor(q, o);
            const float rstd = rsqrtf(q * (1.0f / 1024.0f) + 1e-5f);
#pragma unroll
            for (int i = 0; i < 4; ++i) {
                const int col = 256 * i + 4 * lane;
                const f32x4 g = *(const f32x4*)(p.ln_g + L * 1024 + col), bb = *(const f32x4*)(p.ln_b + L * 1024 + col);
                f32x4 o;
#pragma unroll
                for (int k = 0; k < 4; ++k) o[k] = (v[i][k] - mean) * rstd * g[k] + bb[k];
                *(f32x4*)(p.out + (size_t)row * 1024 + col) = o;
                if (L == 0) {
                    const f32x4 sh = *(const f32x4*)(mod + (size_t)b * 3072 + col), sc = *(const f32x4*)(mod + (size_t)b * 3072 + 1024 + col);
                    u32x2 pk; pk.x = cvt_pk(fmaf(o[0], 1.0f + sc[0], sh[0]), fmaf(o[1], 1.0f + sc[1], sh[1])); pk.y = cvt_pk(fmaf(o[2], 1.0f + sc[2], sh[2]), fmaf(o[3], 1.0f + sc[3], sh[3]));
                    *(u32x2*)(U + (size_t)row * 1024 + col) = pk;
                }
            }
        }
    }
}

constexpr int KT_BYTES = 64 * KP * 2, VT_BYTES = 8192;
struct KVRegs { u32x4 k[2], v[2]; };
DEV void kv_load(KVRegs& r, const bf16_t* __restrict__ kg, const bf16_t* __restrict__ vg, size_t pitch, int tid) {
#pragma unroll
    for (int i = 0; i < 2; ++i) { const int c = tid + 256 * i, row = c >> 3, ch = c & 7;
        r.k[i] = *(const u32x4*)(kg + (size_t)row * pitch + ch * 8); r.v[i] = *(const u32x4*)(vg + (size_t)row * pitch + ch * 8); }
}
DEV void kv_store(const KVRegs& r, char* ksm, char* vsm, int tid) {
#pragma unroll
    for (int i = 0; i < 2; ++i) { const int c = tid + 256 * i, row = c >> 3, ch = c & 7;
        *(u32x4*)(ksm + (row * KP + ch * 8) * 2) = r.k[i];
        *(u32x4*)(vsm + (ch >> 2) * 4096 + row * 64 + (ch & 3) * 16) = r.v[i]; }
}
DEV void load_qf(const bf16_t* q  , int h, bf16x8* qf) {
#pragma unroll
    for (int s = 0; s < 4; ++s) qf[s] = *(const bf16x8*)(q + 16 * s + 8 * h);
}
DEV void qk_tile(const char* ksm, const bf16x8* qf, int r32, int h, f32x16& s0, f32x16& s1) {
#pragma unroll
    for (int r = 0; r < 16; ++r) { s0[r] = 0.f; s1[r] = 0.f; }
#pragma unroll
    for (int s = 0; s < 4; ++s) {
        const bf16x8 a0 = *(const bf16x8*)(ksm + (r32 * KP + 16 * s + 8 * h) * 2);
        const bf16x8 a1 = *(const bf16x8*)(ksm + ((32 + r32) * KP + 16 * s + 8 * h) * 2);
        s0 = mfma(a0, qf[s], s0); s1 = mfma(a1, qf[s], s1);
    }
}
DEV void pv_tile(const char* vsm, int kofs, const f32x16& pt, int lane, f32x16& o0, f32x16& o1) {
    const int h = lane >> 5;
    const char* vb = vsm + ((lane >> 4) & 1) * 32 + (lane & 3) * 8 + (4 * h + ((lane & 15) >> 2) + kofs) * 64;
#pragma unroll
    for (int sp = 0; sp < 2; ++sp) {
        bf16x8 pb;
        { u32x4 t; t.x = cvt_pk(pt[8 * sp], pt[8 * sp + 1]); t.y = cvt_pk(pt[8 * sp + 2], pt[8 * sp + 3]); t.z = cvt_pk(pt[8 * sp + 4], pt[8 * sp + 5]); t.w = cvt_pk(pt[8 * sp + 6], pt[8 * sp + 7]); pb = __builtin_bit_cast(bf16x8, t); }
        const bf16x8 a0 = cat4(vtr(vb + (16 * sp) * 64), vtr(vb + (16 * sp + 8) * 64));
        const bf16x8 a1 = cat4(vtr(vb + 4096 + (16 * sp) * 64), vtr(vb + 4096 + (16 * sp + 8) * 64));
        o0 = mfma(a0, pb, o0); o1 = mfma(a1, pb, o1);
    }
}
DEV void flash_update(f32x16& s0, f32x16& s1, float& m, float& l, f32x16& o0, f32x16& o1, const char* vsm, int lane) {
    float mx = NEG_INF;
#pragma unroll
    for (int r = 0; r < 16; ++r) mx = fmaxf(mx, fmaxf(s0[r], s1[r]));
    mx = fmaxf(mx, __shfl_xor(mx, 32));
    const float mn = fmaxf(m, mx), mu = (mn == NEG_INF) ? 0.f : mn;
    const float alpha = fexp2(m - mu);
    m = mn;
    float ps = 0.f;
#pragma unroll
    for (int r = 0; r < 16; ++r) { s0[r] = fexp2(s0[r] - mu); s1[r] = fexp2(s1[r] - mu); ps += s0[r] + s1[r]; }
    l = fmaf(l, alpha, ps);
#pragma unroll
    for (int r = 0; r < 16; ++r) { o0[r] *= alpha; o1[r] *= alpha; }
    pv_tile(vsm, 0, s0, lane, o0, o1);
    pv_tile(vsm, 32, s1, lane, o0, o1);
}
DEV f32x16 qk32(const char* kbase, const bf16x8* qf, int r32, int h) {
    f32x16 s;
#pragma unroll
    for (int r = 0; r < 16; ++r) s[r] = 0.f;
#pragma unroll
    for (int k = 0; k < 4; ++k) { const bf16x8 a = *(const bf16x8*)(kbase + (r32 * KP + 16 * k + 8 * h) * 2); s = mfma(a, qf[k], s); }
    return s;
}
DEV void flash_update32(f32x16& s, float& m, float& l, f32x16& o0, f32x16& o1, const char* vsm, int kofs, int hstride, int lane) {
    float mx = NEG_INF;
#pragma unroll
    for (int r = 0; r < 16; ++r) mx = fmaxf(mx, s[r]);
    mx = fmaxf(mx, __shfl_xor(mx, 32));
    const float mn = fmaxf(m, mx), mu = (mn == NEG_INF) ? 0.f : mn;
    const float alpha = fexp2(m - mu);
    m = mn;
    float ps = 0.f;
#pragma unroll
    for (int r = 0; r < 16; ++r) { s[r] = fexp2(s[r] - mu); ps += s[r]; }
    l = fmaf(l, alpha, ps);
#pragma unroll
    for (int r = 0; r < 16; ++r) { o0[r] *= alpha; o1[r] *= alpha; }
    const int h = lane >> 5;
    const char* vb = vsm + ((lane >> 4) & 1) * 32 + (lane & 3) * 8 + (4 * h + ((lane & 15) >> 2) + kofs) * 64;
#pragma unroll
    for (int sp = 0; sp < 2; ++sp) {
        u32x4 t; t.x = cvt_pk(s[8 * sp], s[8 * sp + 1]); t.y = cvt_pk(s[8 * sp + 2], s[8 * sp + 3]); t.z = cvt_pk(s[8 * sp + 4], s[8 * sp + 5]); t.w = cvt_pk(s[8 * sp + 6], s[8 * sp + 7]);
        const bf16x8 pb = __builtin_bit_cast(bf16x8, t);
        const bf16x8 a0 = cat4(vtr(vb + (16 * sp) * 64), vtr(vb + (16 * sp + 8) * 64));
        const bf16x8 a1 = cat4(vtr(vb + hstride + (16 * sp) * 64), vtr(vb + hstride + (16 * sp + 8) * 64));
        o0 = mfma(a0, pb, o0); o1 = mfma(a1, pb, o1);
    }
}
DEV void write_mix(const Params& p, size_t token, int mixcol0, const f32x16& o0, const f32x16& o1, int h) {
    const bf16_t* G = (const bf16_t*)(p.ws + WS_H) + token * HP + C_GATE + mixcol0;
    bf16_t* M = (bf16_t*)(p.ws + WS_MIX) + token * 1024 + mixcol0;
#pragma unroll
    for (int dt = 0; dt < 2; ++dt)
#pragma unroll
        for (int a = 0; a < 4; ++a) {
            const int d = 32 * dt + 8 * a + 4 * h;
            const u32x2 g = *(const u32x2*)(G + d);
            const f32x16& o = dt ? o1 : o0;
            u32x2 r; r.x = cvt_pk(o[4 * a] * bf_lo(g.x), o[4 * a + 1] * bf_hi(g.x)); r.y = cvt_pk(o[4 * a + 2] * bf_lo(g.y), o[4 * a + 3] * bf_hi(g.y));
            *(u32x2*)(M + d) = r;
        }
}

DEV void fox_unit(const Params& p, int b, int hh, int qb, char* smem) {
    char* ksm = smem; char* vsm = smem + KT_BYTES; float* cum = (float*)(smem + KT_BYTES + VT_BYTES);
    float* wtot = cum + 2048;
    int tid_ = threadIdx.x; OPAQUE_V(tid_); const int tid = tid_, lane = tid & 63, w = tid >> 6, r32 = lane & 31, h = lane >> 5;
    const int q0 = qb * 128, nneed = q0 + 128;
    const bf16_t* H = (const bf16_t*)(p.ws + WS_H) + (size_t)b * S * HP;
    {
        const float* lf = (const float*)(p.ws + WS_LOGF) + ((size_t)b * 6 + hh) * 2048;
        float v[8]; float s = 0.f;
        if (tid * 8 < nneed) { const f32x4 a = *(const f32x4*)(lf + tid * 8), c = *(const f32x4*)(lf + tid * 8 + 4);
            v[0] = a[0]; v[1] = a[1]; v[2] = a[2]; v[3] = a[3]; v[4] = c[0]; v[5] = c[1]; v[6] = c[2]; v[7] = c[3]; }
        else {
#pragma unroll
            for (int e = 0; e < 8; ++e) v[e] = 0.f; }
#pragma unroll
        for (int e = 0; e < 8; ++e) { s += v[e]; v[e] = s; }
        float inc = s;
#pragma unroll
        for (int o = 1; o < 64; o <<= 1) { const float t = __shfl_up(inc, o); if (lane >= o) inc += t; }
        if (lane == 63) wtot[w] = inc;
        __syncthreads();
        float base = inc - s;
        for (int k = 0; k < w; ++k) base += wtot[k];
        if (tid * 8 < nneed) {
#pragma unroll
            for (int e = 0; e < 8; ++e) cum[tid * 8 + e] = (base + v[e]) * LOG2E; }
        __syncthreads();
    }
    const int tq = q0 + 32 * w + r32;
    bf16x8 qf[4]; load_qf(H + (size_t)tq * HP + C_FOXQ + 64 * hh, h, qf);
    const float cb = cum[tq];
    float m = NEG_INF, l = 0.f; f32x16 o0, o1;
#pragma unroll
    for (int r = 0; r < 16; ++r) { o0[r] = 0.f; o1[r] = 0.f; }
    const int ntiles = nneed / 64, mylast = (q0 + 32 * w + 31) >> 6;
    KVRegs kvr; kv_load(kvr, H + C_FOXK + 64 * hh, H + C_FOXV + 64 * hh, HP, tid);
    for (int kt = 0; kt < ntiles; ++kt) {
        __syncthreads();
        kv_store(kvr, ksm, vsm, tid);
        __syncthreads();
        if (kt + 1 < ntiles) kv_load(kvr, H + (size_t)(kt + 1) * 64 * HP + C_FOXK + 64 * hh, H + (size_t)(kt + 1) * 64 * HP + C_FOXV + 64 * hh, HP, tid);
        if (kt <= mylast) {
            f32x16 s0, s1; qk_tile(ksm, qf, r32, h, s0, s1);
            int lim = tq - 64 * kt - 4 * h; OPAQUE_V(lim);
#pragma unroll
            for (int a = 0; a < 4; ++a) {
                const f32x4 c0 = *(const f32x4*)(cum + kt * 64 + 8 * a + 4 * h), c1 = *(const f32x4*)(cum + kt * 64 + 32 + 8 * a + 4 * h);
#pragma unroll
                for (int k = 0; k < 4; ++k) {
                    s0[4 * a + k] = (8 * a + k) <= lim ? s0[4 * a + k] + (cb - c0[k]) : NEG_INF;
                    s1[4 * a + k] = (8 * a + k + 32) <= lim ? s1[4 * a + k] + (cb - c1[k]) : NEG_INF;
                }
            }
            flash_update(s0, s1, m, l, o0, o1, vsm, lane);
        }
    }
    l += __shfl_xor(l, 32);
    const float inv = 1.0f / l;
#pragma unroll
    for (int r = 0; r < 16; ++r) { o0[r] *= inv; o1[r] *= inv; }
    write_mix(p, (size_t)b * S + tq, 256 + 64 * hh, o0, o1, h);
    __syncthreads();
}

constexpr int BMP = 65;
#ifndef DSA_REP_TOPK
#define DSA_REP_TOPK 1
#endif
#ifndef DSA_REP_IDX
#define DSA_REP_IDX 1
#endif
DEV unsigned ford(float f) { const unsigned u = __float_as_uint(f); return u ^ ((u >> 31) ? 0xffffffffu : 0x80000000u); }
constexpr int TK_NB = 256;
DEV unsigned topk_T_slow(const unsigned (&u)[32], int nch) {
    unsigned T = 0u;
    for (int bit = 31; bit >= 0; --bit) {
        const unsigned cand = T | (1u << bit); int cnt = 0;
#pragma unroll
        for (int i = 0; i < 32; ++i) if (i < nch) cnt += __popcll(__ballot(u[i] >= cand));
        if (cnt >= 256) T = cand;
    }
    return T;
}
DEV unsigned funord(unsigned k) { return k ^ ((k >> 31) ? 0x80000000u : 0xffffffffu); }
DEV void topk_row(const float* sc, int n, unsigned* bmrow, unsigned* hist  , int lane) {
    const int nch = (n + 63) >> 6;
    if (n <= 256) {
        for (int i = 0; i < 32; ++i) {
            const int lo = 64 * i; unsigned long long msk = 0ull;
            if (lo < n) { const int c = n - lo; msk = c >= 64 ? ~0ull : ((1ull << c) - 1ull); }
            if (lane == 0) { bmrow[2 * i] = (unsigned)msk; bmrow[2 * i + 1] = (unsigned)(msk >> 32); }
        }
        return;
    }
    unsigned u[32];
    unsigned kmin = 0xffffffffu, kmax = 0u;
#pragma unroll
    for (int i = 0; i < 32; ++i) { const int idx = 64 * i + lane; const bool ok = (i < nch) && idx < n; u[i] = ok ? ford(sc[idx]) : 0u;
        kmin = ok ? (u[i] < kmin ? u[i] : kmin) : kmin; kmax = u[i] > kmax ? u[i] : kmax; }
#pragma unroll
    for (int o = 32; o >= 1; o >>= 1) { const unsigned a = __shfl_xor(kmin, o), b = __shfl_xor(kmax, o); kmin = a < kmin ? a : kmin; kmax = b > kmax ? b : kmax; }
    unsigned T;
    const float vmin = __uint_as_float(funord(kmin)), vmax = __uint_as_float(funord(kmax));
    if (!(vmax > vmin)) T = kmax;
    else {
        const float scale = (float)TK_NB / (vmax - vmin);
#pragma unroll
        for (int q = 0; q < TK_NB / 64; ++q) hist[64 * q + lane] = 0u;
        __builtin_amdgcn_wave_barrier();
#pragma unroll
        for (int i = 0; i < 32; ++i) if (i < nch) {
            if (u[i] != 0u) { int b = (int)((__uint_as_float(funord(u[i])) - vmin) * scale); b = b > TK_NB - 1 ? TK_NB - 1 : b; atomicAdd(&hist[b], 1u); }
        }
        __builtin_amdgcn_wave_barrier();
        unsigned hb[4]; unsigned sl = 0u;
#pragma unroll
        for (int q = 0; q < 4; ++q) { hb[q] = hist[4 * lane + q]; sl += hb[q]; }
        unsigned suf = sl;
#pragma unroll
        for (int o = 1; o < 64; o <<= 1) { const unsigned t = __shfl_down(suf, o); if (lane + o < 64) suf += t; }
        const unsigned long long ge = __ballot(suf >= 256u);
        const int Ls = 63 - __clzll(ge);
        unsigned above = suf - sl;
        int bstar = 4 * lane; unsigned abv = above;
        { unsigned cum = above; bool found = false;
#pragma unroll
          for (int q = 3; q >= 0; --q) { if (!found && cum + hb[q] >= 256u) { bstar = 4 * lane + q; abv = cum; found = true; } cum += hb[q]; } }
        bstar = __shfl(bstar, Ls); abv = __shfl(abv, Ls);
        const int need = 256 - (int)abv;
        const unsigned cntb = hist[bstar];
        __builtin_amdgcn_wave_barrier();
        if (cntb > (unsigned)TK_NB) T = topk_T_slow(u, nch);
        else {
            int base = 0;
            const unsigned long long lt = (1ull << lane) - 1ull;
#pragma unroll
            for (int i = 0; i < 32; ++i) if (i < nch) {
                bool isb = false;
                if (u[i] != 0u) { int b = (int)((__uint_as_float(funord(u[i])) - vmin) * scale); b = b > TK_NB - 1 ? TK_NB - 1 : b; isb = (b == bstar); }
                const unsigned long long bal = __ballot(isb);
                if (isb) hist[base + __popcll(bal & lt)] = u[i];
                base += __popcll(bal);
            }
            __builtin_amdgcn_wave_barrier();
            unsigned c[TK_NB / 64];
#pragma unroll
            for (int q = 0; q < TK_NB / 64; ++q) c[q] = (64 * q + lane < (int)cntb) ? hist[64 * q + lane] : 0u;
            const int ncq = ((int)cntb + 63) >> 6;
            T = 0u;
            for (int bit = 31; bit >= 0; --bit) {
                const unsigned cand = T | (1u << bit); int cnt = 0;
#pragma unroll
                for (int q = 0; q < TK_NB / 64; ++q) if (q < ncq) cnt += __popcll(__ballot(c[q] >= cand));
                if (cnt >= need) T = cand;
            }
            __builtin_amdgcn_wave_barrier();
        }
    }
    int ngt = 0;
#pragma unroll
    for (int i = 0; i < 32; ++i) if (i < nch) ngt += __popcll(__ballot(u[i] > T));
    const int need = 256 - ngt; int running = 0;
    const unsigned long long lt = (1ull << lane) - 1ull;
#pragma unroll
    for (int i = 0; i < 32; ++i) {
        unsigned long long sm = 0ull;
        if (i < nch) {
            const bool eq = u[i] == T; const unsigned long long bal = __ballot(eq);
            const int pre = running + __popcll(bal & lt);
            const bool sel = (u[i] > T) || (eq && pre < need);
            running += __popcll(bal);
            sm = __ballot(sel);
        }
        if (lane == 0) { bmrow[2 * i] = (unsigned)sm; bmrow[2 * i + 1] = (unsigned)(sm >> 32); }
    }
}
DEV void dsa_unit(const Params& p, int b, int qb, char* smem) {
    float* sc = (float*)smem;
    unsigned* bm = (unsigned*)(smem + 65536);
    unsigned* hist = (unsigned*)(smem + 65536 + 32 * BMP * 4) + (threadIdx.x >> 6) * TK_NB;
    char* ksm = smem; char* vsm = smem + KT_BYTES;
    int tid_ = threadIdx.x; OPAQUE_V(tid_); const int tid = tid_, lane = tid & 63, w = tid >> 6, r32 = lane & 31, h = lane >> 5;
    const int t0 = qb * 32;
    const bf16_t* H = (const bf16_t*)(p.ws + WS_H) + (size_t)b * S * HP;
    const float* IW = (const float*)(p.ws + WS_IW) + (size_t)b * S * 8;
    for (int sb = 0; sb < 4; ++sb) {
        const int ts = t0 + 8 * sb, nkeys = ts + 8, nkt = (nkeys + 31) >> 5;
        const int tl = 2 * ((r32 >> 2) & 1) + (r32 >> 4), head = ((r32 >> 3) & 1) * 4 + (r32 & 3);
        bf16x8 af[2][2]; f32x4 wv[2][4];
#pragma unroll
        for (int mt = 0; mt < 2; ++mt) {
#pragma unroll
            for (int ks = 0; ks < 2; ++ks) af[mt][ks] = *(const bf16x8*)(H + (size_t)(ts + 4 * mt + tl) * HP + C_IDXQ + 32 * head + 16 * ks + 8 * h);
#pragma unroll
            for (int a = 0; a < 4; ++a) wv[mt][a] = *(const f32x4*)(IW + (size_t)(ts + 4 * mt + 2 * h + (a >> 1)) * 8 + (a & 1) * 4);
        }
#pragma unroll 1
        for (int rep_ = 0; rep_ < DSA_REP_IDX; ++rep_) {
        bf16x8 bfn[2];
        if (w < nkt) {
#pragma unroll
            for (int ks = 0; ks < 2; ++ks) bfn[ks] = *(const bf16x8*)(H + (size_t)(32 * w + r32) * HP + C_IDXK + 16 * ks + 8 * h); }
        for (int kt = w; kt < nkt; kt += 4) {
            const int key = 32 * kt + r32;
            bf16x8 bf[2]; bf[0] = bfn[0]; bf[1] = bfn[1];
            if (kt + 4 < nkt) {
#pragma unroll
                for (int ks = 0; ks < 2; ++ks) bfn[ks] = *(const bf16x8*)(H + (size_t)(key + 128) * HP + C_IDXK + 16 * ks + 8 * h); }
#pragma unroll
            for (int mt = 0; mt < 2; ++mt) {
                f32x16 acc;
#pragma unroll
                for (int r = 0; r < 16; ++r) acc[r] = 0.f;
                acc = mfma(af[mt][0], bf[0], acc); acc = mfma(af[mt][1], bf[1], acc);
                float sA = 0.f, sB = 0.f;
#pragma unroll
                for (int a = 0; a < 2; ++a)
#pragma unroll
                    for (int k = 0; k < 4; ++k) { sA = fmaf(wv[mt][a][k], fmaxf(acc[4 * a + k], 0.f), sA); sB = fmaf(wv[mt][a + 2][k], fmaxf(acc[4 * (a + 2) + k], 0.f), sB); }
                const int rowA = 4 * mt + 2 * h, tokA = ts + rowA;
                sc[rowA * 2048 + key] = key <= tokA ? sA : NEG_INF;
                sc[(rowA + 1) * 2048 + key] = key <= tokA + 1 ? sB : NEG_INF;
            }
        }
        }
        __syncthreads();
#pragma unroll 1
        for (int rr = 0; rr < 2 * DSA_REP_TOPK; ++rr) { const int row = 2 * w + (rr & 1); topk_row(sc + row * 2048, ts + row + 1, bm + (8 * sb + row) * BMP, hist, lane); }
        __syncthreads();
    }
    const int tq = t0 + r32;
    bf16x8 qf[4]; load_qf(H + (size_t)tq * HP + C_DSAQ + 64 * w, h, qf);
    float m = NEG_INF, l = 0.f; f32x16 o0, o1;
#pragma unroll
    for (int r = 0; r < 16; ++r) { o0[r] = 0.f; o1[r] = 0.f; }
    const int ntiles = ((t0 + 31) >> 6) + 1;
    KVRegs kvr; kv_load(kvr, H + C_DSAK, H + C_DSAV, HP, tid);
    for (int kt = 0; kt < ntiles; ++kt) {
        __syncthreads();
        kv_store(kvr, ksm, vsm, tid);
        __syncthreads();
        if (kt + 1 < ntiles) kv_load(kvr, H + (size_t)(kt + 1) * 64 * HP + C_DSAK, H + (size_t)(kt + 1) * 64 * HP + C_DSAV, HP, tid);
        f32x16 s0, s1; qk_tile(ksm, qf, r32, h, s0, s1);
        const unsigned w0 = bm[r32 * BMP + 2 * kt] >> (4 * h), w1 = bm[r32 * BMP + 2 * kt + 1] >> (4 * h);
#pragma unroll
        for (int r = 0; r < 16; ++r) { const int bit = (r & 3) + 8 * (r >> 2);
            s0[r] = ((w0 >> bit) & 1u) ? s0[r] : NEG_INF; s1[r] = ((w1 >> bit) & 1u) ? s1[r] : NEG_INF; }
        flash_update(s0, s1, m, l, o0, o1, vsm, lane);
    }
    l += __shfl_xor(l, 32);
    const float inv = l > 0.f ? 1.0f / l : 0.f;
#pragma unroll
    for (int r = 0; r < 16; ++r) { o0[r] *= inv; o1[r] *= inv; }
    write_mix(p, (size_t)b * S + tq, 64 * w, o0, o1, h);
    __syncthreads();
}

DEV void cmp_unit(const Params& p, int L, int kv, int b, int g, int cc, char* smem) {
    float* red = (float*)smem;
    float* hid = (float*)(smem + 32768);
    int tid_ = threadIdx.x; OPAQUE_V(tid_); const int tid = tid_, lane = tid & 63, w = tid >> 6, r32 = lane & 31, h = lane >> 5;
    const bf16_t* H = (const bf16_t*)(p.ws + WS_H) + (size_t)b * S * HP + (kv ? C_VC : C_KC) + 64 * g;
    const bf16_t* W1 = (const bf16_t*)(p.ws + WS_W1T) + (size_t)(L * 2 + kv) * 64 * 2048;
    const float* pe = p.cmp_pe + (size_t)(L * 2 + kv) * 32 * 64;
    int c = cc * 32 + r32; if (c > 126) c = 126;
    f32x16 acc[2];
#pragma unroll
    for (int r = 0; r < 16; ++r) { acc[0][r] = 0.f; acc[1][r] = 0.f; }
#pragma unroll 4
    for (int ks = w * 32; ks < w * 32 + 32; ++ks) {
        const int li = ks >> 2, d0 = (ks & 3) * 16 + 8 * h;
        const u32x4 raw = *(const u32x4*)(H + (size_t)(16 * c + li) * HP + d0);
        const f32x4 p0 = *(const f32x4*)(pe + li * 64 + d0), p1 = *(const f32x4*)(pe + li * 64 + d0 + 4);
        u32x4 t; t.x = cvt_pk(bf_lo(raw.x) + p0[0], bf_hi(raw.x) + p0[1]); t.y = cvt_pk(bf_lo(raw.y) + p0[2], bf_hi(raw.y) + p0[3]);
        t.z = cvt_pk(bf_lo(raw.z) + p1[0], bf_hi(raw.z) + p1[1]); t.w = cvt_pk(bf_lo(raw.w) + p1[2], bf_hi(raw.w) + p1[3]);
        const bf16x8 a = __builtin_bit_cast(bf16x8, t);
#pragma unroll
        for (int nt = 0; nt < 2; ++nt) { const bf16x8 bw = *(const bf16x8*)(W1 + (size_t)(32 * nt + r32) * 2048 + 16 * ks + 8 * h); acc[nt] = mfma(a, bw, acc[nt]); }
    }
#pragma unroll
    for (int nt = 0; nt < 2; ++nt)
#pragma unroll
        for (int r = 0; r < 16; ++r) red[(w * 32 + crow(r, h)) * 64 + 32 * nt + r32] = acc[nt][r];
    __syncthreads();
#pragma unroll
    for (int i = 0; i < 8; ++i) { const int e = tid + 256 * i; const float v = red[e] + red[2048 + e] + red[4096 + e] + red[6144 + e]; hid[e] = v / (1.0f + __expf(-v)); }
    __syncthreads();
    {
        const int cl = tid >> 3, n2 = (tid & 7) * 8; const float* w2 = p.cmp_w2 + (size_t)(L * 2 + kv) * 64 * 64;
        float o[8];
#pragma unroll
        for (int e = 0; e < 8; ++e) o[e] = 0.f;
        for (int n = 0; n < 64; ++n) { const float hv = hid[cl * 64 + n]; const f32x4 wa = *(const f32x4*)(w2 + n * 64 + n2), wb = *(const f32x4*)(w2 + n * 64 + n2 + 4);
#pragma unroll
            for (int e = 0; e < 4; ++e) { o[e] = fmaf(hv, wa[e], o[e]); o[4 + e] = fmaf(hv, wb[e], o[4 + e]); } }
        const int cg_ = cc * 32 + cl;
        if (cg_ >= 127) {
#pragma unroll
            for (int e = 0; e < 8; ++e) o[e] = 0.f; }
        bf16_t* dst = (bf16_t*)(p.ws + (kv ? WS_VC : WS_KC)) + ((size_t)(b * 2 + g) * 128 + cg_) * 64 + n2;
        *(u32x4*)dst = pack8(o);
    }
    __syncthreads();
}

constexpr int KC_BYTES = 128 * KP * 2;
DEV void nsa_unit(const Params& p, int b, int g, int qb, int j, char* smem) {
    char* kcs = smem;
    char* vcs = smem + KC_BYTES;
    char* ksm = smem + KC_BYTES + 16384;
    char* vsm = ksm + KT_BYTES;
    float* scr = (float*)(vsm + VT_BYTES);
    unsigned* uni = (unsigned*)(scr + 4 * 32 * 33);
    int tid_ = threadIdx.x; OPAQUE_V(tid_); const int tid = tid_, lane = tid & 63, w = tid >> 6, r32 = lane & 31, h = lane >> 5;
    const int q0 = qb * 128, tq = q0 + 32 * w + r32;
    const bf16_t* H = (const bf16_t*)(p.ws + WS_H) + (size_t)b * S * HP;
    {
        const bf16_t* kc = (const bf16_t*)(p.ws + WS_KC) + (size_t)(b * 2 + g) * 128 * 64;
        const bf16_t* vc = (const bf16_t*)(p.ws + WS_VC) + (size_t)(b * 2 + g) * 128 * 64;
#pragma unroll
        for (int i = 0; i < 4; ++i) { const int c = tid + 256 * i, row = c >> 3, ch = c & 7;
            *(u32x4*)(kcs + (row * KP + ch * 8) * 2) = *(const u32x4*)(kc + row * 64 + ch * 8);
            *(u32x4*)(vcs + (ch >> 2) * 8192 + row * 64 + (ch & 3) * 16) = *(const u32x4*)(vc + row * 64 + ch * 8); }
    }
    __syncthreads();
    const int clim_ = tq >= 31 ? ((tq - 31) >> 4) : -1;
    const int climh = (clim_ > 126 ? 126 : clim_) - 4 * h;
    float B4[16], E[16];
#pragma unroll
    for (int i = 0; i < 16; ++i) { B4[i] = 0.f; E[i] = 0.f; }
#pragma unroll 1
    for (int jj = 0; jj < 3; ++jj) {
        bf16x8 qf[4]; load_qf(H + (size_t)tq * HP + C_NSAQ + 64 * (3 * g + jj), h, qf);
        float mrun = NEG_INF, lrun = 0.f;
#pragma unroll
        for (int n = 0; n < 4; ++n) {
            f32x16 st = qk32(kcs + n * 32 * KP * 2, qf, r32, h);
            float mx = NEG_INF;
            int lim = climh; OPAQUE_V(lim);
#pragma unroll
            for (int r = 0; r < 16; ++r) { st[r] = (32 * n + CR(r)) <= lim ? st[r] : NEG_INF; mx = fmaxf(mx, st[r]); }
            const float mn = fmaxf(mrun, mx), mu = mn == NEG_INF ? 0.f : mn;
            float ps = 0.f;
#pragma unroll
            for (int r = 0; r < 16; ++r) ps += fexp2(st[r] - mu);
            lrun = fmaf(lrun, fexp2(mrun - mu), ps); mrun = mn;
            __builtin_amdgcn_sched_barrier(0);
        }
        const float mo = __shfl_xor(mrun, 32), lo = __shfl_xor(lrun, 32);
        const float M = fmaxf(mrun, mo), Mu = M == NEG_INF ? 0.f : M;
        const float Lt = lrun * fexp2(mrun - Mu) + lo * fexp2(mo - Mu);
        const float inv = 1.0f / fmaxf(Lt, 1e-30f);
#pragma unroll
        for (int n = 0; n < 4; ++n) {
            f32x16 st = qk32(kcs + n * 32 * KP * 2, qf, r32, h);
            int lim = climh; OPAQUE_V(lim);
#pragma unroll
            for (int a = 0; a < 4; ++a) {
                float pr[4];
#pragma unroll
                for (int k = 0; k < 4; ++k) pr[k] = (32 * n + 8 * a + k) <= lim ? fexp2(st[4 * a + k] - Mu) * inv : 0.f;
                B4[4 * n + a] += (pr[0] + pr[1]) + (pr[2] + pr[3]); E[4 * n + a] += pr[3];
            }
            __builtin_amdgcn_sched_barrier(0);
        }
    }
    {
        float* my = scr + (w * 32 + r32) * 33;
#pragma unroll
        for (int i = 0; i < 16; ++i) { const float eo = __shfl_xor(E[i], 32); E[i] = eo; }
#pragma unroll
        for (int i = 0; i < 16; ++i) { const float prev = h ? E[i] : (i > 0 ? E[i - 1] : 0.f); my[2 * i + h] = B4[i] + prev; }
    }
    __builtin_amdgcn_wave_barrier();
    unsigned sel;
    {
        const float* my = scr + (w * 32 + r32) * 33; const int cur = tq >> 6;
        float v[32];
#pragma unroll
        for (int n = 0; n < 32; ++n) { float s_ = my[n]; const bool forced = (n == 0) || (n == cur) || (n == cur - 1); const bool fut = 64 * n > tq;
            v[n] = forced ? __builtin_huge_valf() : (fut ? NEG_INF : s_); }
        unsigned mk = 0u;
#pragma unroll
        for (int i = 0; i < 32; ++i) {
            int rank = 0;
#pragma unroll
            for (int n = 0; n < 32; ++n) { if (n < i) rank += (v[n] >= v[i]) ? 1 : 0; else if (n > i) rank += (v[n] > v[i]) ? 1 : 0; }
            if (rank < 16 && 64 * i <= tq) mk |= 1u << i;
        }
        sel = mk;
    }
    unsigned wsel = sel;
#pragma unroll
    for (int o = 16; o >= 1; o >>= 1) wsel |= __shfl_xor(wsel, o);
    if (lane == 0) uni[w] = wsel;
    __syncthreads();
    const unsigned bsel = uni[0] | uni[1] | uni[2] | uni[3];
    const float* gs = (const float*)(p.ws + WS_GSIG) + ((size_t)b * S + tq) * 20;
    const float g0 = gs[0 * 6 + g * 3 + j], g1 = gs[1 * 6 + g * 3 + j], g2 = gs[2 * 6 + g * 3 + j];
    f32x16 ot0, ot1;
    {
        bf16x8 qf[4]; load_qf(H + (size_t)tq * HP + C_NSAQ + 64 * (3 * g + j), h, qf);
        float m = NEG_INF, l = 0.f; f32x16 o0, o1;
#pragma unroll
        for (int r = 0; r < 16; ++r) { o0[r] = 0.f; o1[r] = 0.f; }
#pragma unroll 1
        for (int n = 0; n < 4; ++n) {
            f32x16 st = qk32(kcs + n * 32 * KP * 2, qf, r32, h);
            int lim = climh - 32 * n; OPAQUE_V(lim);
#pragma unroll
            for (int r = 0; r < 16; ++r) st[r] = CR(r) <= lim ? st[r] : NEG_INF;
            flash_update32(st, m, l, o0, o1, vcs, 32 * n, 8192, lane);
        }
        l += __shfl_xor(l, 32);
        const float sc_ = l > 0.f ? g0 / l : 0.f;
#pragma unroll
        for (int r = 0; r < 16; ++r) { ot0[r] = o0[r] * sc_; ot1[r] = o1[r] * sc_; }
    }
    bf16x8 qr[4]; load_qf((const bf16_t*)(p.ws + WS_QROT) + ((size_t)b * S + tq) * 384 + 64 * (3 * g + j), h, qr);
    {
        float m = NEG_INF, l = 0.f; f32x16 o0, o1;
#pragma unroll
        for (int r = 0; r < 16; ++r) { o0[r] = 0.f; o1[r] = 0.f; }
        unsigned rem = bsel;
        KVRegs kvr; kv_load(kvr, H + C_KS + 64 * g, H + C_VS + 64 * g, HP, tid);
        while (rem) {
            const int nb = __ffs(rem) - 1; rem &= rem - 1u;
            __syncthreads();
            kv_store(kvr, ksm, vsm, tid);
            __syncthreads();
            if (rem) { const int nx = __ffs(rem) - 1; kv_load(kvr, H + (size_t)nx * 64 * HP + C_KS + 64 * g, H + (size_t)nx * 64 * HP + C_VS + 64 * g, HP, tid); }
            if ((wsel >> nb) & 1u) {
                f32x16 s0, s1; qk_tile(ksm, qr, r32, h, s0, s1);
                int lim = ((sel >> nb) & 1u) ? tq - 64 * nb - 4 * h : -1; OPAQUE_V(lim);
#pragma unroll
                for (int r = 0; r < 16; ++r) { s0[r] = CR(r) <= lim ? s0[r] : NEG_INF; s1[r] = (CR(r) + 32) <= lim ? s1[r] : NEG_INF; }
                flash_update(s0, s1, m, l, o0, o1, vsm, lane);
            }
        }
        l += __shfl_xor(l, 32);
        const float sc_ = l > 0.f ? g1 / l : 0.f;
#pragma unroll
        for (int r = 0; r < 16; ++r) { ot0[r] = fmaf(o0[r], sc_, ot0[r]); ot1[r] = fmaf(o1[r], sc_, ot1[r]); }
    }
    {
        float m = NEG_INF, l = 0.f; f32x16 o0, o1;
#pragma unroll
        for (int r = 0; r < 16; ++r) { o0[r] = 0.f; o1[r] = 0.f; }
        const int kfirst = q0 >= 512 ? (q0 - 512) >> 6 : 0, klast = (q0 + 127) >> 6;
        const int wt0 = q0 + 32 * w;
        const int wfirst = wt0 >= 511 ? (wt0 - 511) >> 6 : 0, wlast = (wt0 + 31) >> 6;
        KVRegs kvr; kv_load(kvr, H + (size_t)kfirst * 64 * HP + C_KW + 64 * g, H + (size_t)kfirst * 64 * HP + C_VW + 64 * g, HP, tid);
        for (int kt = kfirst; kt <= klast; ++kt) {
            __syncthreads();
            kv_store(kvr, ksm, vsm, tid);
            __syncthreads();
            if (kt < klast) kv_load(kvr, H + (size_t)(kt + 1) * 64 * HP + C_KW + 64 * g, H + (size_t)(kt + 1) * 64 * HP + C_VW + 64 * g, HP, tid);
            if (kt >= wfirst && kt <= wlast) {
                f32x16 s0, s1; qk_tile(ksm, qr, r32, h, s0, s1);
                int lim = tq - 64 * kt - 4 * h; OPAQUE_V(lim);
#pragma unroll
                for (int r = 0; r < 16; ++r) { s0[r] = (unsigned)(lim - CR(r)) < 512u ? s0[r] : NEG_INF; s1[r] = (unsigned)(lim - CR(r) - 32) < 512u ? s1[r] : NEG_INF; }
                flash_update(s0, s1, m, l, o0, o1, vsm, lane);
            }
        }
        l += __shfl_xor(l, 32);
        const float sc_ = l > 0.f ? g2 / l : 0.f;
#pragma unroll
        for (int r = 0; r < 16; ++r) { ot0[r] = fmaf(o0[r], sc_, ot0[r]); ot1[r] = fmaf(o1[r], sc_, ot1[r]); }
    }
    write_mix(p, (size_t)b * S + tq, 640 + 64 * (3 * g + j), ot0, ot1, h);
    __syncthreads();
}


#define XB_TMO      128
#define XB_XCNT(j)  (256  + 64 * (j))
#define XB_XSUB(j)  (1280 + 64 * (j))
#define XB_XGEN(j)  (2304 + 64 * (j))
#define XB_TOP      3328
#define XB_TOPGEN   3392
#define XCD_BAR_WORDS 3456
#define XB_SPIN_CAP (1u << 22)
DEV unsigned xb_ld(unsigned* p) { return __hip_atomic_load(p, __ATOMIC_RELAXED, __HIP_MEMORY_SCOPE_AGENT); }
DEV unsigned xb_add(unsigned* p, unsigned v) { return __hip_atomic_fetch_add(p, v, __ATOMIC_RELAXED, __HIP_MEMORY_SCOPE_AGENT); }
DEV unsigned xb_xcc_id() { return (unsigned)__builtin_amdgcn_s_getreg((3 << 11) | 20) & 0xFu; }
#define XB_SPIN(cond, bar) do { unsigned _sp = 0; while (cond) { __builtin_amdgcn_s_sleep(1); \
    if ((++_sp & 255u) == 0u) { if (xb_ld(&(bar)[XB_TMO])) break; if (_sp > XB_SPIN_CAP) { atomicAdd(&(bar)[XB_TMO], 1u); break; } } } } while (0)
struct XcdBarrier { unsigned* bar; unsigned x; volatile LDSAS unsigned* st; };
DEV XcdBarrier xcd_barrier_post(unsigned* bar, volatile LDSAS unsigned* st) {
    XcdBarrier b; b.bar = bar; b.x = xb_xcc_id(); b.st = st;
    if (threadIdx.x == 0) (void)xb_add(&bar[XB_XCNT(b.x)], 1u);
    return b;
}
DEV void xcd_barrier_complete(unsigned* bar, unsigned x, unsigned& nloc, unsigned& nx) {
    const unsigned G = gridDim.x * gridDim.y * gridDim.z;
    unsigned sum, cnt, mine, sp = 0u;
    for (;;) {
        sum = 0u; cnt = 0u; mine = 0u;
#pragma unroll
        for (unsigned j = 0; j < 16; ++j) { const unsigned c = xb_ld(&bar[XB_XCNT(j)]); sum += c; cnt += (c > 0u) ? 1u : 0u; mine = (j == x) ? c : mine; }
        if (sum == G) break;
        __builtin_amdgcn_s_sleep(1);
        if ((++sp & 255u) == 0u) { if (xb_ld(&bar[XB_TMO])) break; if (sp > XB_SPIN_CAP) { atomicAdd(&bar[XB_TMO], 1u); break; } }
    }
    nloc = mine > 0u ? mine : 1u; nx = cnt > 0u ? cnt : 1u;
}
DEV void xcd_barrier(const XcdBarrier& b) {
    asm volatile("s_waitcnt vmcnt(0)" ::: "memory");
    __syncthreads();
    if (threadIdx.x == 0) {
        unsigned* bar = b.bar;
        __builtin_amdgcn_s_waitcnt(0);
        unsigned nloc = b.st[0], nx = b.st[1];
        if (nloc == 0u) { xcd_barrier_complete(bar, b.x, nloc, nx); b.st[0] = nloc; b.st[1] = nx; }
        const unsigned old = xb_add(&bar[XB_XSUB(b.x)], 1u);
        const unsigned gen = old / nloc;
        if (old + 1u == (gen + 1u) * nloc) {
            __builtin_amdgcn_fence(__ATOMIC_RELEASE, "agent");
            asm volatile("s_waitcnt vmcnt(0)" ::: "memory");
            const unsigned og = xb_add(&bar[XB_TOP], 1u);
            const unsigned tg = og / nx;
            if (og + 1u == (tg + 1u) * nx) xb_add(&bar[XB_TOPGEN], 1u);
            else XB_SPIN(xb_ld(&bar[XB_TOPGEN]) == tg, bar);
            __builtin_amdgcn_fence(__ATOMIC_ACQUIRE, "agent");
            xb_add(&bar[XB_XGEN(b.x)], 1u);
            asm volatile("s_waitcnt vmcnt(0)" ::: "memory");
        } else {
            XB_SPIN(xb_ld(&bar[XB_XGEN(b.x)]) == gen, bar);
            __builtin_amdgcn_fence(__ATOMIC_ACQUIRE, "agent");
            asm volatile("s_waitcnt vmcnt(0)" ::: "memory");
        }
    }
    __syncthreads();
}
DEV int grab_unit(unsigned* ctr, char* smem) {
    volatile LDSAS unsigned* st = (volatile LDSAS unsigned*)(smem + SMEM_BYTES - 16);
    __syncthreads();
    if (threadIdx.x == 0) st[2] = __hip_atomic_fetch_add(ctr, 1u, __ATOMIC_RELAXED, __HIP_MEMORY_SCOPE_AGENT);
    __syncthreads();
    return (int)st[2];
}
DEV void phase_mid(const Params& p, int L, char* smem, unsigned* ctr, int tmask = 7) {
    constexpr int N_CMP = 128, N_TOT = 128 + 512 + 768;
    for (;;) {
        const int u = grab_unit(ctr, smem);
        if (u >= N_TOT) break;
        int v = u;
        if (v < 256) { const int qb = 63 - (v >> 3), b = v & 7; if (tmask & 1) dsa_unit(p, b, qb, smem); continue; }
        v -= 256;
        if (v < N_CMP) { const int kv = v & 1, g = (v >> 1) & 1, cc = (v >> 2) & 3, b = v >> 4; if (tmask & 4) cmp_unit(p, L, kv, b, g, cc, smem); continue; }
        v -= N_CMP;
        const int sI = 15 - (v >> 6), r = v & 63;
        if (r < 48) { if (tmask & 2) fox_unit(p, r / 6, r % 6, sI, smem); }
        else { const int r2 = r - 48, qb = 2 * sI + 1 - (r2 >> 3), b = r2 & 7; if (tmask & 1) dsa_unit(p, b, qb, smem); }
    }
}
DEV void phase_nsa(const Params& p, char* smem, unsigned* ctr) {
    for (;;) {
        const int u = grab_unit(ctr, smem);
        if (u >= 768) break;
        const int qb = 15 - u / 48, r = u % 48, b = r / 6, g = (r % 6) / 3, j = r % 3;
        nsa_unit(p, b, g, qb, j, smem);
    }
}
#ifndef PHASE_MASK
#define PHASE_MASK 0xffff
#endif
DEV void run_phase(const Params& p, int ph, char* smem, int rep = 0) {
    unsigned* ctr = (unsigned*)(p.ws + WS_CTRL) + 3584 + 16 * (ph + 12 * rep);
    if (ph == 0) { if (PHASE_MASK & 1) phase_prep(p, smem); return; }
    if (ph == 1) { if (PHASE_MASK & 2) phase_u1(p); return; }
    const int L = (ph - 2) / 5, k = (ph - 2) % 5;
    if (k == 0) { if (PHASE_MASK & 4) phase_gemm_in(p, L, smem); }
    else if (k == 1) { if (PHASE_MASK & 8) phase_mid(p, L, smem, ctr); }
    else if (k == 2) { if (PHASE_MASK & 16) phase_nsa(p, smem, ctr); }
    else if (k == 3) { if (PHASE_MASK & 32) phase_out(p, L, smem); }
    else { if (PHASE_MASK & 64) phase_ln(p, L); }
}
constexpr int N_PHASES = 12;

#ifndef REPEAT_KIND
#define REPEAT_KIND -1
#endif
DEV int phase_kind(int ph) { return ph < 2 ? ph : 2 + (ph - 2) % 5; }
template <bool COOP>
__global__ void __launch_bounds__(256, 2) mega(Params p, int ph_lo, int ph_hi) {
    extern __shared__ __attribute__((aligned(16))) char smem[];
    volatile LDSAS unsigned* st = (volatile LDSAS unsigned*)(smem + SMEM_BYTES - 16);
    XcdBarrier xb;
    if (COOP) {
        if (threadIdx.x == 0) { st[0] = 0u; st[1] = 0u; }
        __syncthreads();
        xb = xcd_barrier_post((unsigned*)(p.ws + WS_CTRL), st);
    }
    for (int ph = ph_lo; ph < ph_hi; ++ph) {
        run_phase(p, ph, smem);
        if (COOP) {
            if (REPEAT_KIND >= 0 && REPEAT_KIND < 7 && phase_kind(ph) == REPEAT_KIND) { xcd_barrier(xb); run_phase(p, ph, smem, 1); }
            if (REPEAT_KIND >= 7 && REPEAT_KIND <= 9 && phase_kind(ph) == 3) { xcd_barrier(xb); phase_mid(p, (ph - 2) / 5, smem, (unsigned*)(p.ws + WS_CTRL) + 3584 + 16 * (ph + 12), 1 << (REPEAT_KIND - 7)); }
            if (ph + 1 < ph_hi) xcd_barrier(xb);
        }
    }
}

#ifndef N_LAUNCH_MODE
#define N_LAUNCH_MODE 1
#endif

extern "C" void kernel_launch(void* const* d_in, const int* in_sizes, int n_in, void* d_out, int out_size, void* d_ws, size_t ws_size, hipStream_t stream) {
    static int grid = 0;
    if (grid == 0) {
        int dev = 0, cus = 0, per_cu = 0;
        hipGetDevice(&dev);
        hipDeviceGetAttribute(&cus, hipDeviceAttributeMultiprocessorCount, dev);
        hipFuncSetAttribute((const void*)mega<true>, hipFuncAttributeMaxDynamicSharedMemorySize, SMEM_BYTES);
        hipFuncSetAttribute((const void*)mega<false>, hipFuncAttributeMaxDynamicSharedMemorySize, SMEM_BYTES);
        hipOccupancyMaxActiveBlocksPerMultiprocessor(&per_cu, (const void*)mega<true>, 256, SMEM_BYTES);
        if (per_cu < 1) per_cu = 1;
        if (per_cu > 2) per_cu = 2;
        grid = cus * per_cu;
        if (ws_size < WS_END) { fprintf(stderr, "workspace too small: %zu < %zu\n", ws_size, (size_t)WS_END); grid = -1; }
    }
    if (grid < 0) return;
    Params p{};
    p.x = (const float*)d_in[0]; p.c = (const float*)d_in[1]; p.w_ada = (const float*)d_in[2]; p.b_ada = (const float*)d_in[3];
    p.w_in = (const float*)d_in[4]; p.b_f = (const float*)d_in[5]; p.cmp_pe = (const float*)d_in[6]; p.cmp_w1 = (const float*)d_in[7];
    p.cmp_w2 = (const float*)d_in[8]; p.w_out = (const float*)d_in[9]; p.ln_g = (const float*)d_in[10]; p.ln_b = (const float*)d_in[11];
    p.out = (float*)d_out; p.ws = (char*)d_ws;
    (void)hipMemsetAsync((char*)d_ws + WS_CTRL, 0, 16384, stream);
#if N_LAUNCH_MODE == 1
    hipLaunchKernelGGL(mega<true>, dim3(grid), dim3(256), SMEM_BYTES, stream, p, 0, N_PHASES);
#else
    for (int ph = 0; ph < N_PHASES; ++ph) hipLaunchKernelGGL(mega<false>, dim3(grid), dim3(256), SMEM_BYTES, stream, p, ph, ph + 1);
#endif
}
```

```cpp
#include <hip/hip_runtime.h>
#include <hip/hip_cooperative_groups.h>
#include <stdint.h>
#include <stdio.h>
namespace cg = cooperative_groups;

#define DEV __device__ __forceinline__
typedef unsigned short bf16_t;
typedef short bf16x8 __attribute__((ext_vector_type(8)));
typedef short s16x4 __attribute__((ext_vector_type(4)));
typedef float f32x16 __attribute__((ext_vector_type(16)));
typedef float f32x4 __attribute__((ext_vector_type(4)));
typedef float f32x2 __attribute__((ext_vector_type(2)));
typedef unsigned u32x4 __attribute__((ext_vector_type(4)));
typedef unsigned u32x2 __attribute__((ext_vector_type(2)));
typedef short v4i16_t __attribute__((ext_vector_type(4)));
#define LDSAS __attribute__((address_space(3)))

constexpr int NB = 8, S = 2048, DM = 1024, NTOK = NB * S;
constexpr int HP = 4160, UP = 1088, WP = 1088, ZP = 1056, W1P = 2112;
constexpr int C_DSAQ = 0, C_DSAK = 256, C_DSAV = 320, C_IDXQ = 384, C_IDXK = 640, C_MISC = 672, C_FOXQ = 704, C_FOXK = 1088, C_FOXV = 1472,
              C_NSAQ = 1856, C_KC = 2240, C_VC = 2368, C_KS = 2496, C_VS = 2624, C_KW = 2752, C_VW = 2880, C_GATE = 3008;
constexpr float LOG2E = 1.4426950408889634f;
constexpr float QS = 0.125f * LOG2E;
constexpr float ALPHA = 1.4142135623730951f;
constexpr float NEG_INF = -__builtin_huge_valf();

constexpr size_t WS_CTRL = 0;
constexpr size_t WS_MOD = 16384;
constexpr size_t WS_CS64 = WS_MOD + 2 * 8 * 3072 * 4;
constexpr size_t WS_CS32 = WS_CS64 + 2048 * 32 * 8;
constexpr size_t WS_WINT = WS_CS32 + 2048 * 16 * 8;
constexpr size_t WS_WOUTT = WS_WINT + (size_t)2 * 4096 * WP * 2;
constexpr size_t WS_W1T = WS_WOUTT + (size_t)2 * 1024 * WP * 2;
constexpr size_t WS_U = WS_W1T + (size_t)2 * 2 * 64 * W1P * 2;
constexpr size_t WS_MIX = WS_U + (size_t)NTOK * UP * 2;
constexpr size_t WS_QROT = WS_MIX + (size_t)NTOK * UP * 2;
constexpr size_t WS_IW = WS_QROT + (size_t)NTOK * 384 * 2;
constexpr size_t WS_GSIG = WS_IW + (size_t)NTOK * 8 * 4;
constexpr size_t WS_LOGF = WS_GSIG + (size_t)NTOK * 20 * 4;
constexpr size_t WS_KC = WS_LOGF + (size_t)8 * 6 * 2048 * 4;
constexpr size_t WS_VC = WS_KC + (size_t)8 * 2 * 128 * 64 * 2;
constexpr size_t WS_H = WS_VC + (size_t)8 * 2 * 128 * 64 * 2;
constexpr size_t WS_END = WS_H + (size_t)NTOK * HP * 2;
static_assert(WS_END <= (size_t)256 * 1024 * 1024, "workspace");

constexpr int SMEM_BYTES = 78848;

struct Params {
    const float *x, *c, *w_ada, *b_ada, *w_in, *b_f, *cmp_pe, *cmp_w1, *cmp_w2, *w_out, *ln_g, *ln_b;
    float* out; char* ws;
};

#define OPAQUE_V(x) asm volatile("" : "+v"(x))
#define CR(r) (((r) & 3) + 8 * ((r) >> 2))
DEV int crow(int r, int h) { return (r & 3) + 8 * (r >> 2) + 4 * h; }
typedef __bf16 bf16x2_t __attribute__((ext_vector_type(2)));
DEV unsigned cvt_pk(float lo, float hi) { const f32x2 v = {lo, hi}; return __builtin_bit_cast(unsigned, __builtin_convertvector(v, bf16x2_t)); }
DEV float bf_lo(unsigned v) { return __uint_as_float(v << 16); }
DEV float bf_hi(unsigned v) { return __uint_as_float(v & 0xffff0000u); }
DEV f32x16 mfma(bf16x8 a, bf16x8 b, f32x16 c) { return __builtin_amdgcn_mfma_f32_32x32x16_bf16(a, b, c, 0, 0, 0); }
DEV float fexp2(float x) { return __builtin_amdgcn_exp2f(x); }
DEV s16x4 vtr(const char* p) { return __builtin_bit_cast(s16x4, __builtin_amdgcn_ds_read_tr16_b64_v4i16((LDSAS v4i16_t*)p)); }
DEV bf16x8 cat4(s16x4 a, s16x4 b) { bf16x8 r; r[0] = a[0]; r[1] = a[1]; r[2] = a[2]; r[3] = a[3]; r[4] = b[0]; r[5] = b[1]; r[6] = b[2]; r[7] = b[3]; return r; }
DEV u32x4 pack8(const float* v) { u32x4 r; r.x = cvt_pk(v[0], v[1]); r.y = cvt_pk(v[2], v[3]); r.z = cvt_pk(v[4], v[5]); r.w = cvt_pk(v[6], v[7]); return r; }
DEV float sigmoidf_(float v) { return 1.0f / (1.0f + __expf(-v)); }

DEV void sincos_acc(float a, float& sn, float& cs) {
    const float q = rintf(a * 0.6366197723675814f);
    float y = fmaf(-q, 1.5703125f, a); y = fmaf(-q, 4.837512969970703125e-4f, y); y = fmaf(-q, 7.54978995489188216e-8f, y);
    const float z = y * y;
    const float sp = y + y * z * (-1.6666654611e-1f + z * (8.3321608736e-3f + z * (-1.9515295891e-4f)));
    const float cp = 1.0f + z * (-0.5f + z * (4.166664568298827e-2f + z * (-1.388731625493765e-3f + z * 2.443315711809948e-5f)));
    const int qi = ((int)q) & 3;
    sn = (qi == 0) ? sp : (qi == 1) ? cp : (qi == 2) ? -sp : -cp;
    cs = (qi == 0) ? cp : (qi == 1) ? -sp : (qi == 2) ? -cp : sp;
}

DEV int win_srccol(int n) {
    if (n < 672) return n;
    if (n < 704) { const int j = n - 672; return j < 8 ? 672 + j : (j < 14 ? 1832 + (j - 8) : 2990 + (j - 14)); }
    if (n < 1856) return 680 + (n - 704);
    if (n < 3008) return 1838 + (n - 1856);
    if (n < 4032) return n;
    return -1;
}
DEV void transpose_unit(const float* __restrict__ src, int ldsrc, bf16_t* __restrict__ dst, int ldd, int n0, int k0, bool winmap, char* smem) {
    float* t = (float*)smem;
    int tid_ = threadIdx.x; OPAQUE_V(tid_); const int tid = tid_;
    {
        const int nn = tid & 63, n = n0 + nn; const int sc = winmap ? win_srccol(n) : n;
#pragma unroll
        for (int i = 0; i < 16; ++i) { const int kk = (tid >> 6) + 4 * i; t[kk * 65 + nn] = sc >= 0 ? src[(size_t)(k0 + kk) * ldsrc + sc] : 0.f; }
    }
    __syncthreads();
    {
        const int nn = tid >> 2, kq = tid & 3; float v[16];
#pragma unroll
        for (int j = 0; j < 16; ++j) v[j] = t[(kq * 16 + j) * 65 + nn];
        u32x4* d = (u32x4*)(dst + (size_t)(n0 + nn) * ldd + k0 + kq * 16);
        d[0] = pack8(v); d[1] = pack8(v + 8);
    }
    __syncthreads();
}
DEV void mod_unit(const Params& p, int L, int cgi, char* smem) {
    float* cs = (float*)smem;
    float* red = (float*)(smem + 32768);
    int tid_ = threadIdx.x; OPAQUE_V(tid_); const int tid = tid_;
#pragma unroll
    for (int i = 0; i < 32; ++i) cs[tid + 256 * i] = p.c[tid + 256 * i];
    __syncthreads();
    const int cc = tid & 31, kk = tid >> 5, col = cgi * 32 + cc;
    float acc[8];
#pragma unroll
    for (int b = 0; b < 8; ++b) acc[b] = 0.f;
    const float* w = p.w_ada + ((size_t)L * 1024 + kk * 128) * 3072 + col;
#pragma unroll 8
    for (int k = 0; k < 128; ++k) {
        const float wv = w[(size_t)k * 3072];
#pragma unroll
        for (int b = 0; b < 8; ++b) acc[b] = fmaf(cs[b * 1024 + kk * 128 + k], wv, acc[b]);
    }
#pragma unroll
    for (int b = 0; b < 8; ++b) red[(kk * 8 + b) * 32 + cc] = acc[b];
    __syncthreads();
    {
        const int b = tid >> 5; float s = p.b_ada[L * 3072 + col];
#pragma unroll
        for (int k2 = 0; k2 < 8; ++k2) s += red[(k2 * 8 + b) * 32 + cc];
        ((float*)(p.ws + WS_MOD))[(L * 8 + b) * 3072 + col] = s;
    }
    __syncthreads();
}
DEV void phase_prep(const Params& p, char* smem) {
    constexpr int N_MOD = 192, N_TAB = 384, N_WIN = 2048, N_WOUT = 512, N_W1 = 128;
    constexpr int TOT = N_MOD + N_TAB + N_WIN + N_WOUT + N_W1;
    for (int u = blockIdx.x; u < TOT; u += gridDim.x) {
        int v = u;
        if (v < N_MOD) { mod_unit(p, v / 96, v % 96, smem); continue; }
        v -= N_MOD;
        if (v < N_TAB) {
            int tx_ = threadIdx.x; OPAQUE_V(tx_); const int idx = v * 256 + tx_;
            if (idx < 65536) {
                const int pos = idx >> 5, i = idx & 31; const float inv = powf(10000.0f, -(float)i / 32.0f);
                float sn, cs; sincos_acc((float)pos * inv, sn, cs);
                ((f32x2*)(p.ws + WS_CS64))[idx] = (f32x2){cs, sn};
            } else {
                const int id2 = idx - 65536; const int pos = id2 >> 4, i = id2 & 15; const float inv = powf(10000.0f, -(float)i / 16.0f);
                float sn, cs; sincos_acc((float)pos * inv, sn, cs);
                ((f32x2*)(p.ws + WS_CS32))[id2] = (f32x2){cs, sn};
            }
            continue;
        }
        v -= N_TAB;
        if (v < N_WIN) { const int L = v >> 10, r = v & 1023, nt = r >> 4, kt = r & 15;
            transpose_unit(p.w_in + (size_t)L * 1024 * 4032, 4032, (bf16_t*)(p.ws + WS_WINT) + (size_t)L * 4096 * WP, WP, nt * 64, kt * 64, true, smem); continue; }
        v -= N_WIN;
        if (v < N_WOUT) { const int L = v >> 8, r = v & 255, nt = r >> 4, kt = r & 15;
            transpose_unit(p.w_out + (size_t)L * 1024 * 1024, 1024, (bf16_t*)(p.ws + WS_WOUTT) + (size_t)L * 1024 * WP, WP, nt * 64, kt * 64, false, smem); continue; }
        v -= N_WOUT;
        { const int lk = v >> 5, kt = v & 31;
            transpose_unit(p.cmp_w1 + (size_t)lk * 2048 * 64, 64, (bf16_t*)(p.ws + WS_W1T) + (size_t)lk * 64 * W1P, W1P, 0, kt * 64, false, smem); }
    }
}

DEV void phase_u1(const Params& p) {
    const float* mod = (const float*)(p.ws + WS_MOD);
    bf16_t* U = (bf16_t*)(p.ws + WS_U);
    for (int u = blockIdx.x; u < 2048; u += gridDim.x) {
        int tx_ = threadIdx.x; OPAQUE_V(tx_);
#pragma unroll
        for (int i = 0; i < 4; ++i) {
            const int e = tx_ + 256 * i, row = 8 * u + (e >> 7), c8 = (e & 127) * 8, b = row >> 11;
            const f32x4* xp = (const f32x4*)(p.x + (size_t)row * 1024 + c8);
            const f32x4* sh = (const f32x4*)(mod + (size_t)b * 3072 + c8);
            const f32x4* sc = (const f32x4*)(mod + (size_t)b * 3072 + 1024 + c8);
            float v[8];
#pragma unroll
            for (int q = 0; q < 2; ++q) { const f32x4 xv = xp[q], s1 = sc[q], s0 = sh[q];
#pragma unroll
                for (int k = 0; k < 4; ++k) v[4 * q + k] = fmaf(xv[k], 1.0f + s1[k], s0[k]); }
            *(u32x4*)(U + (size_t)row * UP + c8) = pack8(v);
        }
    }
}

constexpr int KP = 72, CTP = 132;
DEV void gemm_kloop(const bf16_t* __restrict__ X, int ldx, const bf16_t* __restrict__ W, int ldw, int K, int m0, int n0, char* smem, f32x16 (&acc)[2][2], int tid) {
    const int lane = tid & 63, w = __builtin_amdgcn_readfirstlane(tid >> 6), wm = w >> 1, wn = w & 1, r32 = lane & 31, h = lane >> 5;
    const bf16_t* xg[2]; const bf16_t* wg[2];
#pragma unroll
    for (int i = 0; i < 2; ++i) { const int row = 16 * (2 * w + i) + (lane >> 2), kc = (lane & 3) ^ ((row >> 2) & 3);
        xg[i] = X + (size_t)(m0 + row) * ldx + kc * 8; wg[i] = W + (size_t)(n0 + row) * ldw + kc * 8; }
#define GEMM_STAGE(kt) do { const int st_ = ((kt) & 3) * 16384; _Pragma("unroll") for (int i = 0; i < 2; ++i) { \
        __builtin_amdgcn_global_load_lds((const unsigned*)(xg[i] + (kt) * 32), (LDSAS unsigned*)(smem + st_ + (2 * w + i) * 1024), 16, 0, 0); \
        __builtin_amdgcn_global_load_lds((const unsigned*)(wg[i] + (kt) * 32), (LDSAS unsigned*)(smem + st_ + 8192 + (2 * w + i) * 1024), 16, 0, 0); } } while (0)
#pragma unroll
    for (int i = 0; i < 2; ++i)
#pragma unroll
        for (int j = 0; j < 2; ++j)
#pragma unroll
            for (int r = 0; r < 16; ++r) acc[i][j][r] = 0.f;
    const int nk = K / 32;
    int offA[2], offB[2];
#pragma unroll
    for (int i = 0; i < 2; ++i) { const int ra = wm * 64 + 32 * i + r32, rb = wn * 64 + 32 * i + r32;
        offA[i] = 8192 + ra * 64 + ((h ^ ((ra >> 2) & 3)) << 4); offB[i] = rb * 64 + ((h ^ ((rb >> 2) & 3)) << 4); }
    GEMM_STAGE(0); GEMM_STAGE(1); GEMM_STAGE(2);
    for (int kt = 0; kt < nk; ++kt) {
        if (kt + 2 < nk) asm volatile("s_waitcnt vmcnt(8)" ::: "memory");
        else if (kt + 1 < nk) asm volatile("s_waitcnt vmcnt(4)" ::: "memory");
        else asm volatile("s_waitcnt vmcnt(0)" ::: "memory");
        __builtin_amdgcn_s_barrier();
        asm volatile("" ::: "memory");
        if (kt + 3 < nk) GEMM_STAGE(kt + 3);
        const char* st = smem + (kt & 3) * 16384;
#pragma unroll
        for (int s2 = 0; s2 < 2; ++s2) {
            bf16x8 a[2], b[2];
#pragma unroll
            for (int i = 0; i < 2; ++i) { a[i] = *(const bf16x8*)(st + (offA[i] ^ (s2 << 5))); b[i] = *(const bf16x8*)(st + (offB[i] ^ (s2 << 5))); }
#pragma unroll
            for (int i = 0; i < 2; ++i)
#pragma unroll
                for (int j = 0; j < 2; ++j) acc[i][j] = mfma(a[i], b[j], acc[i][j]);
        }
    }
#undef GEMM_STAGE
    __syncthreads();
}
DEV void acc_to_ct(const f32x16 (&acc)[2][2], char* smem, int tid) {
    const int lane = tid & 63, w = __builtin_amdgcn_readfirstlane(tid >> 6), wm = w >> 1, wn = w & 1, r32 = lane & 31, h = lane >> 5;
    float* Ct = (float*)smem;
#pragma unroll
    for (int i = 0; i < 2; ++i)
#pragma unroll
        for (int j = 0; j < 2; ++j)
#pragma unroll
            for (int a = 0; a < 4; ++a) {
                f32x4 v = {acc[i][j][4 * a], acc[i][j][4 * a + 1], acc[i][j][4 * a + 2], acc[i][j][4 * a + 3]};
                *(f32x4*)(Ct + (wn * 64 + 32 * j + r32) * CTP + wm * 64 + 32 * i + 8 * a + 4 * h) = v;
            }
    __syncthreads();
}

constexpr int CSP = 136;
DEV float silu_fast(float a) { return a * __builtin_amdgcn_rcpf(1.0f + fexp2(-LOG2E * a)); }
DEV void cs_store4(bf16_t* Cs, int row, int col, float a, float b, float c, float d) { u32x2 v; v.x = cvt_pk(a, b); v.y = cvt_pk(c, d); *(u32x2*)(Cs + row * CSP + col) = v; }
DEV void phase_gemm_in(const Params& p, int L, char* smem) {
    const bf16_t* U = (const bf16_t*)(p.ws + WS_U);
    const bf16_t* W = (const bf16_t*)(p.ws + WS_WINT) + (size_t)L * 4096 * WP;
    bf16_t* H = (bf16_t*)(p.ws + WS_H);
    bf16_t* Cs = (bf16_t*)smem;
    for (int u = blockIdx.x; u < 4096; u += gridDim.x) {
        int tid_ = threadIdx.x; OPAQUE_V(tid_); const int tid = tid_;
        const int lane = tid & 63, w = __builtin_amdgcn_readfirstlane(tid >> 6), wm = w >> 1, wn = w & 1, r32 = lane & 31, h = lane >> 5;
        const int mt = u >> 5, nt = u & 31, m0 = mt * 128, c64 = 2 * nt + wm;
        f32x16 acc[2][2];
        gemm_kloop(U, UP, W, WP, 1024, m0, nt * 128, smem, acc, tid);
        const bool is_rope64 = c64 <= 4 || (c64 >= 29 && c64 <= 34) || c64 == 39 || c64 == 40 || c64 == 43 || c64 == 44;
        const bool is_nsaq = c64 >= 29 && c64 <= 34;
        f32x16 rot0[2], rot1[2];
#pragma unroll
        for (int j = 0; j < 2; ++j) {
            const int trow = 64 * wn + 32 * j + r32, token = m0 + trow, pos = token & 2047;
            f32x16& A0 = acc[0][j]; f32x16& A1 = acc[1][j];
            if (is_rope64) {
                const float sc = (c64 <= 3 || is_nsaq) ? QS : 1.0f;
                const f32x2* ct = (const f32x2*)(p.ws + WS_CS64) + pos * 32 + 4 * h;
#pragma unroll
                for (int a = 0; a < 4; ++a) {
                    const f32x4 c01 = *(const f32x4*)(ct + 8 * a), c23 = *(const f32x4*)(ct + 8 * a + 2);
                    const float cs_[4] = {c01[0], c01[2], c23[0], c23[2]}, sn_[4] = {c01[1], c01[3], c23[1], c23[3]};
#pragma unroll
                    for (int k = 0; k < 4; ++k) { const float x1 = A0[4 * a + k], x2 = A1[4 * a + k];
                        const float o1 = (x1 * cs_[k] - x2 * sn_[k]) * sc, o2 = (x1 * sn_[k] + x2 * cs_[k]) * sc;
                        if (is_nsaq) { rot0[j][4 * a + k] = o1; rot1[j][4 * a + k] = o2; A0[4 * a + k] = x1 * sc; A1[4 * a + k] = x2 * sc; }
                        else { A0[4 * a + k] = o1; A1[4 * a + k] = o2; } }
                }
            } else if ((c64 >= 6 && c64 <= 10)) {
                const f32x2* ct = (const f32x2*)(p.ws + WS_CS32) + pos * 16 + 4 * h;
#pragma unroll
                for (int a = 0; a < 2; ++a) {
                    const f32x4 c01 = *(const f32x4*)(ct + 8 * a), c23 = *(const f32x4*)(ct + 8 * a + 2);
                    const float cs_[4] = {c01[0], c01[2], c23[0], c23[2]}, sn_[4] = {c01[1], c01[3], c23[1], c23[3]};
#pragma unroll
                    for (int k = 0; k < 4; ++k) {
                        { const float x1 = A0[4 * a + k], x2 = A0[4 * (a + 2) + k]; A0[4 * a + k] = x1 * cs_[k] - x2 * sn_[k]; A0[4 * (a + 2) + k] = x1 * sn_[k] + x2 * cs_[k]; }
                        if (c64 != 10) { const float x1 = A1[4 * a + k], x2 = A1[4 * (a + 2) + k]; A1[4 * a + k] = x1 * cs_[k] - x2 * sn_[k]; A1[4 * (a + 2) + k] = x1 * sn_[k] + x2 * cs_[k]; }
                    }
                }
                if (c64 == 10) {
                    const int b = token >> 11;
                    float* iw = (float*)(p.ws + WS_IW) + (size_t)token * 8 + 4 * h;
                    *(f32x4*)iw = (f32x4){A1[0], A1[1], A1[2], A1[3]} * 0.35355339059327373f;
                    float* lf = (float*)(p.ws + WS_LOGF) + (size_t)b * 6 * 2048 + pos; float* gs = (float*)(p.ws + WS_GSIG) + (size_t)token * 20;
#pragma unroll
                    for (int a = 1; a < 4; ++a)
#pragma unroll
                        for (int k = 0; k < 4; ++k) {
                            const int f = 8 * a + k;
                            const float v = A1[4 * a + k];
                            if (a == 1) {
                                if (h == 0 || k < 2) { const int e = 4 * h + k; const float x = v + p.b_f[L * 6 + e]; lf[(size_t)e * 2048] = fminf(x, 0.f) - log1pf(expf(-fabsf(x))); }
                                else gs[k - 2] = 1.0f / (1.0f + expf(-v));
                            } else gs[f + 4 * h - 14] = 1.0f / (1.0f + expf(-v));
                        }
                }
            } else {
                const bool isq = (c64 >= 11 && c64 <= 16), silu = c64 >= 47;
#pragma unroll
                for (int r = 0; r < 16; ++r) {
                    if (silu) { A0[r] = silu_fast(A0[r]); A1[r] = silu_fast(A1[r]); }
                    else if (isq) { A0[r] *= QS; A1[r] *= QS; }
                }
            }
#pragma unroll
            for (int a = 0; a < 4; ++a) {
                cs_store4(Cs, trow, 64 * wm + 8 * a + 4 * h, A0[4 * a], A0[4 * a + 1], A0[4 * a + 2], A0[4 * a + 3]);
                cs_store4(Cs, trow, 64 * wm + 32 + 8 * a + 4 * h, A1[4 * a], A1[4 * a + 1], A1[4 * a + 2], A1[4 * a + 3]);
            }
        }
        __syncthreads();
#pragma unroll
        for (int it = 0; it < 8; ++it) { const int row = (tid >> 4) + 16 * it, ch = tid & 15;
            *(u32x4*)(H + (size_t)(m0 + row) * HP + nt * 128 + ch * 8) = *(const u32x4*)(Cs + row * CSP + ch * 8); }
        if (nt >= 14 && nt <= 17) {
            __syncthreads();
            if (is_nsaq) {
#pragma unroll
                for (int j = 0; j < 2; ++j) { const int trow = 64 * wn + 32 * j + r32;
#pragma unroll
                    for (int a = 0; a < 4; ++a) {
                        cs_store4(Cs, trow, 64 * wm + 8 * a + 4 * h, rot0[j][4 * a], rot0[j][4 * a + 1], rot0[j][4 * a + 2], rot0[j][4 * a + 3]);
                        cs_store4(Cs, trow, 64 * wm + 32 + 8 * a + 4 * h, rot1[j][4 * a], rot1[j][4 * a + 1], rot1[j][4 * a + 2], rot1[j][4 * a + 3]);
                    } }
            }
            __syncthreads();
            bf16_t* QR = (bf16_t*)(p.ws + WS_QROT);
#pragma unroll
            for (int it = 0; it < 8; ++it) { const int row = (tid >> 4) + 16 * it, ch = tid & 15; const int cc = 2 * nt + (ch >> 3);
                if (cc >= 29 && cc <= 34) *(u32x4*)(QR + (size_t)(m0 + row) * 384 + (cc - 29) * 64 + (ch & 7) * 8) = *(const u32x4*)(Cs + row * CSP + ch * 8); }
        }
        __syncthreads();
    }
}
DEV void phase_out(const Params& p, int L, char* smem) {
    const bf16_t* A = (const bf16_t*)(p.ws + WS_MIX);
    const bf16_t* W = (const bf16_t*)(p.ws + WS_WOUTT) + (size_t)L * 1024 * WP;
    float* Z = (float*)(p.ws + WS_H);
    const float* mod = (const float*)(p.ws + WS_MOD) + (size_t)L * 8 * 3072;
    for (int u = blockIdx.x; u < 1024; u += gridDim.x) {
        const int mt = u >> 3, nt = u & 7, m0 = mt * 128, n0 = nt * 128;
        int tx_ = threadIdx.x; OPAQUE_V(tx_);
        { f32x16 acc[2][2]; gemm_kloop(A, UP, W, WP, 1024, m0, n0, smem, acc, tx_); acc_to_ct(acc, smem, tx_); }
        const float* Ct = (const float*)smem;
#pragma unroll
        for (int i = 0; i < 16; ++i) {
            const int item = tx_ + 256 * i, row = item >> 5, c4 = (item & 31) * 4, token = m0 + row, b = token >> 11;
            const f32x4 y = *(const f32x4*)(Ct + row * CTP + c4);
            const f32x4 g = *(const f32x4*)(mod + (size_t)b * 3072 + 2048 + n0 + c4);
            f32x4 z;
#pragma unroll
            for (int k = 0; k < 4; ++k) z[k] = (1.0f + g[k]) * y[k];
            *(f32x4*)(Z + (size_t)token * ZP + n0 + c4) = z;
        }
        __syncthreads();
    }
}
DEV void phase_ln(const Params& p, int L) {
    const float* Z = (const float*)(p.ws + WS_H);
    const float* xin = L == 0 ? p.x : p.out;
    const float* mod = (const float*)(p.ws + WS_MOD) + (size_t)8 * 3072;
    bf16_t* U = (bf16_t*)(p.ws + WS_U);
    for (int u = blockIdx.x; u < 1024; u += gridDim.x) {
        int tx_ = threadIdx.x; OPAQUE_V(tx_);
        const int lane = tx_ & 63, w = __builtin_amdgcn_readfirstlane(tx_ >> 6);
        for (int rr = 0; rr < 4; ++rr) {
            const int row = u * 16 + w * 4 + rr, b = row >> 11;
            f32x4 v[4]; float s = 0.f;
#pragma unroll
            for (int i = 0; i < 4; ++i) { const f32x4 xv = *(const f32x4*)(xin + (size_t)row * 1024 + 256 * i + 4 * lane);
                v[i] = *(const f32x4*)(Z + (size_t)row * ZP + 256 * i + 4 * lane) + ALPHA * xv; s += (v[i][0] + v[i][1]) + (v[i][2] + v[i][3]); }
#pragma unroll
            for (int o = 32; o >= 1; o >>= 1) s += __shfl_xor(s, o);
            const float mean = s * (1.0f / 1024.0f); float q = 0.f;
#pragma unroll
            for (int i = 0; i < 4; ++i)
#pragma unroll
                for (int k = 0; k < 4; ++k) { const float d = v[i][k] - mean; q = fmaf(d, d, q); }
#pragma unroll
            for (int o = 32; o >= 1; o >>= 1) q += __shfl_xor(q, o);
            const float rstd = rsqrtf(q * (1.0f / 1024.0f) + 1e-5f);
#pragma unroll
            for (int i = 0; i < 4; ++i) {
                const int col = 256 * i + 4 * lane;
                const f32x4 g = *(const f32x4*)(p.ln_g + L * 1024 + col), bb = *(const f32x4*)(p.ln_b + L * 1024 + col);
                f32x4 o;
#pragma unroll
                for (int k = 0; k < 4; ++k) o[k] = (v[i][k] - mean) * rstd * g[k] + bb[k];
                *(f32x4*)(p.out + (size_t)row * 1024 + col) = o;
                if (L == 0) {
                    const f32x4 sh = *(const f32x4*)(mod + (size_t)b * 3072 + col), sc = *(const f32x4*)(mod + (size_t)b * 3072 + 1024 + col);
                    u32x2 pk; pk.x = cvt_pk(fmaf(o[0], 1.0f + sc[0], sh[0]), fmaf(o[1], 1.0f + sc[1], sh[1])); pk.y = cvt_pk(fmaf(o[2], 1.0f + sc[2], sh[2]), fmaf(o[3], 1.0f + sc[3], sh[3]));
                    *(u32x2*)(U + (size_t)row * UP + col) = pk;
                }
            }
        }
    }
}

constexpr int KT_BYTES = 64 * KP * 2, VT_BYTES = 8192;
struct KVRegs { u32x4 k[2], v[2]; };
DEV void kv_load(KVRegs& r, const bf16_t* __restrict__ kg, const bf16_t* __restrict__ vg, size_t pitch, int tid) {
#pragma unroll
    for (int i = 0; i < 2; ++i) { const int c = tid + 256 * i, row = c >> 3, ch = c & 7;
        r.k[i] = *(const u32x4*)(kg + (size_t)row * pitch + ch * 8); r.v[i] = *(const u32x4*)(vg + (size_t)row * pitch + ch * 8); }
}
DEV void kv_store(const KVRegs& r, char* ksm, char* vsm, int tid) {
#pragma unroll
    for (int i = 0; i < 2; ++i) { const int c = tid + 256 * i, row = c >> 3, ch = c & 7;
        *(u32x4*)(ksm + (row * KP + ch * 8) * 2) = r.k[i];
        *(u32x4*)(vsm + (ch >> 2) * 4096 + row * 64 + (ch & 3) * 16) = r.v[i]; }
}
DEV void load_qf(const bf16_t* q  , int h, bf16x8* qf) {
#pragma unroll
    for (int s = 0; s < 4; ++s) qf[s] = *(const bf16x8*)(q + 16 * s + 8 * h);
}
DEV void qk_tile(const char* ksm, const bf16x8* qf, int r32, int h, f32x16& s0, f32x16& s1) {
#pragma unroll
    for (int r = 0; r < 16; ++r) { s0[r] = 0.f; s1[r] = 0.f; }
#pragma unroll
    for (int s = 0; s < 4; ++s) {
        const bf16x8 a0 = *(const bf16x8*)(ksm + (r32 * KP + 16 * s + 8 * h) * 2);
        const bf16x8 a1 = *(const bf16x8*)(ksm + ((32 + r32) * KP + 16 * s + 8 * h) * 2);
        s0 = mfma(a0, qf[s], s0); s1 = mfma(a1, qf[s], s1);
    }
}
DEV void pv_tile(const char* vsm, int kofs, const f32x16& pt, int lane, f32x16& o0, f32x16& o1) {
    const int h = lane >> 5;
    const char* vb = vsm + ((lane >> 4) & 1) * 32 + (lane & 3) * 8 + (4 * h + ((lane & 15) >> 2) + kofs) * 64;
#pragma unroll
    for (int sp = 0; sp < 2; ++sp) {
        bf16x8 pb;
        { u32x4 t; t.x = cvt_pk(pt[8 * sp], pt[8 * sp + 1]); t.y = cvt_pk(pt[8 * sp + 2], pt[8 * sp + 3]); t.z = cvt_pk(pt[8 * sp + 4], pt[8 * sp + 5]); t.w = cvt_pk(pt[8 * sp + 6], pt[8 * sp + 7]); pb = __builtin_bit_cast(bf16x8, t); }
        const bf16x8 a0 = cat4(vtr(vb + (16 * sp) * 64), vtr(vb + (16 * sp + 8) * 64));
        const bf16x8 a1 = cat4(vtr(vb + 4096 + (16 * sp) * 64), vtr(vb + 4096 + (16 * sp + 8) * 64));
        o0 = mfma(a0, pb, o0); o1 = mfma(a1, pb, o1);
    }
}
DEV void flash_update(f32x16& s0, f32x16& s1, float& m, float& l, f32x16& o0, f32x16& o1, const char* vsm, int lane) {
    float mx = NEG_INF;
#pragma unroll
    for (int r = 0; r < 16; ++r) mx = fmaxf(mx, fmaxf(s0[r], s1[r]));
    mx = fmaxf(mx, __shfl_xor(mx, 32));
    const float mn = fmaxf(m, mx), mu = (mn == NEG_INF) ? 0.f : mn;
    const float alpha = fexp2(m - mu);
    m = mn;
    float ps = 0.f;
#pragma unroll
    for (int r = 0; r < 16; ++r) { s0[r] = fexp2(s0[r] - mu); s1[r] = fexp2(s1[r] - mu); ps += s0[r] + s1[r]; }
    l = fmaf(l, alpha, ps);
#pragma unroll
    for (int r = 0; r < 16; ++r) { o0[r] *= alpha; o1[r] *= alpha; }
    pv_tile(vsm, 0, s0, lane, o0, o1);
    pv_tile(vsm, 32, s1, lane, o0, o1);
}
DEV f32x16 qk32(const char* kbase, const bf16x8* qf, int r32, int h) {
    f32x16 s;
#pragma unroll
    for (int r = 0; r < 16; ++r) s[r] = 0.f;
#pragma unroll
    for (int k = 0; k < 4; ++k) { const bf16x8 a = *(const bf16x8*)(kbase + (r32 * KP + 16 * k + 8 * h) * 2); s = mfma(a, qf[k], s); }
    return s;
}
DEV void flash_update32(f32x16& s, float& m, float& l, f32x16& o0, f32x16& o1, const char* vsm, int kofs, int hstride, int lane) {
    float mx = NEG_INF;
#pragma unroll
    for (int r = 0; r < 16; ++r) mx = fmaxf(mx, s[r]);
    mx = fmaxf(mx, __shfl_xor(mx, 32));
    const float mn = fmaxf(m, mx), mu = (mn == NEG_INF) ? 0.f : mn;
    const float alpha = fexp2(m - mu);
    m = mn;
    float ps = 0.f;
#pragma unroll
    for (int r = 0; r < 16; ++r) { s[r] = fexp2(s[r] - mu); ps += s[r]; }
    l = fmaf(l, alpha, ps);
#pragma unroll
    for (int r = 0; r < 16; ++r) { o0[r] *= alpha; o1[r] *= alpha; }
    const int h = lane >> 5;
    const char* vb = vsm + ((lane >> 4) & 1) * 32 + (lane & 3) * 8 + (4 * h + ((lane & 15) >> 2) + kofs) * 64;
#pragma unroll
    for (int sp = 0; sp < 2; ++sp) {
        u32x4 t; t.x = cvt_pk(s[8 * sp], s[8 * sp + 1]); t.y = cvt_pk(s[8 * sp + 2], s[8 * sp + 3]); t.z = cvt_pk(s[8 * sp + 4], s[8 * sp + 5]); t.w = cvt_pk(s[8 * sp + 6], s[8 * sp + 7]);
        const bf16x8 pb = __builtin_bit_cast(bf16x8, t);
        const bf16x8 a0 = cat4(vtr(vb + (16 * sp) * 64), vtr(vb + (16 * sp + 8) * 64));
        const bf16x8 a1 = cat4(vtr(vb + hstride + (16 * sp) * 64), vtr(vb + hstride + (16 * sp + 8) * 64));
        o0 = mfma(a0, pb, o0); o1 = mfma(a1, pb, o1);
    }
}
DEV void qk_tile_c(const char* ksm, const bf16x8* qf, int r32, int h, const f32x16& c0, const f32x16& c1, f32x16& s0, f32x16& s1) {
    s0 = c0; s1 = c1;
#pragma unroll
    for (int s = 0; s < 4; ++s) {
        const bf16x8 a0 = *(const bf16x8*)(ksm + (r32 * KP + 16 * s + 8 * h) * 2);
        const bf16x8 a1 = *(const bf16x8*)(ksm + ((32 + r32) * KP + 16 * s + 8 * h) * 2);
        s0 = mfma(a0, qf[s], s0); s1 = mfma(a1, qf[s], s1);
    }
}
DEV float max3f(float a, float b, float c) { return fmaxf(fmaxf(a, b), c); }
struct FlashSt { float mref, l; bool unset; f32x16 o0, o1; };
DEV void flash_init(FlashSt& st) { st.mref = 0.f; st.l = 0.f; st.unset = true;
#pragma unroll
    for (int r = 0; r < 16; ++r) { st.o0[r] = 0.f; st.o1[r] = 0.f; } }
DEV bool flash_lazy(f32x16& s0, f32x16& s1, FlashSt& st, const char* vsm, int lane) {
    float mx = max3f(s0[0], s0[1], s1[0]);
#pragma unroll
    for (int r = 1; r < 16; r += 1) mx = (r & 1) ? max3f(mx, s0[r], s1[r]) : mx;
#pragma unroll
    for (int r = 2; r < 16; r += 2) mx = max3f(mx, s0[r], s1[r]);
    mx = fmaxf(mx, __shfl_xor(mx, 32));
    const bool fin = mx > NEG_INF;
    const bool need = fin && (st.unset || mx > 8.0f);
    bool moved = false;
    if (__any(need)) {
        const bool upd = fin && (st.unset || mx > 0.f);
        const float delta = upd ? mx : 0.f;
        const float alpha = st.unset ? 1.0f : fexp2(-delta);
        st.mref += delta; st.l *= alpha;
#pragma unroll
        for (int r = 0; r < 16; ++r) { st.o0[r] *= alpha; st.o1[r] *= alpha; s0[r] -= delta; s1[r] -= delta; }
        st.unset = st.unset && !fin;
        moved = true;
    }
    float ps = 0.f;
#pragma unroll
    for (int r = 0; r < 16; ++r) { s0[r] = fexp2(s0[r]); s1[r] = fexp2(s1[r]); ps += s0[r] + s1[r]; }
    st.l += ps;
    pv_tile(vsm, 0, s0, lane, st.o0, st.o1);
    pv_tile(vsm, 32, s1, lane, st.o0, st.o1);
    return moved;
}
DEV void fill16(f32x16& t, float v) {
#pragma unroll
    for (int r = 0; r < 16; ++r) t[r] = v; }
DEV void write_mix(const Params& p, size_t token, int mixcol0, const f32x16& o0, const f32x16& o1, int h) {
    const bf16_t* G = (const bf16_t*)(p.ws + WS_H) + token * HP + C_GATE + mixcol0;
    bf16_t* M = (bf16_t*)(p.ws + WS_MIX) + token * UP + mixcol0;
#pragma unroll
    for (int dt = 0; dt < 2; ++dt)
#pragma unroll
        for (int a = 0; a < 4; ++a) {
            const int d = 32 * dt + 8 * a + 4 * h;
            const u32x2 g = *(const u32x2*)(G + d);
            const f32x16& o = dt ? o1 : o0;
            u32x2 r; r.x = cvt_pk(o[4 * a] * bf_lo(g.x), o[4 * a + 1] * bf_hi(g.x)); r.y = cvt_pk(o[4 * a + 2] * bf_lo(g.y), o[4 * a + 3] * bf_hi(g.y));
            *(u32x2*)(M + d) = r;
        }
}

DEV void fox_unit(const Params& p, int b, int hh, int qb, char* smem) {
    char* ksm = smem; char* vsm = smem + KT_BYTES; float* cum = (float*)(smem + KT_BYTES + VT_BYTES);
    float* wtot = cum + 2048;
    int tid_ = threadIdx.x; OPAQUE_V(tid_); const int tid = tid_, lane = tid & 63, w = __builtin_amdgcn_readfirstlane(tid >> 6), r32 = lane & 31, h = lane >> 5;
    const int q0 = qb * 128, nneed = q0 + 128;
    const bf16_t* H = (const bf16_t*)(p.ws + WS_H) + (size_t)b * S * HP;
    {
        const float* lf = (const float*)(p.ws + WS_LOGF) + ((size_t)b * 6 + hh) * 2048;
        float v[8]; float s = 0.f;
        if (tid * 8 < nneed) { const f32x4 a = *(const f32x4*)(lf + tid * 8), c = *(const f32x4*)(lf + tid * 8 + 4);
            v[0] = a[0]; v[1] = a[1]; v[2] = a[2]; v[3] = a[3]; v[4] = c[0]; v[5] = c[1]; v[6] = c[2]; v[7] = c[3]; }
        else {
#pragma unroll
            for (int e = 0; e < 8; ++e) v[e] = 0.f; }
#pragma unroll
        for (int e = 0; e < 8; ++e) { s += v[e]; v[e] = s; }
        float inc = s;
#pragma unroll
        for (int o = 1; o < 64; o <<= 1) { const float t = __shfl_up(inc, o); if (lane >= o) inc += t; }
        if (lane == 63) wtot[w] = inc;
        __syncthreads();
        float base = inc - s;
        for (int k = 0; k < w; ++k) base += wtot[k];
        if (tid * 8 < nneed) {
#pragma unroll
            for (int e = 0; e < 8; ++e) cum[tid * 8 + e] = (base + v[e]) * LOG2E; }
        __syncthreads();
    }
    const int tq = q0 + 32 * w + r32;
    bf16x8 qf[4]; load_qf(H + (size_t)tq * HP + C_FOXQ + 64 * hh, h, qf);
    const float cb = cum[tq];
    FlashSt st; flash_init(st);
    const int ntiles = nneed / 64, mylast = (q0 + 32 * w + 31) >> 6, wt0 = q0 + 32 * w;
    KVRegs kvr; kv_load(kvr, H + (size_t)(ntiles - 1) * 64 * HP + C_FOXK + 64 * hh, H + (size_t)(ntiles - 1) * 64 * HP + C_FOXV + 64 * hh, HP, tid);
    for (int kt = ntiles - 1; kt >= 0; --kt) {
        __syncthreads();
        kv_store(kvr, ksm, vsm, tid);
        __syncthreads();
        if (kt > 0) kv_load(kvr, H + (size_t)(kt - 1) * 64 * HP + C_FOXK + 64 * hh, H + (size_t)(kt - 1) * 64 * HP + C_FOXV + 64 * hh, HP, tid);
        if (kt <= mylast) {
            const float cbm = cb - st.mref;
            f32x16 c0, c1;
#pragma unroll
            for (int a = 0; a < 4; ++a) {
                const f32x4 k0 = *(const f32x4*)(cum + kt * 64 + 8 * a + 4 * h), k1 = *(const f32x4*)(cum + kt * 64 + 32 + 8 * a + 4 * h);
#pragma unroll
                for (int k = 0; k < 4; ++k) { c0[4 * a + k] = cbm - k0[k]; c1[4 * a + k] = cbm - k1[k]; }
            }
            if (kt * 64 + 63 > wt0) {
                int lim = tq - 64 * kt - 4 * h; OPAQUE_V(lim);
#pragma unroll
                for (int r = 0; r < 16; ++r) { c0[r] = CR(r) <= lim ? c0[r] : NEG_INF; c1[r] = (CR(r) + 32) <= lim ? c1[r] : NEG_INF; }
            }
            f32x16 s0, s1; qk_tile_c(ksm, qf, r32, h, c0, c1, s0, s1);
            flash_lazy(s0, s1, st, vsm, lane);
        }
    }
    float l = st.l; l += __shfl_xor(l, 32);
    const float inv = 1.0f / l;
    f32x16 o0, o1;
#pragma unroll
    for (int r = 0; r < 16; ++r) { o0[r] = st.o0[r] * inv; o1[r] = st.o1[r] * inv; }
    write_mix(p, (size_t)b * S + tq, 256 + 64 * hh, o0, o1, h);
    __syncthreads();
}

constexpr int BMP = 65;
#ifndef DSA_REP_TOPK
#define DSA_REP_TOPK 1
#endif
#ifndef DSA_REP_IDX
#define DSA_REP_IDX 1
#endif
DEV unsigned ford(float f) { const unsigned u = __float_as_uint(f); return u ^ ((u >> 31) ? 0xffffffffu : 0x80000000u); }
constexpr int TK_NB = 256;
DEV unsigned funord(unsigned k) { return k ^ ((k >> 31) ? 0x80000000u : 0xffffffffu); }
DEV void topk_row(const float* sc, int n, unsigned* bmrow, unsigned* hist  , int lane) {
    const int nch = (n + 63) >> 6;
    if (n <= 256) {
        if (lane < 32) { const int lo = 64 * lane; unsigned long long msk = 0ull;
            if (lo < n) { const int c = n - lo; msk = c >= 64 ? ~0ull : ((1ull << c) - 1ull); }
            bmrow[2 * lane] = (unsigned)msk; bmrow[2 * lane + 1] = (unsigned)(msk >> 32); }
        return;
    }
    const float PINF = __builtin_huge_valf();
    float v[32]; float vmax = NEG_INF, vmin = PINF;
#pragma unroll
    for (int i = 0; i < 32; ++i) {
        v[i] = NEG_INF;
        if (i < nch) { v[i] = sc[64 * i + lane]; vmax = fmaxf(vmax, v[i]);
            if (i < nch - 1) vmin = fminf(vmin, v[i]); else vmin = fminf(vmin, v[i] == NEG_INF ? PINF : v[i]); }
    }
#pragma unroll
    for (int o = 32; o >= 1; o >>= 1) { vmax = fmaxf(vmax, __shfl_xor(vmax, o)); vmin = fminf(vmin, __shfl_xor(vmin, o)); }
    float Tf; bool tiecut = false; int need_eq = 0;
    if (!(vmax > vmin)) { Tf = vmax; tiecut = true; }
    else {
        const float scale = (float)(TK_NB - 1) / (vmax - vmin);
        int bn[32];
#pragma unroll
        for (int q = 0; q < TK_NB / 64; ++q) hist[64 * q + lane] = 0u;
        __builtin_amdgcn_wave_barrier();
#pragma unroll
        for (int i = 0; i < 32; ++i) { bn[i] = TK_NB - 1;
            if (i < nch) { int b = (int)((vmax - v[i]) * scale); b = b > TK_NB - 1 ? TK_NB - 1 : b; bn[i] = b; atomicAdd(&hist[b], 1u); } }
        __builtin_amdgcn_wave_barrier();
        unsigned hb[4]; unsigned sl = 0u;
#pragma unroll
        for (int q = 0; q < 4; ++q) { hb[q] = hist[4 * lane + q]; sl += hb[q]; }
        unsigned pre = sl;
#pragma unroll
        for (int o = 1; o < 64; o <<= 1) { const unsigned t = __shfl_up(pre, o); if (lane >= o) pre += t; }
        const unsigned long long ge = __ballot(pre >= 256u);
        const int Ls = __ffsll((long long)ge) - 1;
        int bstar = 4 * lane; unsigned abv = pre - sl;
        { unsigned cum = pre - sl; bool found = false;
#pragma unroll
          for (int q = 0; q < 4; ++q) { if (!found && cum + hb[q] >= 256u) { bstar = 4 * lane + q; abv = cum; found = true; } cum += hb[q]; } }
        bstar = __shfl(bstar, Ls); abv = __shfl(abv, Ls);
        const int need = 256 - (int)abv;
        const unsigned cntb = hist[bstar];
        __builtin_amdgcn_wave_barrier();
        unsigned T;
        if (cntb > (unsigned)TK_NB) {
            T = 0u;
            for (int bit = 31; bit >= 0; --bit) {
                const unsigned cand = T | (1u << bit); int cnt = 0;
#pragma unroll
                for (int i = 0; i < 32; ++i) if (i < nch) cnt += __popcll(__ballot(ford(v[i]) >= cand));
                if (cnt >= 256) T = cand;
            }
            tiecut = true;
        } else {
            int base = 0;
            const unsigned long long lt = (1ull << lane) - 1ull;
#pragma unroll
            for (int i = 0; i < 32; ++i) if (i < nch) {
                const bool isb = bn[i] == bstar;
                const unsigned long long bal = __ballot(isb);
                if (bal) { if (isb) hist[base + __popcll(bal & lt)] = ford(v[i]); base += __popcll(bal); }
            }
            __builtin_amdgcn_wave_barrier();
            unsigned c[TK_NB / 64];
#pragma unroll
            for (int q = 0; q < TK_NB / 64; ++q) c[q] = (64 * q + lane < (int)cntb) ? hist[64 * q + lane] : 0u;
            const int ncq = ((int)cntb + 63) >> 6;
            T = 0u;
            for (int bit = 31; bit >= 0; --bit) {
                const unsigned cand = T | (1u << bit); int cnt = 0;
#pragma unroll
                for (int q = 0; q < TK_NB / 64; ++q) if (q < ncq) cnt += __popcll(__ballot(c[q] >= cand));
                if (cnt >= need) T = cand;
            }
            int cgt = 0, ceq = 0;
#pragma unroll
            for (int q = 0; q < TK_NB / 64; ++q) if (q < ncq) { cgt += __popcll(__ballot(c[q] > T)); ceq += __popcll(__ballot(c[q] == T)); }
            need_eq = need - cgt;
            tiecut = ceq != need_eq;
            __builtin_amdgcn_wave_barrier();
        }
        Tf = __uint_as_float(funord(T));
    }
    if (!tiecut) {
#pragma unroll
        for (int i = 0; i < 32; ++i) { unsigned long long sm = 0ull; if (i < nch) sm = __ballot(v[i] >= Tf);
            bmrow[2 * i] = (unsigned)sm; bmrow[2 * i + 1] = (unsigned)(sm >> 32); }
    } else {
        int ngt = 0;
#pragma unroll
        for (int i = 0; i < 32; ++i) if (i < nch) ngt += __popcll(__ballot(v[i] > Tf));
        const int need = 256 - ngt; int running = 0;
        const unsigned long long lt = (1ull << lane) - 1ull;
#pragma unroll
        for (int i = 0; i < 32; ++i) {
            unsigned long long sm = 0ull;
            if (i < nch) {
                const bool eq = v[i] == Tf; const unsigned long long bal = __ballot(eq);
                const int pre = running + __popcll(bal & lt);
                const bool sel = (v[i] > Tf) || (eq && pre < need);
                running += __popcll(bal);
                sm = __ballot(sel);
            }
            bmrow[2 * i] = (unsigned)sm; bmrow[2 * i + 1] = (unsigned)(sm >> 32);
        }
    }
}
DEV void dsa_unit(const Params& p, int b, int qb, char* smem) {
    float* sc = (float*)smem;
    unsigned* bm = (unsigned*)(smem + 65536);
    unsigned* hist = (unsigned*)(smem + 65536 + 32 * BMP * 4) + __builtin_amdgcn_readfirstlane(threadIdx.x >> 6) * TK_NB;
    char* ksm = smem; char* vsm = smem + KT_BYTES;
    int tid_ = threadIdx.x; OPAQUE_V(tid_); const int tid = tid_, lane = tid & 63, w = __builtin_amdgcn_readfirstlane(tid >> 6), r32 = lane & 31, h = lane >> 5;
    const int t0 = qb * 32;
    const bf16_t* H = (const bf16_t*)(p.ws + WS_H) + (size_t)b * S * HP;
    const float* IW = (const float*)(p.ws + WS_IW) + (size_t)b * S * 8;
    for (int sb = 0; sb < 4; ++sb) {
        const int ts = t0 + 8 * sb, nkeys = ts + 8, nkt = ((nkeys + 63) >> 6) << 1;
        const int tl = 2 * ((r32 >> 2) & 1) + (r32 >> 4), head = ((r32 >> 3) & 1) * 4 + (r32 & 3);
        bf16x8 af[2][2]; f32x4 wv[2][4];
#pragma unroll
        for (int mt = 0; mt < 2; ++mt) {
#pragma unroll
            for (int ks = 0; ks < 2; ++ks) af[mt][ks] = *(const bf16x8*)(H + (size_t)(ts + 4 * mt + tl) * HP + C_IDXQ + 32 * head + 16 * ks + 8 * h);
#pragma unroll
            for (int a = 0; a < 4; ++a) wv[mt][a] = *(const f32x4*)(IW + (size_t)(ts + 4 * mt + 2 * h + (a >> 1)) * 8 + (a & 1) * 4);
        }
#pragma unroll 1
        for (int rep_ = 0; rep_ < DSA_REP_IDX; ++rep_) {
        bf16x8 bfn[2];
        if (w < nkt) {
#pragma unroll
            for (int ks = 0; ks < 2; ++ks) bfn[ks] = *(const bf16x8*)(H + (size_t)(32 * w + r32) * HP + C_IDXK + 16 * ks + 8 * h); }
        for (int kt = w; kt < nkt; kt += 4) {
            const int key = 32 * kt + r32;
            bf16x8 bf[2]; bf[0] = bfn[0]; bf[1] = bfn[1];
            if (kt + 4 < nkt) {
#pragma unroll
                for (int ks = 0; ks < 2; ++ks) bfn[ks] = *(const bf16x8*)(H + (size_t)(key + 128) * HP + C_IDXK + 16 * ks + 8 * h); }
#pragma unroll
            for (int mt = 0; mt < 2; ++mt) {
                f32x16 acc;
#pragma unroll
                for (int r = 0; r < 16; ++r) acc[r] = 0.f;
                acc = mfma(af[mt][0], bf[0], acc); acc = mfma(af[mt][1], bf[1], acc);
                float sA = 0.f, sB = 0.f;
#pragma unroll
                for (int a = 0; a < 2; ++a)
#pragma unroll
                    for (int k = 0; k < 4; ++k) { sA = fmaf(wv[mt][a][k], fmaxf(acc[4 * a + k], 0.f), sA); sB = fmaf(wv[mt][a + 2][k], fmaxf(acc[4 * (a + 2) + k], 0.f), sB); }
                const int rowA = 4 * mt + 2 * h, tokA = ts + rowA;
                sc[rowA * 2048 + key] = key <= tokA ? sA + 0.0f : NEG_INF;
                sc[(rowA + 1) * 2048 + key] = key <= tokA + 1 ? sB + 0.0f : NEG_INF;
            }
        }
        }
        __syncthreads();
#pragma unroll 1
        for (int rr = 0; rr < 2 * DSA_REP_TOPK; ++rr) { const int row = 2 * w + (rr & 1); topk_row(sc + row * 2048, ts + row + 1, bm + (8 * sb + row) * BMP, hist, lane); }
        __syncthreads();
    }
    const int tq = t0 + r32;
    bf16x8 qf[4]; load_qf(H + (size_t)tq * HP + C_DSAQ + 64 * w, h, qf);
    FlashSt st; flash_init(st);
    f32x16 negm; fill16(negm, 0.f);
    const int ntiles = ((t0 + 31) >> 6) + 1;
    KVRegs kvr; kv_load(kvr, H + C_DSAK, H + C_DSAV, HP, tid);
    for (int kt = 0; kt < ntiles; ++kt) {
        __syncthreads();
        kv_store(kvr, ksm, vsm, tid);
        __syncthreads();
        if (kt + 1 < ntiles) kv_load(kvr, H + (size_t)(kt + 1) * 64 * HP + C_DSAK, H + (size_t)(kt + 1) * 64 * HP + C_DSAV, HP, tid);
        f32x16 s0, s1; qk_tile_c(ksm, qf, r32, h, negm, negm, s0, s1);
        const unsigned w0 = bm[r32 * BMP + 2 * kt] >> (4 * h), w1 = bm[r32 * BMP + 2 * kt + 1] >> (4 * h);
#pragma unroll
        for (int r = 0; r < 16; ++r) { const int bit = (r & 3) + 8 * (r >> 2);
            s0[r] = ((w0 >> bit) & 1u) ? s0[r] : NEG_INF; s1[r] = ((w1 >> bit) & 1u) ? s1[r] : NEG_INF; }
        if (flash_lazy(s0, s1, st, vsm, lane)) fill16(negm, -st.mref);
    }
    float l = st.l; l += __shfl_xor(l, 32);
    const float inv = l > 0.f ? 1.0f / l : 0.f;
    f32x16 o0, o1;
#pragma unroll
    for (int r = 0; r < 16; ++r) { o0[r] = st.o0[r] * inv; o1[r] = st.o1[r] * inv; }
    write_mix(p, (size_t)b * S + tq, 64 * w, o0, o1, h);
    __syncthreads();
}

DEV void cmp_unit(const Params& p, int L, int kv, int b, int g, int cc, char* smem) {
    float* red = (float*)smem;
    float* hid = (float*)(smem + 32768);
    int tid_ = threadIdx.x; OPAQUE_V(tid_); const int tid = tid_, lane = tid & 63, w = __builtin_amdgcn_readfirstlane(tid >> 6), r32 = lane & 31, h = lane >> 5;
    const bf16_t* H = (const bf16_t*)(p.ws + WS_H) + (size_t)b * S * HP + (kv ? C_VC : C_KC) + 64 * g;
    const bf16_t* W1 = (const bf16_t*)(p.ws + WS_W1T) + (size_t)(L * 2 + kv) * 64 * W1P;
    const float* pe = p.cmp_pe + (size_t)(L * 2 + kv) * 32 * 64;
    int c = cc * 32 + r32; if (c > 126) c = 126;
    f32x16 acc[2];
#pragma unroll
    for (int r = 0; r < 16; ++r) { acc[0][r] = 0.f; acc[1][r] = 0.f; }
#pragma unroll 4
    for (int ks = w * 32; ks < w * 32 + 32; ++ks) {
        const int li = ks >> 2, d0 = (ks & 3) * 16 + 8 * h;
        const u32x4 raw = *(const u32x4*)(H + (size_t)(16 * c + li) * HP + d0);
        const f32x4 p0 = *(const f32x4*)(pe + li * 64 + d0), p1 = *(const f32x4*)(pe + li * 64 + d0 + 4);
        u32x4 t; t.x = cvt_pk(bf_lo(raw.x) + p0[0], bf_hi(raw.x) + p0[1]); t.y = cvt_pk(bf_lo(raw.y) + p0[2], bf_hi(raw.y) + p0[3]);
        t.z = cvt_pk(bf_lo(raw.z) + p1[0], bf_hi(raw.z) + p1[1]); t.w = cvt_pk(bf_lo(raw.w) + p1[2], bf_hi(raw.w) + p1[3]);
        const bf16x8 a = __builtin_bit_cast(bf16x8, t);
#pragma unroll
        for (int nt = 0; nt < 2; ++nt) { const bf16x8 bw = *(const bf16x8*)(W1 + (size_t)(32 * nt + r32) * W1P + 16 * ks + 8 * h); acc[nt] = mfma(a, bw, acc[nt]); }
    }
#pragma unroll
    for (int nt = 0; nt < 2; ++nt)
#pragma unroll
        for (int r = 0; r < 16; ++r) red[(w * 32 + crow(r, h)) * 64 + 32 * nt + r32] = acc[nt][r];
    __syncthreads();
#pragma unroll
    for (int i = 0; i < 8; ++i) { const int e = tid + 256 * i; const float v = red[e] + red[2048 + e] + red[4096 + e] + red[6144 + e]; hid[e] = v / (1.0f + __expf(-v)); }
    __syncthreads();
    {
        const int cl = tid >> 3, n2 = (tid & 7) * 8; const float* w2 = p.cmp_w2 + (size_t)(L * 2 + kv) * 64 * 64;
        float o[8];
#pragma unroll
        for (int e = 0; e < 8; ++e) o[e] = 0.f;
        for (int n = 0; n < 64; ++n) { const float hv = hid[cl * 64 + n]; const f32x4 wa = *(const f32x4*)(w2 + n * 64 + n2), wb = *(const f32x4*)(w2 + n * 64 + n2 + 4);
#pragma unroll
            for (int e = 0; e < 4; ++e) { o[e] = fmaf(hv, wa[e], o[e]); o[4 + e] = fmaf(hv, wb[e], o[4 + e]); } }
        const int cg_ = cc * 32 + cl;
        if (cg_ >= 127) {
#pragma unroll
            for (int e = 0; e < 8; ++e) o[e] = 0.f; }
        bf16_t* dst = (bf16_t*)(p.ws + (kv ? WS_VC : WS_KC)) + ((size_t)(b * 2 + g) * 128 + cg_) * 64 + n2;
        *(u32x4*)dst = pack8(o);
    }
    __syncthreads();
}

constexpr int KC_BYTES = 128 * KP * 2;
DEV void nsa_unit(const Params& p, int b, int g, int qb, int j, char* smem) {
    char* kcs = smem;
    char* vcs = smem + KC_BYTES;
    char* ksm = smem + KC_BYTES + 16384;
    char* vsm = ksm + KT_BYTES;
    float* scr = (float*)(vsm + VT_BYTES);
    unsigned* uni = (unsigned*)(scr + 4 * 32 * 33);
    int tid_ = threadIdx.x; OPAQUE_V(tid_); const int tid = tid_, lane = tid & 63, w = __builtin_amdgcn_readfirstlane(tid >> 6), r32 = lane & 31, h = lane >> 5;
    const int q0 = qb * 128, tq = q0 + 32 * w + r32;
    const bf16_t* H = (const bf16_t*)(p.ws + WS_H) + (size_t)b * S * HP;
    {
        const bf16_t* kc = (const bf16_t*)(p.ws + WS_KC) + (size_t)(b * 2 + g) * 128 * 64;
        const bf16_t* vc = (const bf16_t*)(p.ws + WS_VC) + (size_t)(b * 2 + g) * 128 * 64;
#pragma unroll
        for (int i = 0; i < 4; ++i) { const int c = tid + 256 * i, row = c >> 3, ch = c & 7;
            *(u32x4*)(kcs + (row * KP + ch * 8) * 2) = *(const u32x4*)(kc + row * 64 + ch * 8);
            *(u32x4*)(vcs + (ch >> 2) * 8192 + row * 64 + (ch & 3) * 16) = *(const u32x4*)(vc + row * 64 + ch * 8); }
    }
    __syncthreads();
    const int clim_ = tq >= 31 ? ((tq - 31) >> 4) : -1;
    const int climh = (clim_ > 126 ? 126 : clim_) - 4 * h;
    float B4[16], E[16];
#pragma unroll
    for (int i = 0; i < 16; ++i) { B4[i] = 0.f; E[i] = 0.f; }
#pragma unroll 1
    for (int jj = 0; jj < 3; ++jj) {
        bf16x8 qf[4]; load_qf(H + (size_t)tq * HP + C_NSAQ + 64 * (3 * g + jj), h, qf);
        float mrun = NEG_INF, lrun = 0.f;
#pragma unroll
        for (int n = 0; n < 4; ++n) {
            f32x16 st = qk32(kcs + n * 32 * KP * 2, qf, r32, h);
            float mx = NEG_INF;
            int lim = climh; OPAQUE_V(lim);
#pragma unroll
            for (int r = 0; r < 16; ++r) { st[r] = (32 * n + CR(r)) <= lim ? st[r] : NEG_INF; mx = fmaxf(mx, st[r]); }
            const float mn = fmaxf(mrun, mx), mu = mn == NEG_INF ? 0.f : mn;
            float ps = 0.f;
#pragma unroll
            for (int r = 0; r < 16; ++r) ps += fexp2(st[r] - mu);
            lrun = fmaf(lrun, fexp2(mrun - mu), ps); mrun = mn;
            __builtin_amdgcn_sched_barrier(0);
        }
        const float mo = __shfl_xor(mrun, 32), lo = __shfl_xor(lrun, 32);
        const float M = fmaxf(mrun, mo), Mu = M == NEG_INF ? 0.f : M;
        const float Lt = lrun * fexp2(mrun - Mu) + lo * fexp2(mo - Mu);
        const float inv = 1.0f / fmaxf(Lt, 1e-30f);
#pragma unroll
        for (int n = 0; n < 4; ++n) {
            f32x16 st = qk32(kcs + n * 32 * KP * 2, qf, r32, h);
            int lim = climh; OPAQUE_V(lim);
#pragma unroll
            for (int a = 0; a < 4; ++a) {
                float pr[4];
#pragma unroll
                for (int k = 0; k < 4; ++k) pr[k] = (32 * n + 8 * a + k) <= lim ? fexp2(st[4 * a + k] - Mu) * inv : 0.f;
                B4[4 * n + a] += (pr[0] + pr[1]) + (pr[2] + pr[3]); E[4 * n + a] += pr[3];
            }
            __builtin_amdgcn_sched_barrier(0);
        }
    }
    {
        float* my = scr + (w * 32 + r32) * 33;
#pragma unroll
        for (int i = 0; i < 16; ++i) { const float eo = __shfl_xor(E[i], 32); E[i] = eo; }
#pragma unroll
        for (int i = 0; i < 16; ++i) { const float prev = h ? E[i] : (i > 0 ? E[i - 1] : 0.f); my[2 * i + h] = B4[i] + prev; }
    }
    __builtin_amdgcn_wave_barrier();
    unsigned sel;
    {
        const float* my = scr + (w * 32 + r32) * 33; const int cur = tq >> 6;
        float v[32];
#pragma unroll
        for (int n = 0; n < 32; ++n) { float s_ = my[n]; const bool forced = (n == 0) || (n == cur) || (n == cur - 1); const bool fut = 64 * n > tq;
            v[n] = forced ? __builtin_huge_valf() : (fut ? NEG_INF : s_); }
        unsigned mk = 0u;
#pragma unroll
        for (int i = 0; i < 32; ++i) {
            int rank = 0;
#pragma unroll
            for (int n = 0; n < 32; ++n) { if (n < i) rank += (v[n] >= v[i]) ? 1 : 0; else if (n > i) rank += (v[n] > v[i]) ? 1 : 0; }
            if (rank < 16 && 64 * i <= tq) mk |= 1u << i;
        }
        sel = mk;
    }
    unsigned wsel = sel;
#pragma unroll
    for (int o = 16; o >= 1; o >>= 1) wsel |= __shfl_xor(wsel, o);
    if (lane == 0) uni[w] = wsel;
    __syncthreads();
    const unsigned bsel = uni[0] | uni[1] | uni[2] | uni[3];
    const float* gs = (const float*)(p.ws + WS_GSIG) + ((size_t)b * S + tq) * 20;
    const float g0 = gs[0 * 6 + g * 3 + j], g1 = gs[1 * 6 + g * 3 + j], g2 = gs[2 * 6 + g * 3 + j];
    f32x16 ot0, ot1;
    {
        bf16x8 qf[4]; load_qf(H + (size_t)tq * HP + C_NSAQ + 64 * (3 * g + j), h, qf);
        float m = NEG_INF, l = 0.f; f32x16 o0, o1;
#pragma unroll
        for (int r = 0; r < 16; ++r) { o0[r] = 0.f; o1[r] = 0.f; }
#pragma unroll 1
        for (int n = 0; n < 4; ++n) {
            f32x16 st = qk32(kcs + n * 32 * KP * 2, qf, r32, h);
            int lim = climh - 32 * n; OPAQUE_V(lim);
#pragma unroll
            for (int r = 0; r < 16; ++r) st[r] = CR(r) <= lim ? st[r] : NEG_INF;
            flash_update32(st, m, l, o0, o1, vcs, 32 * n, 8192, lane);
        }
        l += __shfl_xor(l, 32);
        const float sc_ = l > 0.f ? g0 / l : 0.f;
#pragma unroll
        for (int r = 0; r < 16; ++r) { ot0[r] = o0[r] * sc_; ot1[r] = o1[r] * sc_; }
    }
    bf16x8 qr[4]; load_qf((const bf16_t*)(p.ws + WS_QROT) + ((size_t)b * S + tq) * 384 + 64 * (3 * g + j), h, qr);
    {
        FlashSt st; flash_init(st);
        f32x16 negm; fill16(negm, 0.f);
        unsigned rem = bsel;
        KVRegs kvr; kv_load(kvr, H + C_KS + 64 * g, H + C_VS + 64 * g, HP, tid);
        const int wt0 = q0 + 32 * w;
        while (rem) {
            const int nb = __ffs(rem) - 1; rem &= rem - 1u;
            __syncthreads();
            kv_store(kvr, ksm, vsm, tid);
            __syncthreads();
            if (rem) { const int nx = __ffs(rem) - 1; kv_load(kvr, H + (size_t)nx * 64 * HP + C_KS + 64 * g, H + (size_t)nx * 64 * HP + C_VS + 64 * g, HP, tid); }
            if ((wsel >> nb) & 1u) {
                f32x16 s0, s1; qk_tile_c(ksm, qr, r32, h, negm, negm, s0, s1);
                int lim = ((sel >> nb) & 1u) ? tq - 64 * nb - 4 * h : -1; OPAQUE_V(lim);
#pragma unroll
                for (int r = 0; r < 16; ++r) { s0[r] = CR(r) <= lim ? s0[r] : NEG_INF; s1[r] = (CR(r) + 32) <= lim ? s1[r] : NEG_INF; }
                if (flash_lazy(s0, s1, st, vsm, lane)) fill16(negm, -st.mref);
            }
        }
        float l = st.l; l += __shfl_xor(l, 32);
        const float sc_ = l > 0.f ? g1 / l : 0.f;
#pragma unroll
        for (int r = 0; r < 16; ++r) { ot0[r] = fmaf(st.o0[r], sc_, ot0[r]); ot1[r] = fmaf(st.o1[r], sc_, ot1[r]); }
    }
    {
        FlashSt st; flash_init(st);
        f32x16 negm; fill16(negm, 0.f);
        const int kfirst = q0 >= 512 ? (q0 - 512) >> 6 : 0, klast = (q0 + 127) >> 6;
        const int wt0 = q0 + 32 * w;
        const int wfirst = wt0 >= 511 ? (wt0 - 511) >> 6 : 0, wlast = (wt0 + 31) >> 6;
        KVRegs kvr; kv_load(kvr, H + (size_t)kfirst * 64 * HP + C_KW + 64 * g, H + (size_t)kfirst * 64 * HP + C_VW + 64 * g, HP, tid);
        for (int kt = kfirst; kt <= klast; ++kt) {
            __syncthreads();
            kv_store(kvr, ksm, vsm, tid);
            __syncthreads();
            if (kt < klast) kv_load(kvr, H + (size_t)(kt + 1) * 64 * HP + C_KW + 64 * g, H + (size_t)(kt + 1) * 64 * HP + C_VW + 64 * g, HP, tid);
            if (kt >= wfirst && kt <= wlast) {
                f32x16 s0, s1; qk_tile_c(ksm, qr, r32, h, negm, negm, s0, s1);
                if (!(64 * kt + 63 <= wt0 && 64 * kt > wt0 + 31 - 512)) {
                    int lim = tq - 64 * kt - 4 * h; OPAQUE_V(lim);
#pragma unroll
                    for (int r = 0; r < 16; ++r) { s0[r] = (unsigned)(lim - CR(r)) < 512u ? s0[r] : NEG_INF; s1[r] = (unsigned)(lim - CR(r) - 32) < 512u ? s1[r] : NEG_INF; }
                }
                if (flash_lazy(s0, s1, st, vsm, lane)) fill16(negm, -st.mref);
            }
        }
        float l = st.l; l += __shfl_xor(l, 32);
        const float sc_ = l > 0.f ? g2 / l : 0.f;
#pragma unroll
        for (int r = 0; r < 16; ++r) { ot0[r] = fmaf(st.o0[r], sc_, ot0[r]); ot1[r] = fmaf(st.o1[r], sc_, ot1[r]); }
    }
    write_mix(p, (size_t)b * S + tq, 640 + 64 * (3 * g + j), ot0, ot1, h);
    __syncthreads();
}


#define XB_TMO      128
#define XB_XCNT(j)  (256  + 64 * (j))
#define XB_XSUB(j)  (1280 + 64 * (j))
#define XB_XGEN(j)  (2304 + 64 * (j))
#define XB_TOP      3328
#define XB_TOPGEN   3392
#define XCD_BAR_WORDS 3456
#define XB_SPIN_CAP (1u << 22)
DEV unsigned xb_ld(unsigned* p) { return __hip_atomic_load(p, __ATOMIC_RELAXED, __HIP_MEMORY_SCOPE_AGENT); }
DEV unsigned xb_add(unsigned* p, unsigned v) { return __hip_atomic_fetch_add(p, v, __ATOMIC_RELAXED, __HIP_MEMORY_SCOPE_AGENT); }
DEV unsigned xb_xcc_id() { return (unsigned)__builtin_amdgcn_s_getreg((3 << 11) | 20) & 0xFu; }
#define XB_SPIN(cond, bar) do { unsigned _sp = 0; while (cond) { __builtin_amdgcn_s_sleep(1); \
    if ((++_sp & 255u) == 0u) { if (xb_ld(&(bar)[XB_TMO])) break; if (_sp > XB_SPIN_CAP) { atomicAdd(&(bar)[XB_TMO], 1u); break; } } } } while (0)
struct XcdBarrier { unsigned* bar; unsigned x; volatile LDSAS unsigned* st; };
DEV XcdBarrier xcd_barrier_post(unsigned* bar, volatile LDSAS unsigned* st) {
    XcdBarrier b; b.bar = bar; b.x = xb_xcc_id(); b.st = st;
    if (threadIdx.x == 0) (void)xb_add(&bar[XB_XCNT(b.x)], 1u);
    return b;
}
DEV void xcd_barrier_complete(unsigned* bar, unsigned x, unsigned& nloc, unsigned& nx) {
    const unsigned G = gridDim.x * gridDim.y * gridDim.z;
    unsigned sum, cnt, mine, sp = 0u;
    for (;;) {
        sum = 0u; cnt = 0u; mine = 0u;
#pragma unroll
        for (unsigned j = 0; j < 16; ++j) { const unsigned c = xb_ld(&bar[XB_XCNT(j)]); sum += c; cnt += (c > 0u) ? 1u : 0u; mine = (j == x) ? c : mine; }
        if (sum == G) break;
        __builtin_amdgcn_s_sleep(1);
        if ((++sp & 255u) == 0u) { if (xb_ld(&bar[XB_TMO])) break; if (sp > XB_SPIN_CAP) { atomicAdd(&bar[XB_TMO], 1u); break; } }
    }
    nloc = mine > 0u ? mine : 1u; nx = cnt > 0u ? cnt : 1u;
}
DEV void xcd_barrier(const XcdBarrier& b) {
    asm volatile("s_waitcnt vmcnt(0)" ::: "memory");
    __syncthreads();
    if (threadIdx.x == 0) {
        unsigned* bar = b.bar;
        __builtin_amdgcn_s_waitcnt(0);
        unsigned nloc = b.st[0], nx = b.st[1];
        if (nloc == 0u) { xcd_barrier_complete(bar, b.x, nloc, nx); b.st[0] = nloc; b.st[1] = nx; }
        const unsigned old = xb_add(&bar[XB_XSUB(b.x)], 1u);
        const unsigned gen = old / nloc;
        if (old + 1u == (gen + 1u) * nloc) {
            __builtin_amdgcn_fence(__ATOMIC_RELEASE, "agent");
            asm volatile("s_waitcnt vmcnt(0)" ::: "memory");
            const unsigned og = xb_add(&bar[XB_TOP], 1u);
            const unsigned tg = og / nx;
            if (og + 1u == (tg + 1u) * nx) xb_add(&bar[XB_TOPGEN], 1u);
            else XB_SPIN(xb_ld(&bar[XB_TOPGEN]) == tg, bar);
            __builtin_amdgcn_fence(__ATOMIC_ACQUIRE, "agent");
            xb_add(&bar[XB_XGEN(b.x)], 1u);
            asm volatile("s_waitcnt vmcnt(0)" ::: "memory");
        } else {
            XB_SPIN(xb_ld(&bar[XB_XGEN(b.x)]) == gen, bar);
            __builtin_amdgcn_fence(__ATOMIC_ACQUIRE, "agent");
            asm volatile("s_waitcnt vmcnt(0)" ::: "memory");
        }
    }
    __syncthreads();
}
DEV int grab_unit(unsigned* ctr, char* smem) {
    volatile LDSAS unsigned* st = (volatile LDSAS unsigned*)(smem + SMEM_BYTES - 16);
    __syncthreads();
    if (threadIdx.x == 0) st[2] = __hip_atomic_fetch_add(ctr, 1u, __ATOMIC_RELAXED, __HIP_MEMORY_SCOPE_AGENT);
    __syncthreads();
    return (int)st[2];
}
DEV void phase_mid(const Params& p, int L, char* smem, unsigned* ctr, int tmask = 7) {
    constexpr int N_CMP = 128, N_TOT = 128 + 512 + 768;
    for (;;) {
        const int u = grab_unit(ctr, smem);
        if (u >= N_TOT) break;
        int v = u;
        if (v < 256) { const int qb = 63 - (v >> 3), b = v & 7; if (tmask & 1) dsa_unit(p, b, qb, smem); continue; }
        v -= 256;
        if (v < N_CMP) { const int kv = v & 1, g = (v >> 1) & 1, cc = (v >> 2) & 3, b = v >> 4; if (tmask & 4) cmp_unit(p, L, kv, b, g, cc, smem); continue; }
        v -= N_CMP;
        const int sI = 15 - (v >> 6), r = v & 63;
        if (r < 48) { if (tmask & 2) fox_unit(p, r / 6, r % 6, sI, smem); }
        else { const int r2 = r - 48, qb = 2 * sI + 1 - (r2 >> 3), b = r2 & 7; if (tmask & 1) dsa_unit(p, b, qb, smem); }
    }
}
DEV void phase_nsa(const Params& p, char* smem, unsigned* ctr) {
    for (;;) {
        const int u = grab_unit(ctr, smem);
        if (u >= 768) break;
        const int qb = 15 - u / 48, r = u % 48, b = r / 6, g = (r % 6) / 3, j = r % 3;
        nsa_unit(p, b, g, qb, j, smem);
    }
}
#ifndef PHASE_MASK
#define PHASE_MASK 0xffff
#endif
DEV void run_phase(const Params& p, int ph, char* smem, int rep = 0) {
    unsigned* ctr = (unsigned*)(p.ws + WS_CTRL) + 3584 + 16 * (ph + 12 * rep);
    if (ph == 0) { if (PHASE_MASK & 1) phase_prep(p, smem); return; }
    if (ph == 1) { if (PHASE_MASK & 2) phase_u1(p); return; }
    const int L = (ph - 2) / 5, k = (ph - 2) % 5;
    if (k == 0) { if (PHASE_MASK & 4) phase_gemm_in(p, L, smem); }
    else if (k == 1) { if (PHASE_MASK & 8) phase_mid(p, L, smem, ctr); }
    else if (k == 2) { if (PHASE_MASK & 16) phase_nsa(p, smem, ctr); }
    else if (k == 3) { if (PHASE_MASK & 32) phase_out(p, L, smem); }
    else { if (PHASE_MASK & 64) phase_ln(p, L); }
}
constexpr int N_PHASES = 12;

#ifndef REPEAT_KIND
#define REPEAT_KIND -1
#endif
DEV int phase_kind(int ph) { return ph < 2 ? ph : 2 + (ph - 2) % 5; }
template <bool COOP>
__global__ void __launch_bounds__(256, 2) mega(Params p, int ph_lo, int ph_hi) {
    extern __shared__ __attribute__((aligned(16))) char smem[];
    volatile LDSAS unsigned* st = (volatile LDSAS unsigned*)(smem + SMEM_BYTES - 16);
    XcdBarrier xb;
    if (COOP) {
        if (threadIdx.x == 0) { st[0] = 0u; st[1] = 0u; }
        __syncthreads();
        xb = xcd_barrier_post((unsigned*)(p.ws + WS_CTRL), st);
    }
    for (int ph = ph_lo; ph < ph_hi; ++ph) {
        run_phase(p, ph, smem);
        if (COOP) {
            if (REPEAT_KIND >= 0 && REPEAT_KIND < 7 && phase_kind(ph) == REPEAT_KIND) { xcd_barrier(xb); run_phase(p, ph, smem, 1); }
            if (REPEAT_KIND >= 7 && REPEAT_KIND <= 9 && phase_kind(ph) == 3) { xcd_barrier(xb); phase_mid(p, (ph - 2) / 5, smem, (unsigned*)(p.ws + WS_CTRL) + 3584 + 16 * (ph + 12), 1 << (REPEAT_KIND - 7)); }
            if (ph + 1 < ph_hi) xcd_barrier(xb);
        }
    }
}

#ifndef N_LAUNCH_MODE
#define N_LAUNCH_MODE 1
#endif

extern "C" void kernel_launch(void* const* d_in, const int* in_sizes, int n_in, void* d_out, int out_size, void* d_ws, size_t ws_size, hipStream_t stream) {
    static int grid = 0;
    if (grid == 0) {
        int dev = 0, cus = 0, per_cu = 0;
        hipGetDevice(&dev);
        hipDeviceGetAttribute(&cus, hipDeviceAttributeMultiprocessorCount, dev);
        hipFuncSetAttribute((const void*)mega<true>, hipFuncAttributeMaxDynamicSharedMemorySize, SMEM_BYTES);
        hipFuncSetAttribute((const void*)mega<false>, hipFuncAttributeMaxDynamicSharedMemorySize, SMEM_BYTES);
        hipOccupancyMaxActiveBlocksPerMultiprocessor(&per_cu, (const void*)mega<true>, 256, SMEM_BYTES);
        if (per_cu < 1) per_cu = 1;
        if (per_cu > 2) per_cu = 2;
        grid = cus * per_cu;
        if (ws_size < WS_END) { fprintf(stderr, "workspace too small: %zu < %zu\n", ws_size, (size_t)WS_END); grid = -1; }
    }
    if (grid < 0) return;
    Params p{};
    p.x = (const float*)d_in[0]; p.c = (const float*)d_in[1]; p.w_ada = (const float*)d_in[2]; p.b_ada = (const float*)d_in[3];
    p.w_in = (const float*)d_in[4]; p.b_f = (const float*)d_in[5]; p.cmp_pe = (const float*)d_in[6]; p.cmp_w1 = (const float*)d_in[7];
    p.cmp_w2 = (const float*)d_in[8]; p.w_out = (const float*)d_in[9]; p.ln_g = (const float*)d_in[10]; p.ln_b = (const float*)d_in[11];
    p.out = (float*)d_out; p.ws = (char*)d_ws;
    (void)hipMemsetAsync((char*)d_ws + WS_CTRL, 0, 16384, stream);
#if N_LAUNCH_MODE == 1
    hipLaunchKernelGGL(mega<true>, dim3(grid), dim3(256), SMEM_BYTES, stream, p, 0, N_PHASES);
#else
    for (int ph = 0; ph < N_PHASES; ++ph) hipLaunchKernelGGL(mega<false>, dim3(grid), dim3(256), SMEM_BYTES, stream, p, ph, ph + 1);
#endif
}
```

```cpp
#include <hip/hip_runtime.h>
#include <hip/hip_cooperative_groups.h>
#include <stdint.h>
#include <stdio.h>
namespace cg = cooperative_groups;

#define DEV __device__ __forceinline__
typedef unsigned short bf16_t;
typedef short bf16x8 __attribute__((ext_vector_type(8)));
typedef short s16x4 __attribute__((ext_vector_type(4)));
typedef float f32x16 __attribute__((ext_vector_type(16)));
typedef float f32x4 __attribute__((ext_vector_type(4)));
typedef float f32x2 __attribute__((ext_vector_type(2)));
typedef unsigned u32x4 __attribute__((ext_vector_type(4)));
typedef unsigned u32x2 __attribute__((ext_vector_type(2)));
typedef short v4i16_t __attribute__((ext_vector_type(4)));
#define LDSAS __attribute__((address_space(3)))

constexpr int NB = 8, S = 2048, DM = 1024, NTOK = NB * S;
constexpr int HP = 4160, UP = 1088, WP = 1088, ZP = 1088, W1P = 2112;
constexpr int C_DSAQ = 0, C_DSAK = 256, C_DSAV = 320, C_IDXQ = 384, C_IDXK = 640, C_MISC = 672, C_FOXQ = 704, C_FOXK = 1088, C_FOXV = 1472,
              C_NSAQ = 1856, C_KC = 2240, C_VC = 2368, C_KS = 2496, C_VS = 2624, C_KW = 2752, C_VW = 2880, C_GATE = 3008;
constexpr float LOG2E = 1.4426950408889634f;
constexpr float QS = 0.125f * LOG2E;
constexpr float ALPHA = 1.4142135623730951f;
constexpr float NEG_INF = -__builtin_huge_valf();

constexpr size_t WS_CTRL = 0;
constexpr size_t WS_MOD = 16384;
constexpr size_t WS_CS64 = WS_MOD + 2 * 8 * 3072 * 4;
constexpr size_t WS_CS32 = WS_CS64 + 2048 * 32 * 8;
constexpr size_t WS_WINT = WS_CS32 + 2048 * 16 * 8;
constexpr size_t WS_WOUTT = WS_WINT + (size_t)2 * 4096 * WP * 2;
constexpr size_t WS_W1T = WS_WOUTT + (size_t)2 * 1024 * WP * 2;
constexpr size_t WS_U = WS_W1T + (size_t)2 * 2 * 64 * W1P * 2;
constexpr size_t WS_MIX = WS_U + (size_t)NTOK * UP * 2;
constexpr size_t WS_QROT = WS_MIX + (size_t)NTOK * UP * 2;
constexpr size_t WS_IW = WS_QROT + (size_t)NTOK * 384 * 2;
constexpr size_t WS_GSIG = WS_IW + (size_t)NTOK * 8 * 4;
constexpr size_t WS_LOGF = WS_GSIG + (size_t)NTOK * 20 * 4;
constexpr size_t WS_KC = WS_LOGF + (size_t)8 * 6 * 2048 * 4;
constexpr size_t WS_VC = WS_KC + (size_t)8 * 2 * 128 * 64 * 2;
constexpr size_t WS_H = WS_VC + (size_t)8 * 2 * 128 * 64 * 2;
constexpr size_t WS_BM = WS_H + (size_t)NTOK * HP * 2;
constexpr size_t WS_END = WS_BM + (size_t)NTOK * 64 * 4;
static_assert(WS_END <= (size_t)256 * 1024 * 1024, "workspace");

constexpr int SMEM_BYTES = 78848;

struct Params {
    const float *x, *c, *w_ada, *b_ada, *w_in, *b_f, *cmp_pe, *cmp_w1, *cmp_w2, *w_out, *ln_g, *ln_b;
    float* out; char* ws;
};

#define OPAQUE_V(x) asm volatile("" : "+v"(x))
#define CR(r) (((r) & 3) + 8 * ((r) >> 2))
DEV int crow(int r, int h) { return (r & 3) + 8 * (r >> 2) + 4 * h; }
typedef __bf16 bf16x2_t __attribute__((ext_vector_type(2)));
DEV unsigned cvt_pk(float lo, float hi) { const f32x2 v = {lo, hi}; return __builtin_bit_cast(unsigned, __builtin_convertvector(v, bf16x2_t)); }
DEV float bf_lo(unsigned v) { return __uint_as_float(v << 16); }
DEV float bf_hi(unsigned v) { return __uint_as_float(v & 0xffff0000u); }
DEV f32x16 mfma(bf16x8 a, bf16x8 b, f32x16 c) { return __builtin_amdgcn_mfma_f32_32x32x16_bf16(a, b, c, 0, 0, 0); }
DEV float fexp2(float x) { return __builtin_amdgcn_exp2f(x); }
DEV s16x4 vtr(const char* p) { return __builtin_bit_cast(s16x4, __builtin_amdgcn_ds_read_tr16_b64_v4i16((LDSAS v4i16_t*)p)); }
DEV bf16x8 cat4(s16x4 a, s16x4 b) { bf16x8 r; r[0] = a[0]; r[1] = a[1]; r[2] = a[2]; r[3] = a[3]; r[4] = b[0]; r[5] = b[1]; r[6] = b[2]; r[7] = b[3]; return r; }
DEV u32x4 pack8(const float* v) { u32x4 r; r.x = cvt_pk(v[0], v[1]); r.y = cvt_pk(v[2], v[3]); r.z = cvt_pk(v[4], v[5]); r.w = cvt_pk(v[6], v[7]); return r; }
DEV float sigmoidf_(float v) { return 1.0f / (1.0f + __expf(-v)); }

DEV void sincos_acc(float a, float& sn, float& cs) {
    const float q = rintf(a * 0.6366197723675814f);
    float y = fmaf(-q, 1.5703125f, a); y = fmaf(-q, 4.837512969970703125e-4f, y); y = fmaf(-q, 7.54978995489188216e-8f, y);
    const float z = y * y;
    const float sp = y + y * z * (-1.6666654611e-1f + z * (8.3321608736e-3f + z * (-1.9515295891e-4f)));
    const float cp = 1.0f + z * (-0.5f + z * (4.166664568298827e-2f + z * (-1.388731625493765e-3f + z * 2.443315711809948e-5f)));
    const int qi = ((int)q) & 3;
    sn = (qi == 0) ? sp : (qi == 1) ? cp : (qi == 2) ? -sp : -cp;
    cs = (qi == 0) ? cp : (qi == 1) ? -sp : (qi == 2) ? -cp : sp;
}

DEV int win_srccol(int n) {
    if (n < 672) return n;
    if (n < 704) { const int j = n - 672; return j < 8 ? 672 + j : (j < 14 ? 1832 + (j - 8) : 2990 + (j - 14)); }
    if (n < 1856) return 680 + (n - 704);
    if (n < 3008) return 1838 + (n - 1856);
    if (n < 4032) return n;
    return -1;
}
DEV void transpose_unit(const float* __restrict__ src, int ldsrc, bf16_t* __restrict__ dst, int ldd, int n0, int k0, bool winmap, char* smem) {
    float* t = (float*)smem;
    int tid_ = threadIdx.x; OPAQUE_V(tid_); const int tid = tid_;
    {
        const int nn = tid & 63, n = n0 + nn; const int sc = winmap ? win_srccol(n) : n;
#pragma unroll
        for (int i = 0; i < 16; ++i) { const int kk = (tid >> 6) + 4 * i; t[kk * 65 + nn] = sc >= 0 ? src[(size_t)(k0 + kk) * ldsrc + sc] : 0.f; }
    }
    __syncthreads();
    {
        const int nn = tid >> 2, kq = tid & 3; float v[16];
#pragma unroll
        for (int j = 0; j < 16; ++j) v[j] = t[(kq * 16 + j) * 65 + nn];
        u32x4* d = (u32x4*)(dst + (size_t)(n0 + nn) * ldd + k0 + kq * 16);
        d[0] = pack8(v); d[1] = pack8(v + 8);
    }
    __syncthreads();
}
DEV void mod_unit(const Params& p, int L, int cgi, char* smem) {
    float* cs = (float*)smem;
    float* red = (float*)(smem + 32768);
    int tid_ = threadIdx.x; OPAQUE_V(tid_); const int tid = tid_;
#pragma unroll
    for (int i = 0; i < 32; ++i) cs[tid + 256 * i] = p.c[tid + 256 * i];
    __syncthreads();
    const int cc = tid & 31, kk = tid >> 5, col = cgi * 32 + cc;
    float acc[8];
#pragma unroll
    for (int b = 0; b < 8; ++b) acc[b] = 0.f;
    const float* w = p.w_ada + ((size_t)L * 1024 + kk * 128) * 3072 + col;
#pragma unroll 8
    for (int k = 0; k < 128; ++k) {
        const float wv = w[(size_t)k * 3072];
#pragma unroll
        for (int b = 0; b < 8; ++b) acc[b] = fmaf(cs[b * 1024 + kk * 128 + k], wv, acc[b]);
    }
#pragma unroll
    for (int b = 0; b < 8; ++b) red[(kk * 8 + b) * 32 + cc] = acc[b];
    __syncthreads();
    {
        const int b = tid >> 5; float s = p.b_ada[L * 3072 + col];
#pragma unroll
        for (int k2 = 0; k2 < 8; ++k2) s += red[(k2 * 8 + b) * 32 + cc];
        ((float*)(p.ws + WS_MOD))[(L * 8 + b) * 3072 + col] = s;
    }
    __syncthreads();
}
DEV void phase_prep(const Params& p, char* smem) {
    constexpr int N_MOD = 192, N_TAB = 384, N_WIN = 2048, N_WOUT = 512, N_W1 = 128;
    constexpr int TOT = N_MOD + N_TAB + N_WIN + N_WOUT + N_W1;
    for (int u = blockIdx.x; u < TOT; u += gridDim.x) {
        int v = u;
        if (v < N_MOD) { mod_unit(p, v / 96, v % 96, smem); continue; }
        v -= N_MOD;
        if (v < N_TAB) {
            int tx_ = threadIdx.x; OPAQUE_V(tx_); const int idx = v * 256 + tx_;
            if (idx < 65536) {
                const int pos = idx >> 5, i = idx & 31; const float inv = powf(10000.0f, -(float)i / 32.0f);
                float sn, cs; sincos_acc((float)pos * inv, sn, cs);
                ((f32x2*)(p.ws + WS_CS64))[idx] = (f32x2){cs, sn};
            } else {
                const int id2 = idx - 65536; const int pos = id2 >> 4, i = id2 & 15; const float inv = powf(10000.0f, -(float)i / 16.0f);
                float sn, cs; sincos_acc((float)pos * inv, sn, cs);
                ((f32x2*)(p.ws + WS_CS32))[id2] = (f32x2){cs, sn};
            }
            continue;
        }
        v -= N_TAB;
        if (v < N_WIN) { const int L = v >> 10, r = v & 1023, nt = r >> 4, kt = r & 15;
            transpose_unit(p.w_in + (size_t)L * 1024 * 4032, 4032, (bf16_t*)(p.ws + WS_WINT) + (size_t)L * 4096 * WP, WP, nt * 64, kt * 64, true, smem); continue; }
        v -= N_WIN;
        if (v < N_WOUT) { const int L = v >> 8, r = v & 255, nt = r >> 4, kt = r & 15;
            transpose_unit(p.w_out + (size_t)L * 1024 * 1024, 1024, (bf16_t*)(p.ws + WS_WOUTT) + (size_t)L * 1024 * WP, WP, nt * 64, kt * 64, false, smem); continue; }
        v -= N_WOUT;
        { const int lk = v >> 5, kt = v & 31;
            transpose_unit(p.cmp_w1 + (size_t)lk * 2048 * 64, 64, (bf16_t*)(p.ws + WS_W1T) + (size_t)lk * 64 * W1P, W1P, 0, kt * 64, false, smem); }
    }
}

DEV void phase_u1(const Params& p) {
    const float* mod = (const float*)(p.ws + WS_MOD);
    bf16_t* U = (bf16_t*)(p.ws + WS_U);
    for (int u = blockIdx.x; u < 2048; u += gridDim.x) {
        int tx_ = threadIdx.x; OPAQUE_V(tx_);
#pragma unroll
        for (int i = 0; i < 4; ++i) {
            const int e = tx_ + 256 * i, row = 8 * u + (e >> 7), c8 = (e & 127) * 8, b = row >> 11;
            const f32x4* xp = (const f32x4*)(p.x + (size_t)row * 1024 + c8);
            const f32x4* sh = (const f32x4*)(mod + (size_t)b * 3072 + c8);
            const f32x4* sc = (const f32x4*)(mod + (size_t)b * 3072 + 1024 + c8);
            float v[8];
#pragma unroll
            for (int q = 0; q < 2; ++q) { const f32x4 xv = xp[q], s1 = sc[q], s0 = sh[q];
#pragma unroll
                for (int k = 0; k < 4; ++k) v[4 * q + k] = fmaf(xv[k], 1.0f + s1[k], s0[k]); }
            *(u32x4*)(U + (size_t)row * UP + c8) = pack8(v);
        }
    }
}

constexpr int KP = 72, CTP = 132;
constexpr int GST = 24576;
DEV void gemm_kloop(const bf16_t* __restrict__ X, int ldx, const bf16_t* __restrict__ W, int ldw, int K, int m0, int n0, char* smem, f32x16 (&acc)[2][4], int tid) {
    const int lane = tid & 63, w = __builtin_amdgcn_readfirstlane(tid >> 6), wm = w >> 1, wn = w & 1, r32 = lane & 31, h = lane >> 5;
    const bf16_t* xg[4]; const bf16_t* wg[2];
#pragma unroll
    for (int i = 0; i < 4; ++i) { const int row = 16 * (4 * w + i) + (lane >> 2), kc = (lane & 3) ^ ((row >> 2) & 3); xg[i] = X + (size_t)(m0 + row) * ldx + kc * 8; }
#pragma unroll
    for (int i = 0; i < 2; ++i) { const int row = 16 * (2 * w + i) + (lane >> 2), kc = (lane & 3) ^ ((row >> 2) & 3); wg[i] = W + (size_t)(n0 + row) * ldw + kc * 8; }
#define GEMM_STAGE(kt, stb) do { \
        _Pragma("unroll") for (int i = 0; i < 4; ++i) __builtin_amdgcn_global_load_lds((const unsigned*)(xg[i] + (kt) * 32), (LDSAS unsigned*)(smem + (stb) + (4 * w + i) * 1024), 16, 0, 0); \
        _Pragma("unroll") for (int i = 0; i < 2; ++i) __builtin_amdgcn_global_load_lds((const unsigned*)(wg[i] + (kt) * 32), (LDSAS unsigned*)(smem + (stb) + 16384 + (2 * w + i) * 1024), 16, 0, 0); } while (0)
#pragma unroll
    for (int i = 0; i < 2; ++i)
#pragma unroll
        for (int j = 0; j < 4; ++j)
#pragma unroll
            for (int r = 0; r < 16; ++r) acc[i][j][r] = 0.f;
    const int nk = K / 32;
    int offA[2], offB[4];
#pragma unroll
    for (int i = 0; i < 2; ++i) { const int ra = wm * 64 + 32 * i + r32; offA[i] = 16384 + ra * 64 + ((h ^ ((ra >> 2) & 3)) << 4); }
#pragma unroll
    for (int j = 0; j < 4; ++j) { const int rb = wn * 128 + 32 * j + r32; offB[j] = rb * 64 + ((h ^ ((rb >> 2) & 3)) << 4); }
    GEMM_STAGE(0, 0); GEMM_STAGE(1, GST);
    int cur = 0, nxt = 2 * GST;
    for (int kt = 0; kt < nk; ++kt) {
        if (kt + 1 < nk) asm volatile("s_waitcnt vmcnt(6)" ::: "memory");
        else asm volatile("s_waitcnt vmcnt(0)" ::: "memory");
        __builtin_amdgcn_s_barrier();
        asm volatile("" ::: "memory");
        if (kt + 2 < nk) GEMM_STAGE(kt + 2, nxt);
        const char* st = smem + cur;
#pragma unroll
        for (int s2 = 0; s2 < 2; ++s2) {
            bf16x8 a[2], b[4];
#pragma unroll
            for (int i = 0; i < 2; ++i) a[i] = *(const bf16x8*)(st + (offA[i] ^ (s2 << 5)));
#pragma unroll
            for (int j = 0; j < 4; ++j) b[j] = *(const bf16x8*)(st + (offB[j] ^ (s2 << 5)));
#pragma unroll
            for (int i = 0; i < 2; ++i)
#pragma unroll
                for (int j = 0; j < 4; ++j) acc[i][j] = mfma(a[i], b[j], acc[i][j]);
        }
        nxt = cur; cur = cur == 2 * GST ? 0 : cur + GST;
    }
#undef GEMM_STAGE
    __syncthreads();
}

constexpr int CSP = 136;
DEV float silu_fast(float a) { return a * __builtin_amdgcn_rcpf(1.0f + fexp2(-LOG2E * a)); }
DEV void cs_store4(bf16_t* Cs, int row, int col, float a, float b, float c, float d) { u32x2 v; v.x = cvt_pk(a, b); v.y = cvt_pk(c, d); *(u32x2*)(Cs + row * CSP + col) = v; }
DEV void cs_flush(const bf16_t* Cs, bf16_t* dst, size_t ldd, int tid) {
#pragma unroll
    for (int it = 0; it < 16; ++it) { const int row = (tid >> 4) + 16 * it, ch = tid & 15;
        *(u32x4*)(dst + (size_t)row * ldd + ch * 8) = *(const u32x4*)(Cs + row * CSP + ch * 8); }
}
DEV void phase_gemm_in(const Params& p, int L, char* smem) {
    const bf16_t* U = (const bf16_t*)(p.ws + WS_U);
    const bf16_t* W = (const bf16_t*)(p.ws + WS_WINT) + (size_t)L * 4096 * WP;
    bf16_t* H = (bf16_t*)(p.ws + WS_H);
    bf16_t* Cs = (bf16_t*)smem;
    for (int u = blockIdx.x; u < 2048; u += gridDim.x) {
        int tid_ = threadIdx.x; OPAQUE_V(tid_); const int tid = tid_;
        const int lane = tid & 63, w = __builtin_amdgcn_readfirstlane(tid >> 6), wm = w >> 1, wn = w & 1, r32 = lane & 31, h = lane >> 5;
        const int mt = u >> 5, nt = u & 31, m0 = mt * 256, c64 = 2 * nt + wm;
        f32x16 acc[2][4];
        gemm_kloop(U, UP, W, WP, 1024, m0, nt * 128, smem, acc, tid);
        const bool is_rope64 = c64 <= 4 || (c64 >= 29 && c64 <= 34) || c64 == 39 || c64 == 40 || c64 == 43 || c64 == 44;
        const bool is_nsaq = c64 >= 29 && c64 <= 34;
#pragma unroll
        for (int j = 0; j < 4; ++j) {
            const int trow = 128 * wn + 32 * j + r32, token = m0 + trow, pos = token & 2047;
            f32x16& A0 = acc[0][j]; f32x16& A1 = acc[1][j];
            if (is_rope64) {
                if (is_nsaq) {
#pragma unroll
                    for (int r = 0; r < 16; ++r) { A0[r] *= QS; A1[r] *= QS; }
                } else {
                    const float sc = c64 <= 3 ? QS : 1.0f;
                    const f32x2* ct = (const f32x2*)(p.ws + WS_CS64) + pos * 32 + 4 * h;
#pragma unroll
                    for (int a = 0; a < 4; ++a) {
                        const f32x4 c01 = *(const f32x4*)(ct + 8 * a), c23 = *(const f32x4*)(ct + 8 * a + 2);
                        const float cs_[4] = {c01[0], c01[2], c23[0], c23[2]}, sn_[4] = {c01[1], c01[3], c23[1], c23[3]};
#pragma unroll
                        for (int k = 0; k < 4; ++k) { const float x1 = A0[4 * a + k], x2 = A1[4 * a + k];
                            A0[4 * a + k] = (x1 * cs_[k] - x2 * sn_[k]) * sc; A1[4 * a + k] = (x1 * sn_[k] + x2 * cs_[k]) * sc; }
                    }
                }
            } else if ((c64 >= 6 && c64 <= 10)) {
                const f32x2* ct = (const f32x2*)(p.ws + WS_CS32) + pos * 16 + 4 * h;
#pragma unroll
                for (int a = 0; a < 2; ++a) {
                    const f32x4 c01 = *(const f32x4*)(ct + 8 * a), c23 = *(const f32x4*)(ct + 8 * a + 2);
                    const float cs_[4] = {c01[0], c01[2], c23[0], c23[2]}, sn_[4] = {c01[1], c01[3], c23[1], c23[3]};
#pragma unroll
                    for (int k = 0; k < 4; ++k) {
                        { const float x1 = A0[4 * a + k], x2 = A0[4 * (a + 2) + k]; A0[4 * a + k] = x1 * cs_[k] - x2 * sn_[k]; A0[4 * (a + 2) + k] = x1 * sn_[k] + x2 * cs_[k]; }
                        if (c64 != 10) { const float x1 = A1[4 * a + k], x2 = A1[4 * (a + 2) + k]; A1[4 * a + k] = x1 * cs_[k] - x2 * sn_[k]; A1[4 * (a + 2) + k] = x1 * sn_[k] + x2 * cs_[k]; }
                    }
                }
                if (c64 == 10) {
                    const int b = token >> 11;
                    float* iw = (float*)(p.ws + WS_IW) + (size_t)token * 8 + 4 * h;
                    *(f32x4*)iw = (f32x4){A1[0], A1[1], A1[2], A1[3]} * 0.35355339059327373f;
                    float* lf = (float*)(p.ws + WS_LOGF) + (size_t)b * 6 * 2048 + pos; float* gs = (float*)(p.ws + WS_GSIG) + (size_t)token * 20;
#pragma unroll
                    for (int a = 1; a < 4; ++a)
#pragma unroll
                        for (int k = 0; k < 4; ++k) {
                            const int f = 8 * a + k;
                            const float v = A1[4 * a + k];
                            if (a == 1) {
                                if (h == 0 || k < 2) { const int e = 4 * h + k; const float x = v + p.b_f[L * 6 + e]; lf[(size_t)e * 2048] = fminf(x, 0.f) - log1pf(expf(-fabsf(x))); }
                                else gs[k - 2] = 1.0f / (1.0f + expf(-v));
                            } else gs[f + 4 * h - 14] = 1.0f / (1.0f + expf(-v));
                        }
                }
            } else {
                const bool isq = (c64 >= 11 && c64 <= 16), silu = c64 >= 47;
#pragma unroll
                for (int r = 0; r < 16; ++r) {
                    if (silu) { A0[r] = silu_fast(A0[r]); A1[r] = silu_fast(A1[r]); }
                    else if (isq) { A0[r] *= QS; A1[r] *= QS; }
                }
            }
#pragma unroll
            for (int a = 0; a < 4; ++a) {
                cs_store4(Cs, trow, 64 * wm + 8 * a + 4 * h, A0[4 * a], A0[4 * a + 1], A0[4 * a + 2], A0[4 * a + 3]);
                cs_store4(Cs, trow, 64 * wm + 32 + 8 * a + 4 * h, A1[4 * a], A1[4 * a + 1], A1[4 * a + 2], A1[4 * a + 3]);
            }
        }
        __syncthreads();
        cs_flush(Cs, H + (size_t)m0 * HP + nt * 128, HP, tid);
        if (nt >= 14 && nt <= 17) {
            __syncthreads();
            if (is_nsaq) {
#pragma unroll
                for (int j = 0; j < 4; ++j) { const int trow = 128 * wn + 32 * j + r32, pos = (m0 + trow) & 2047;
                    const f32x16& A0 = acc[0][j]; const f32x16& A1 = acc[1][j];
                    const f32x2* ct = (const f32x2*)(p.ws + WS_CS64) + pos * 32 + 4 * h;
#pragma unroll
                    for (int a = 0; a < 4; ++a) {
                        const f32x4 c01 = *(const f32x4*)(ct + 8 * a), c23 = *(const f32x4*)(ct + 8 * a + 2);
                        const float cs_[4] = {c01[0], c01[2], c23[0], c23[2]}, sn_[4] = {c01[1], c01[3], c23[1], c23[3]};
                        float o1[4], o2[4];
#pragma unroll
                        for (int k = 0; k < 4; ++k) { const float x1 = A0[4 * a + k], x2 = A1[4 * a + k]; o1[k] = x1 * cs_[k] - x2 * sn_[k]; o2[k] = x1 * sn_[k] + x2 * cs_[k]; }
                        cs_store4(Cs, trow, 64 * wm + 8 * a + 4 * h, o1[0], o1[1], o1[2], o1[3]);
                        cs_store4(Cs, trow, 64 * wm + 32 + 8 * a + 4 * h, o2[0], o2[1], o2[2], o2[3]);
                    } }
            }
            __syncthreads();
            bf16_t* QR = (bf16_t*)(p.ws + WS_QROT);
#pragma unroll
            for (int it = 0; it < 16; ++it) { const int row = (tid >> 4) + 16 * it, ch = tid & 15; const int cc = 2 * nt + (ch >> 3);
                if (cc >= 29 && cc <= 34) *(u32x4*)(QR + (size_t)(m0 + row) * 384 + (cc - 29) * 64 + (ch & 7) * 8) = *(const u32x4*)(Cs + row * CSP + ch * 8); }
        }
        __syncthreads();
    }
}
DEV void phase_out(const Params& p, int L, char* smem) {
    const bf16_t* A = (const bf16_t*)(p.ws + WS_MIX);
    const bf16_t* W = (const bf16_t*)(p.ws + WS_WOUTT) + (size_t)L * 1024 * WP;
    bf16_t* Z = (bf16_t*)(p.ws + WS_H);
    const float* mod = (const float*)(p.ws + WS_MOD) + (size_t)L * 8 * 3072;
    bf16_t* Cs = (bf16_t*)smem;
    for (int u = blockIdx.x; u < 512; u += gridDim.x) {
        int tid_ = threadIdx.x; OPAQUE_V(tid_); const int tid = tid_;
        const int lane = tid & 63, w = __builtin_amdgcn_readfirstlane(tid >> 6), wm = w >> 1, wn = w & 1, r32 = lane & 31, h = lane >> 5;
        const int mt = u >> 3, nt = u & 7, m0 = mt * 256, n0 = nt * 128, b = m0 >> 11;
        f32x16 acc[2][4];
        gemm_kloop(A, UP, W, WP, 1024, m0, n0, smem, acc, tid);
        f32x4 g1[2][4];
#pragma unroll
        for (int i = 0; i < 2; ++i)
#pragma unroll
            for (int a = 0; a < 4; ++a) g1[i][a] = *(const f32x4*)(mod + (size_t)b * 3072 + 2048 + n0 + 64 * wm + 32 * i + 8 * a + 4 * h) + 1.0f;
#pragma unroll
        for (int j = 0; j < 4; ++j) { const int trow = 128 * wn + 32 * j + r32;
#pragma unroll
            for (int i = 0; i < 2; ++i)
#pragma unroll
                for (int a = 0; a < 4; ++a) cs_store4(Cs, trow, 64 * wm + 32 * i + 8 * a + 4 * h, acc[i][j][4 * a] * g1[i][a][0], acc[i][j][4 * a + 1] * g1[i][a][1], acc[i][j][4 * a + 2] * g1[i][a][2], acc[i][j][4 * a + 3] * g1[i][a][3]);
        }
        __syncthreads();
        cs_flush(Cs, Z + (size_t)m0 * ZP + n0, ZP, tid);
        __syncthreads();
    }
}
DEV void phase_ln(const Params& p, int L) {
    const bf16_t* Z = (const bf16_t*)(p.ws + WS_H);
    const float* xin = L == 0 ? p.x : p.out;
    const float* mod = (const float*)(p.ws + WS_MOD) + (size_t)8 * 3072;
    bf16_t* U = (bf16_t*)(p.ws + WS_U);
    for (int u = blockIdx.x; u < 1024; u += gridDim.x) {
        int tx_ = threadIdx.x; OPAQUE_V(tx_);
        const int lane = tx_ & 63, w = __builtin_amdgcn_readfirstlane(tx_ >> 6);
        for (int rr = 0; rr < 4; ++rr) {
            const int row = u * 16 + w * 4 + rr, b = row >> 11;
            f32x4 v[4]; float s = 0.f;
#pragma unroll
            for (int i = 0; i < 4; ++i) { const f32x4 xv = *(const f32x4*)(xin + (size_t)row * 1024 + 256 * i + 4 * lane);
                const u32x2 zz = *(const u32x2*)(Z + (size_t)row * ZP + 256 * i + 4 * lane);
                v[i] = (f32x4){bf_lo(zz.x), bf_hi(zz.x), bf_lo(zz.y), bf_hi(zz.y)} + ALPHA * xv; s += (v[i][0] + v[i][1]) + (v[i][2] + v[i][3]); }
#pragma unroll
            for (int o = 32; o >= 1; o >>= 1) s += __shfl_xor(s, o);
            const float mean = s * (1.0f / 1024.0f); float q = 0.f;
#pragma unroll
            for (int i = 0; i < 4; ++i)
#pragma unroll
                for (int k = 0; k < 4; ++k) { const float d = v[i][k] - mean; q = fmaf(d, d, q); }
#pragma unroll
            for (int o = 32; o >= 1; o >>= 1) q += __shfl_xor(q, o);
            const float rstd = rsqrtf(q * (1.0f / 1024.0f) + 1e-5f);
#pragma unroll
            for (int i = 0; i < 4; ++i) {
                const int col = 256 * i + 4 * lane;
                const f32x4 g = *(const f32x4*)(p.ln_g + L * 1024 + col), bb = *(const f32x4*)(p.ln_b + L * 1024 + col);
                f32x4 o;
#pragma unroll
                for (int k = 0; k < 4; ++k) o[k] = (v[i][k] - mean) * rstd * g[k] + bb[k];
                *(f32x4*)(p.out + (size_t)row * 1024 + col) = o;
                if (L == 0) {
                    const f32x4 sh = *(const f32x4*)(mod + (size_t)b * 3072 + col), sc = *(const f32x4*)(mod + (size_t)b * 3072 + 1024 + col);
                    u32x2 pk; pk.x = cvt_pk(fmaf(o[0], 1.0f + sc[0], sh[0]), fmaf(o[1], 1.0f + sc[1], sh[1])); pk.y = cvt_pk(fmaf(o[2], 1.0f + sc[2], sh[2]), fmaf(o[3], 1.0f + sc[3], sh[3]));
                    *(u32x2*)(U + (size_t)row * UP + col) = pk;
                }
            }
        }
    }
}

constexpr int KT_BYTES = 64 * KP * 2, VT_BYTES = 8192;
struct KVRegs { u32x4 k[2], v[2]; };
DEV void kv_load(KVRegs& r, const bf16_t* __restrict__ kg, const bf16_t* __restrict__ vg, size_t pitch, int tid) {
#pragma unroll
    for (int i = 0; i < 2; ++i) { const int c = tid + 256 * i, row = c >> 3, ch = c & 7;
        r.k[i] = *(const u32x4*)(kg + (size_t)row * pitch + ch * 8); r.v[i] = *(const u32x4*)(vg + (size_t)row * pitch + ch * 8); }
}
DEV void kv_store(const KVRegs& r, char* ksm, char* vsm, int tid) {
#pragma unroll
    for (int i = 0; i < 2; ++i) { const int c = tid + 256 * i, row = c >> 3, ch = c & 7;
        *(u32x4*)(ksm + (row * KP + ch * 8) * 2) = r.k[i];
        *(u32x4*)(vsm + (ch >> 2) * 4096 + row * 64 + (ch & 3) * 16) = r.v[i]; }
}
DEV void load_qf(const bf16_t* q  , int h, bf16x8* qf) {
#pragma unroll
    for (int s = 0; s < 4; ++s) qf[s] = *(const bf16x8*)(q + 16 * s + 8 * h);
}
DEV void qk_tile(const char* ksm, const bf16x8* qf, int r32, int h, f32x16& s0, f32x16& s1) {
#pragma unroll
    for (int r = 0; r < 16; ++r) { s0[r] = 0.f; s1[r] = 0.f; }
#pragma unroll
    for (int s = 0; s < 4; ++s) {
        const bf16x8 a0 = *(const bf16x8*)(ksm + (r32 * KP + 16 * s + 8 * h) * 2);
        const bf16x8 a1 = *(const bf16x8*)(ksm + ((32 + r32) * KP + 16 * s + 8 * h) * 2);
        s0 = mfma(a0, qf[s], s0); s1 = mfma(a1, qf[s], s1);
    }
}
DEV void pv_tile(const char* vsm, int kofs, const f32x16& pt, int lane, f32x16& o0, f32x16& o1) {
    const int h = lane >> 5;
    const char* vb = vsm + ((lane >> 4) & 1) * 32 + (lane & 3) * 8 + (4 * h + ((lane & 15) >> 2) + kofs) * 64;
#pragma unroll
    for (int sp = 0; sp < 2; ++sp) {
        bf16x8 pb;
        { u32x4 t; t.x = cvt_pk(pt[8 * sp], pt[8 * sp + 1]); t.y = cvt_pk(pt[8 * sp + 2], pt[8 * sp + 3]); t.z = cvt_pk(pt[8 * sp + 4], pt[8 * sp + 5]); t.w = cvt_pk(pt[8 * sp + 6], pt[8 * sp + 7]); pb = __builtin_bit_cast(bf16x8, t); }
        const bf16x8 a0 = cat4(vtr(vb + (16 * sp) * 64), vtr(vb + (16 * sp + 8) * 64));
        const bf16x8 a1 = cat4(vtr(vb + 4096 + (16 * sp) * 64), vtr(vb + 4096 + (16 * sp + 8) * 64));
        o0 = mfma(a0, pb, o0); o1 = mfma(a1, pb, o1);
    }
}
DEV void flash_update(f32x16& s0, f32x16& s1, float& m, float& l, f32x16& o0, f32x16& o1, const char* vsm, int lane) {
    float mx = NEG_INF;
#pragma unroll
    for (int r = 0; r < 16; ++r) mx = fmaxf(mx, fmaxf(s0[r], s1[r]));
    mx = fmaxf(mx, __shfl_xor(mx, 32));
    const float mn = fmaxf(m, mx), mu = (mn == NEG_INF) ? 0.f : mn;
    const float alpha = fexp2(m - mu);
    m = mn;
    float ps = 0.f;
#pragma unroll
    for (int r = 0; r < 16; ++r) { s0[r] = fexp2(s0[r] - mu); s1[r] = fexp2(s1[r] - mu); ps += s0[r] + s1[r]; }
    l = fmaf(l, alpha, ps);
#pragma unroll
    for (int r = 0; r < 16; ++r) { o0[r] *= alpha; o1[r] *= alpha; }
    pv_tile(vsm, 0, s0, lane, o0, o1);
    pv_tile(vsm, 32, s1, lane, o0, o1);
}
DEV f32x16 qk32(const char* kbase, const bf16x8* qf, int r32, int h) {
    f32x16 s;
#pragma unroll
    for (int r = 0; r < 16; ++r) s[r] = 0.f;
#pragma unroll
    for (int k = 0; k < 4; ++k) { const bf16x8 a = *(const bf16x8*)(kbase + (r32 * KP + 16 * k + 8 * h) * 2); s = mfma(a, qf[k], s); }
    return s;
}
DEV void flash_update32(f32x16& s, float& m, float& l, f32x16& o0, f32x16& o1, const char* vsm, int kofs, int hstride, int lane) {
    float mx = NEG_INF;
#pragma unroll
    for (int r = 0; r < 16; ++r) mx = fmaxf(mx, s[r]);
    mx = fmaxf(mx, __shfl_xor(mx, 32));
    const float mn = fmaxf(m, mx), mu = (mn == NEG_INF) ? 0.f : mn;
    const float alpha = fexp2(m - mu);
    m = mn;
    float ps = 0.f;
#pragma unroll
    for (int r = 0; r < 16; ++r) { s[r] = fexp2(s[r] - mu); ps += s[r]; }
    l = fmaf(l, alpha, ps);
#pragma unroll
    for (int r = 0; r < 16; ++r) { o0[r] *= alpha; o1[r] *= alpha; }
    const int h = lane >> 5;
    const char* vb = vsm + ((lane >> 4) & 1) * 32 + (lane & 3) * 8 + (4 * h + ((lane & 15) >> 2) + kofs) * 64;
#pragma unroll
    for (int sp = 0; sp < 2; ++sp) {
        u32x4 t; t.x = cvt_pk(s[8 * sp], s[8 * sp + 1]); t.y = cvt_pk(s[8 * sp + 2], s[8 * sp + 3]); t.z = cvt_pk(s[8 * sp + 4], s[8 * sp + 5]); t.w = cvt_pk(s[8 * sp + 6], s[8 * sp + 7]);
        const bf16x8 pb = __builtin_bit_cast(bf16x8, t);
        const bf16x8 a0 = cat4(vtr(vb + (16 * sp) * 64), vtr(vb + (16 * sp + 8) * 64));
        const bf16x8 a1 = cat4(vtr(vb + hstride + (16 * sp) * 64), vtr(vb + hstride + (16 * sp + 8) * 64));
        o0 = mfma(a0, pb, o0); o1 = mfma(a1, pb, o1);
    }
}
DEV void qk_tile_c(const char* ksm, const bf16x8* qf, int r32, int h, const f32x16& c0, const f32x16& c1, f32x16& s0, f32x16& s1) {
    s0 = c0; s1 = c1;
#pragma unroll
    for (int s = 0; s < 4; ++s) {
        const bf16x8 a0 = *(const bf16x8*)(ksm + (r32 * KP + 16 * s + 8 * h) * 2);
        const bf16x8 a1 = *(const bf16x8*)(ksm + ((32 + r32) * KP + 16 * s + 8 * h) * 2);
        s0 = mfma(a0, qf[s], s0); s1 = mfma(a1, qf[s], s1);
    }
}
DEV float max3f(float a, float b, float c) { return fmaxf(fmaxf(a, b), c); }
struct FlashSt { float mref, l; bool unset; f32x16 o0, o1; };
DEV void flash_init(FlashSt& st) { st.mref = 0.f; st.l = 0.f; st.unset = true;
#pragma unroll
    for (int r = 0; r < 16; ++r) { st.o0[r] = 0.f; st.o1[r] = 0.f; } }
DEV bool flash_lazy(f32x16& s0, f32x16& s1, FlashSt& st, const char* vsm, int lane) {
    float mx = max3f(s0[0], s0[1], s1[0]);
#pragma unroll
    for (int r = 1; r < 16; r += 1) mx = (r & 1) ? max3f(mx, s0[r], s1[r]) : mx;
#pragma unroll
    for (int r = 2; r < 16; r += 2) mx = max3f(mx, s0[r], s1[r]);
    mx = fmaxf(mx, __shfl_xor(mx, 32));
    const bool fin = mx > NEG_INF;
    const bool need = fin && (st.unset || mx > 8.0f);
    bool moved = false;
    if (__any(need)) {
        const bool upd = fin && (st.unset || mx > 0.f);
        const float delta = upd ? mx : 0.f;
        const float alpha = st.unset ? 1.0f : fexp2(-delta);
        st.mref += delta; st.l *= alpha;
#pragma unroll
        for (int r = 0; r < 16; ++r) { st.o0[r] *= alpha; st.o1[r] *= alpha; s0[r] -= delta; s1[r] -= delta; }
        st.unset = st.unset && !fin;
        moved = true;
    }
    float ps = 0.f;
#pragma unroll
    for (int r = 0; r < 16; ++r) { s0[r] = fexp2(s0[r]); s1[r] = fexp2(s1[r]); ps += s0[r] + s1[r]; }
    st.l += ps;
    pv_tile(vsm, 0, s0, lane, st.o0, st.o1);
    pv_tile(vsm, 32, s1, lane, st.o0, st.o1);
    return moved;
}
DEV void fill16(f32x16& t, float v) {
#pragma unroll
    for (int r = 0; r < 16; ++r) t[r] = v; }
DEV void write_mix(const Params& p, size_t token, int mixcol0, const f32x16& o0, const f32x16& o1, int h) {
    const bf16_t* G = (const bf16_t*)(p.ws + WS_H) + token * HP + C_GATE + mixcol0;
    bf16_t* M = (bf16_t*)(p.ws + WS_MIX) + token * UP + mixcol0;
#pragma unroll
    for (int dt = 0; dt < 2; ++dt)
#pragma unroll
        for (int a = 0; a < 4; ++a) {
            const int d = 32 * dt + 8 * a + 4 * h;
            const u32x2 g = *(const u32x2*)(G + d);
            const f32x16& o = dt ? o1 : o0;
            u32x2 r; r.x = cvt_pk(o[4 * a] * bf_lo(g.x), o[4 * a + 1] * bf_hi(g.x)); r.y = cvt_pk(o[4 * a + 2] * bf_lo(g.y), o[4 * a + 3] * bf_hi(g.y));
            *(u32x2*)(M + d) = r;
        }
}

DEV void fox_unit(const Params& p, int b, int hh, int qb, char* smem) {
    char* ksm = smem; char* vsm = smem + KT_BYTES; float* cum = (float*)(smem + KT_BYTES + VT_BYTES);
    float* wtot = cum + 2048;
    int tid_ = threadIdx.x; OPAQUE_V(tid_); const int tid = tid_, lane = tid & 63, w = __builtin_amdgcn_readfirstlane(tid >> 6), r32 = lane & 31, h = lane >> 5;
    const int q0 = qb * 128, nneed = q0 + 128;
    const bf16_t* H = (const bf16_t*)(p.ws + WS_H) + (size_t)b * S * HP;
    {
        const float* lf = (const float*)(p.ws + WS_LOGF) + ((size_t)b * 6 + hh) * 2048;
        float v[8]; float s = 0.f;
        if (tid * 8 < nneed) { const f32x4 a = *(const f32x4*)(lf + tid * 8), c = *(const f32x4*)(lf + tid * 8 + 4);
            v[0] = a[0]; v[1] = a[1]; v[2] = a[2]; v[3] = a[3]; v[4] = c[0]; v[5] = c[1]; v[6] = c[2]; v[7] = c[3]; }
        else {
#pragma unroll
            for (int e = 0; e < 8; ++e) v[e] = 0.f; }
#pragma unroll
        for (int e = 0; e < 8; ++e) { s += v[e]; v[e] = s; }
        float inc = s;
#pragma unroll
        for (int o = 1; o < 64; o <<= 1) { const float t = __shfl_up(inc, o); if (lane >= o) inc += t; }
        if (lane == 63) wtot[w] = inc;
        __syncthreads();
        float base = inc - s;
        for (int k = 0; k < w; ++k) base += wtot[k];
        if (tid * 8 < nneed) {
#pragma unroll
            for (int e = 0; e < 8; ++e) cum[tid * 8 + e] = (base + v[e]) * LOG2E; }
        __syncthreads();
    }
    const int tq = q0 + 32 * w + r32;
    bf16x8 qf[4]; load_qf(H + (size_t)tq * HP + C_FOXQ + 64 * hh, h, qf);
    const float cb = cum[tq];
    FlashSt st; flash_init(st);
    const int ntiles = nneed / 64, mylast = (q0 + 32 * w + 31) >> 6, wt0 = q0 + 32 * w;
    KVRegs kvr; kv_load(kvr, H + (size_t)(ntiles - 1) * 64 * HP + C_FOXK + 64 * hh, H + (size_t)(ntiles - 1) * 64 * HP + C_FOXV + 64 * hh, HP, tid);
    for (int kt = ntiles - 1; kt >= 0; --kt) {
        __syncthreads();
        kv_store(kvr, ksm, vsm, tid);
        __syncthreads();
        if (kt > 0) kv_load(kvr, H + (size_t)(kt - 1) * 64 * HP + C_FOXK + 64 * hh, H + (size_t)(kt - 1) * 64 * HP + C_FOXV + 64 * hh, HP, tid);
        if (kt <= mylast) {
            const float cbm = cb - st.mref;
            f32x16 c0, c1;
#pragma unroll
            for (int a = 0; a < 4; ++a) {
                const f32x4 k0 = *(const f32x4*)(cum + kt * 64 + 8 * a + 4 * h), k1 = *(const f32x4*)(cum + kt * 64 + 32 + 8 * a + 4 * h);
#pragma unroll
                for (int k = 0; k < 4; ++k) { c0[4 * a + k] = cbm - k0[k]; c1[4 * a + k] = cbm - k1[k]; }
            }
            if (kt * 64 + 63 > wt0) {
                int lim = tq - 64 * kt - 4 * h; OPAQUE_V(lim);
#pragma unroll
                for (int r = 0; r < 16; ++r) { c0[r] = CR(r) <= lim ? c0[r] : NEG_INF; c1[r] = (CR(r) + 32) <= lim ? c1[r] : NEG_INF; }
            }
            f32x16 s0, s1; qk_tile_c(ksm, qf, r32, h, c0, c1, s0, s1);
            flash_lazy(s0, s1, st, vsm, lane);
        }
    }
    float l = st.l; l += __shfl_xor(l, 32);
    const float inv = 1.0f / l;
    f32x16 o0, o1;
#pragma unroll
    for (int r = 0; r < 16; ++r) { o0[r] = st.o0[r] * inv; o1[r] = st.o1[r] * inv; }
    write_mix(p, (size_t)b * S + tq, 256 + 64 * hh, o0, o1, h);
    __syncthreads();
}

constexpr int BMP = 65;
#ifndef DSA_PROBE_STG
#define DSA_PROBE_STG 0
#endif
#ifndef DSA_REP_IDX
#define DSA_REP_IDX 1
#endif
DEV unsigned ford(float f) { const unsigned u = __float_as_uint(f); return u ^ ((u >> 31) ? 0xffffffffu : 0x80000000u); }
constexpr int TK_NB = 256;
DEV unsigned funord(unsigned k) { return k ^ ((k >> 31) ? 0x80000000u : 0xffffffffu); }
template <int STG>
DEV void topk_row(const float* sc, int n, unsigned* bmrow, unsigned* hist  , int lane) {
    const int nch = (n + 63) >> 6;
    if (n <= 256) {
        if (lane < 32) { const int lo = 64 * lane; unsigned long long msk = 0ull;
            if (lo < n) { const int c = n - lo; msk = c >= 64 ? ~0ull : ((1ull << c) - 1ull); }
            bmrow[2 * lane] = (unsigned)msk; bmrow[2 * lane + 1] = (unsigned)(msk >> 32); }
        return;
    }
    const float PINF = __builtin_huge_valf();
    float v[32]; float vmax = NEG_INF, vmin = PINF;
#pragma unroll
    for (int i = 0; i < 32; ++i) {
        v[i] = NEG_INF;
        if (i < nch) { v[i] = sc[64 * i + lane]; vmax = fmaxf(vmax, v[i]);
            if (i < nch - 1) vmin = fminf(vmin, v[i]); else vmin = fminf(vmin, v[i] == NEG_INF ? PINF : v[i]); }
    }
#pragma unroll
    for (int o = 32; o >= 1; o >>= 1) { vmax = fmaxf(vmax, __shfl_xor(vmax, o)); vmin = fminf(vmin, __shfl_xor(vmin, o)); }
    if (STG <= 1) { if (lane == 0) bmrow[0] = __float_as_uint(vmax + vmin); return; }
    float Tf; bool tiecut = false; int need_eq = 0;
    if (!(vmax > vmin)) { Tf = vmax; tiecut = true; }
    else {
        const float scale = (float)(TK_NB - 1) / (vmax - vmin);
        int bn[32];
#pragma unroll
        for (int q = 0; q < TK_NB / 64; ++q) hist[64 * q + lane] = 0u;
        __builtin_amdgcn_wave_barrier();
#pragma unroll
        for (int i = 0; i < 32; ++i) { bn[i] = TK_NB - 1;
            if (i < nch) { int b = (int)((vmax - v[i]) * scale); b = b > TK_NB - 1 ? TK_NB - 1 : b; bn[i] = b; atomicAdd(&hist[b], 1u); } }
        __builtin_amdgcn_wave_barrier();
        if (STG <= 2) { if (lane == 0) bmrow[0] = hist[3] + bn[7]; return; }
        unsigned hb[4]; unsigned sl = 0u;
#pragma unroll
        for (int q = 0; q < 4; ++q) { hb[q] = hist[4 * lane + q]; sl += hb[q]; }
        unsigned pre = sl;
#pragma unroll
        for (int o = 1; o < 64; o <<= 1) { const unsigned t = __shfl_up(pre, o); if (lane >= o) pre += t; }
        const unsigned long long ge = __ballot(pre >= 256u);
        const int Ls = __ffsll((long long)ge) - 1;
        int bstar = 4 * lane; unsigned abv = pre - sl;
        { unsigned cum = pre - sl; bool found = false;
#pragma unroll
          for (int q = 0; q < 4; ++q) { if (!found && cum + hb[q] >= 256u) { bstar = 4 * lane + q; abv = cum; found = true; } cum += hb[q]; } }
        bstar = __shfl(bstar, Ls); abv = __shfl(abv, Ls);
        const int need = 256 - (int)abv;
        const unsigned cntb = hist[bstar];
        __builtin_amdgcn_wave_barrier();
        if (STG <= 3) { if (lane == 0) bmrow[0] = cntb + need; return; }
        unsigned T;
        if (cntb > (unsigned)TK_NB) {
            T = 0u;
            for (int bit = 31; bit >= 0; --bit) {
                const unsigned cand = T | (1u << bit); int cnt = 0;
#pragma unroll
                for (int i = 0; i < 32; ++i) if (i < nch) cnt += __popcll(__ballot(ford(v[i]) >= cand));
                if (cnt >= 256) T = cand;
            }
            tiecut = true;
        } else {
            int base = 0;
            const unsigned long long lt = (1ull << lane) - 1ull;
#pragma unroll
            for (int i = 0; i < 32; ++i) if (i < nch) {
                const bool isb = bn[i] == bstar;
                const unsigned long long bal = __ballot(isb);
                if (bal) { if (isb) hist[base + __popcll(bal & lt)] = ford(v[i]); base += __popcll(bal); }
            }
            __builtin_amdgcn_wave_barrier();
            unsigned c[TK_NB / 64];
#pragma unroll
            for (int q = 0; q < TK_NB / 64; ++q) c[q] = (64 * q + lane < (int)cntb) ? hist[64 * q + lane] : 0u;
            const int ncq = ((int)cntb + 63) >> 6;
            T = 0u;
            for (int bit = 31; bit >= 0; --bit) {
                const unsigned cand = T | (1u << bit); int cnt = 0;
#pragma unroll
                for (int q = 0; q < TK_NB / 64; ++q) if (q < ncq) cnt += __popcll(__ballot(c[q] >= cand));
                if (cnt >= need) T = cand;
            }
            int cgt = 0, ceq = 0;
#pragma unroll
            for (int q = 0; q < TK_NB / 64; ++q) if (q < ncq) { cgt += __popcll(__ballot(c[q] > T)); ceq += __popcll(__ballot(c[q] == T)); }
            need_eq = need - cgt;
            tiecut = ceq != need_eq;
            __builtin_amdgcn_wave_barrier();
        }
        Tf = __uint_as_float(funord(T));
    }
    if (STG <= 4) { if (lane == 0) bmrow[0] = __float_as_uint(Tf) + (tiecut ? 1 : 0); return; }
    if (!tiecut) {
#pragma unroll
        for (int i = 0; i < 32; ++i) { unsigned long long sm = 0ull; if (i < nch) sm = __ballot(v[i] >= Tf);
            bmrow[2 * i] = (unsigned)sm; bmrow[2 * i + 1] = (unsigned)(sm >> 32); }
    } else {
        int ngt = 0;
#pragma unroll
        for (int i = 0; i < 32; ++i) if (i < nch) ngt += __popcll(__ballot(v[i] > Tf));
        const int need = 256 - ngt; int running = 0;
        const unsigned long long lt = (1ull << lane) - 1ull;
#pragma unroll
        for (int i = 0; i < 32; ++i) {
            unsigned long long sm = 0ull;
            if (i < nch) {
                const bool eq = v[i] == Tf; const unsigned long long bal = __ballot(eq);
                const int pre = running + __popcll(bal & lt);
                const bool sel = (v[i] > Tf) || (eq && pre < need);
                running += __popcll(bal);
                sm = __ballot(sel);
            }
            bmrow[2 * i] = (unsigned)sm; bmrow[2 * i + 1] = (unsigned)(sm >> 32);
        }
    }
}
DEV void dsa_index_unit(const Params& p, int b, int sb8, char* smem) {
    float* sc = (float*)smem;
    unsigned* hist = (unsigned*)(smem + 65536) + __builtin_amdgcn_readfirstlane(threadIdx.x >> 6) * TK_NB;
    int tid_ = threadIdx.x; OPAQUE_V(tid_); const int tid = tid_, lane = tid & 63, w = __builtin_amdgcn_readfirstlane(tid >> 6), r32 = lane & 31, h = lane >> 5;
    const bf16_t* H = (const bf16_t*)(p.ws + WS_H) + (size_t)b * S * HP;
    const float* IW = (const float*)(p.ws + WS_IW) + (size_t)b * S * 8;
    unsigned* BM = (unsigned*)(p.ws + WS_BM) + (size_t)b * S * 64;
    {
        const int ts = 8 * sb8, nkeys = ts + 8, nkt = ((nkeys + 63) >> 6) << 1;
        const int tl = 2 * ((r32 >> 2) & 1) + (r32 >> 4), head = ((r32 >> 3) & 1) * 4 + (r32 & 3);
        bf16x8 af[2][2]; f32x4 wv[2][4];
#pragma unroll
        for (int mt = 0; mt < 2; ++mt) {
#pragma unroll
            for (int ks = 0; ks < 2; ++ks) af[mt][ks] = *(const bf16x8*)(H + (size_t)(ts + 4 * mt + tl) * HP + C_IDXQ + 32 * head + 16 * ks + 8 * h);
#pragma unroll
            for (int a = 0; a < 4; ++a) wv[mt][a] = *(const f32x4*)(IW + (size_t)(ts + 4 * mt + 2 * h + (a >> 1)) * 8 + (a & 1) * 4);
        }
        bf16x8 bfn[2];
        if (w < nkt) {
#pragma unroll
            for (int ks = 0; ks < 2; ++ks) bfn[ks] = *(const bf16x8*)(H + (size_t)(32 * w + r32) * HP + C_IDXK + 16 * ks + 8 * h); }
        for (int kt = w; kt < nkt; kt += 4) {
            const int key = 32 * kt + r32;
            bf16x8 bf[2]; bf[0] = bfn[0]; bf[1] = bfn[1];
            if (kt + 4 < nkt) {
#pragma unroll
                for (int ks = 0; ks < 2; ++ks) bfn[ks] = *(const bf16x8*)(H + (size_t)(key + 128) * HP + C_IDXK + 16 * ks + 8 * h); }
#pragma unroll
            for (int mt = 0; mt < 2; ++mt) {
                f32x16 acc;
#pragma unroll
                for (int r = 0; r < 16; ++r) acc[r] = 0.f;
                acc = mfma(af[mt][0], bf[0], acc); acc = mfma(af[mt][1], bf[1], acc);
                float sA = 0.f, sB = 0.f;
#pragma unroll
                for (int a = 0; a < 2; ++a)
#pragma unroll
                    for (int k = 0; k < 4; ++k) { sA = fmaf(wv[mt][a][k], fmaxf(acc[4 * a + k], 0.f), sA); sB = fmaf(wv[mt][a + 2][k], fmaxf(acc[4 * (a + 2) + k], 0.f), sB); }
                const int rowA = 4 * mt + 2 * h, tokA = ts + rowA;
                sc[rowA * 2048 + key] = key <= tokA ? sA + 0.0f : NEG_INF;
                sc[(rowA + 1) * 2048 + key] = key <= tokA + 1 ? sB + 0.0f : NEG_INF;
            }
        }
        __syncthreads();
#pragma unroll 1
        for (int rr = 0; rr < 2; ++rr) { const int row = 2 * w + rr; topk_row<9>(sc + row * 2048, ts + row + 1, BM + (size_t)(ts + row) * 64, hist, lane); }
        __syncthreads();
    }
}
DEV void dsa_attn_unit(const Params& p, int b, int qb, char* smem) {
    char* ksm = smem; char* vsm = smem + KT_BYTES;
    unsigned* bm = (unsigned*)(smem + KT_BYTES + VT_BYTES);
    int tid_ = threadIdx.x; OPAQUE_V(tid_); const int tid = tid_, lane = tid & 63, w = __builtin_amdgcn_readfirstlane(tid >> 6), r32 = lane & 31, h = lane >> 5;
    const int t0 = qb * 32;
    const bf16_t* H = (const bf16_t*)(p.ws + WS_H) + (size_t)b * S * HP;
    {
        const unsigned* BM = (const unsigned*)(p.ws + WS_BM) + ((size_t)b * S + t0) * 64;
#pragma unroll
        for (int i = 0; i < 8; ++i) { const int e = tid + 256 * i; bm[(e >> 6) * BMP + (e & 63)] = BM[e]; }
    }
    const int tq = t0 + r32;
    bf16x8 qf[4]; load_qf(H + (size_t)tq * HP + C_DSAQ + 64 * w, h, qf);
    FlashSt st; flash_init(st);
    f32x16 negm; fill16(negm, 0.f);
    const int ntiles = ((t0 + 31) >> 6) + 1;
    KVRegs kvr; kv_load(kvr, H + C_DSAK, H + C_DSAV, HP, tid);
    for (int kt = 0; kt < ntiles; ++kt) {
        __syncthreads();
        kv_store(kvr, ksm, vsm, tid);
        __syncthreads();
        if (kt + 1 < ntiles) kv_load(kvr, H + (size_t)(kt + 1) * 64 * HP + C_DSAK, H + (size_t)(kt + 1) * 64 * HP + C_DSAV, HP, tid);
        f32x16 s0, s1; qk_tile_c(ksm, qf, r32, h, negm, negm, s0, s1);
        const unsigned w0 = bm[r32 * BMP + 2 * kt] >> (4 * h), w1 = bm[r32 * BMP + 2 * kt + 1] >> (4 * h);
#pragma unroll
        for (int r = 0; r < 16; ++r) { const int bit = (r & 3) + 8 * (r >> 2);
            s0[r] = ((w0 >> bit) & 1u) ? s0[r] : NEG_INF; s1[r] = ((w1 >> bit) & 1u) ? s1[r] : NEG_INF; }
        if (flash_lazy(s0, s1, st, vsm, lane)) fill16(negm, -st.mref);
    }
    float l = st.l; l += __shfl_xor(l, 32);
    const float inv = l > 0.f ? 1.0f / l : 0.f;
    f32x16 o0, o1;
#pragma unroll
    for (int r = 0; r < 16; ++r) { o0[r] = st.o0[r] * inv; o1[r] = st.o1[r] * inv; }
    write_mix(p, (size_t)b * S + tq, 64 * w, o0, o1, h);
    __syncthreads();
}

DEV void cmp_unit(const Params& p, int L, int kv, int b, int g, int cc, char* smem) {
    float* red = (float*)smem;
    float* hid = (float*)(smem + 32768);
    int tid_ = threadIdx.x; OPAQUE_V(tid_); const int tid = tid_, lane = tid & 63, w = __builtin_amdgcn_readfirstlane(tid >> 6), r32 = lane & 31, h = lane >> 5;
    const bf16_t* H = (const bf16_t*)(p.ws + WS_H) + (size_t)b * S * HP + (kv ? C_VC : C_KC) + 64 * g;
    const bf16_t* W1 = (const bf16_t*)(p.ws + WS_W1T) + (size_t)(L * 2 + kv) * 64 * W1P;
    const float* pe = p.cmp_pe + (size_t)(L * 2 + kv) * 32 * 64;
    int c = cc * 32 + r32; if (c > 126) c = 126;
    f32x16 acc[2];
#pragma unroll
    for (int r = 0; r < 16; ++r) { acc[0][r] = 0.f; acc[1][r] = 0.f; }
#pragma unroll 4
    for (int ks = w * 32; ks < w * 32 + 32; ++ks) {
        const int li = ks >> 2, d0 = (ks & 3) * 16 + 8 * h;
        const u32x4 raw = *(const u32x4*)(H + (size_t)(16 * c + li) * HP + d0);
        const f32x4 p0 = *(const f32x4*)(pe + li * 64 + d0), p1 = *(const f32x4*)(pe + li * 64 + d0 + 4);
        u32x4 t; t.x = cvt_pk(bf_lo(raw.x) + p0[0], bf_hi(raw.x) + p0[1]); t.y = cvt_pk(bf_lo(raw.y) + p0[2], bf_hi(raw.y) + p0[3]);
        t.z = cvt_pk(bf_lo(raw.z) + p1[0], bf_hi(raw.z) + p1[1]); t.w = cvt_pk(bf_lo(raw.w) + p1[2], bf_hi(raw.w) + p1[3]);
        const bf16x8 a = __builtin_bit_cast(bf16x8, t);
#pragma unroll
        for (int nt = 0; nt < 2; ++nt) { const bf16x8 bw = *(const bf16x8*)(W1 + (size_t)(32 * nt + r32) * W1P + 16 * ks + 8 * h); acc[nt] = mfma(a, bw, acc[nt]); }
    }
#pragma unroll
    for (int nt = 0; nt < 2; ++nt)
#pragma unroll
        for (int r = 0; r < 16; ++r) red[(w * 32 + crow(r, h)) * 64 + 32 * nt + r32] = acc[nt][r];
    __syncthreads();
#pragma unroll
    for (int i = 0; i < 8; ++i) { const int e = tid + 256 * i; const float v = red[e] + red[2048 + e] + red[4096 + e] + red[6144 + e]; hid[e] = v / (1.0f + __expf(-v)); }
    __syncthreads();
    {
        const int cl = tid >> 3, n2 = (tid & 7) * 8; const float* w2 = p.cmp_w2 + (size_t)(L * 2 + kv) * 64 * 64;
        float o[8];
#pragma unroll
        for (int e = 0; e < 8; ++e) o[e] = 0.f;
        for (int n = 0; n < 64; ++n) { const float hv = hid[cl * 64 + n]; const f32x4 wa = *(const f32x4*)(w2 + n * 64 + n2), wb = *(const f32x4*)(w2 + n * 64 + n2 + 4);
#pragma unroll
            for (int e = 0; e < 4; ++e) { o[e] = fmaf(hv, wa[e], o[e]); o[4 + e] = fmaf(hv, wb[e], o[4 + e]); } }
        const int cg_ = cc * 32 + cl;
        if (cg_ >= 127) {
#pragma unroll
            for (int e = 0; e < 8; ++e) o[e] = 0.f; }
        bf16_t* dst = (bf16_t*)(p.ws + (kv ? WS_VC : WS_KC)) + ((size_t)(b * 2 + g) * 128 + cg_) * 64 + n2;
        *(u32x4*)dst = pack8(o);
    }
    __syncthreads();
}

constexpr int KC_BYTES = 128 * KP * 2;
DEV void nsa_unit(const Params& p, int b, int g, int qb, int j, char* smem) {
    char* kcs = smem;
    char* vcs = smem + KC_BYTES;
    char* ksm = smem + KC_BYTES + 16384;
    char* vsm = ksm + KT_BYTES;
    float* scr = (float*)(vsm + VT_BYTES);
    unsigned* uni = (unsigned*)(scr + 4 * 32 * 33);
    int tid_ = threadIdx.x; OPAQUE_V(tid_); const int tid = tid_, lane = tid & 63, w = __builtin_amdgcn_readfirstlane(tid >> 6), r32 = lane & 31, h = lane >> 5;
    const int q0 = qb * 128, tq = q0 + 32 * w + r32;
    const bf16_t* H = (const bf16_t*)(p.ws + WS_H) + (size_t)b * S * HP;
    {
        const bf16_t* kc = (const bf16_t*)(p.ws + WS_KC) + (size_t)(b * 2 + g) * 128 * 64;
        const bf16_t* vc = (const bf16_t*)(p.ws + WS_VC) + (size_t)(b * 2 + g) * 128 * 64;
#pragma unroll
        for (int i = 0; i < 4; ++i) { const int c = tid + 256 * i, row = c >> 3, ch = c & 7;
            *(u32x4*)(kcs + (row * KP + ch * 8) * 2) = *(const u32x4*)(kc + row * 64 + ch * 8);
            *(u32x4*)(vcs + (ch >> 2) * 8192 + row * 64 + (ch & 3) * 16) = *(const u32x4*)(vc + row * 64 + ch * 8); }
    }
    __syncthreads();
    const int clim_ = tq >= 31 ? ((tq - 31) >> 4) : -1;
    const int climh = (clim_ > 126 ? 126 : clim_) - 4 * h;
    float B4[16], E[16];
#pragma unroll
    for (int i = 0; i < 16; ++i) { B4[i] = 0.f; E[i] = 0.f; }
#pragma unroll 1
    for (int jj = 0; jj < 3; ++jj) {
        bf16x8 qf[4]; load_qf(H + (size_t)tq * HP + C_NSAQ + 64 * (3 * g + jj), h, qf);
        float mrun = NEG_INF, lrun = 0.f;
#pragma unroll
        for (int n = 0; n < 4; ++n) {
            f32x16 st = qk32(kcs + n * 32 * KP * 2, qf, r32, h);
            float mx = NEG_INF;
            int lim = climh; OPAQUE_V(lim);
#pragma unroll
            for (int r = 0; r < 16; ++r) { st[r] = (32 * n + CR(r)) <= lim ? st[r] : NEG_INF; mx = fmaxf(mx, st[r]); }
            const float mn = fmaxf(mrun, mx), mu = mn == NEG_INF ? 0.f : mn;
            float ps = 0.f;
#pragma unroll
            for (int r = 0; r < 16; ++r) ps += fexp2(st[r] - mu);
            lrun = fmaf(lrun, fexp2(mrun - mu), ps); mrun = mn;
            __builtin_amdgcn_sched_barrier(0);
        }
        const float mo = __shfl_xor(mrun, 32), lo = __shfl_xor(lrun, 32);
        const float M = fmaxf(mrun, mo), Mu = M == NEG_INF ? 0.f : M;
        const float Lt = lrun * fexp2(mrun - Mu) + lo * fexp2(mo - Mu);
        const float inv = 1.0f / fmaxf(Lt, 1e-30f);
#pragma unroll
        for (int n = 0; n < 4; ++n) {
            f32x16 st = qk32(kcs + n * 32 * KP * 2, qf, r32, h);
            int lim = climh; OPAQUE_V(lim);
#pragma unroll
            for (int a = 0; a < 4; ++a) {
                float pr[4];
#pragma unroll
                for (int k = 0; k < 4; ++k) pr[k] = (32 * n + 8 * a + k) <= lim ? fexp2(st[4 * a + k] - Mu) * inv : 0.f;
                B4[4 * n + a] += (pr[0] + pr[1]) + (pr[2] + pr[3]); E[4 * n + a] += pr[3];
            }
            __builtin_amdgcn_sched_barrier(0);
        }
    }
    {
        float* my = scr + (w * 32 + r32) * 33;
#pragma unroll
        for (int i = 0; i < 16; ++i) { const float eo = __shfl_xor(E[i], 32); E[i] = eo; }
#pragma unroll
        for (int i = 0; i < 16; ++i) { const float prev = h ? E[i] : (i > 0 ? E[i - 1] : 0.f); my[2 * i + h] = B4[i] + prev; }
    }
    __builtin_amdgcn_wave_barrier();
    unsigned sel;
    {
        const float* my = scr + (w * 32 + r32) * 33; const int cur = tq >> 6;
        float v[32];
#pragma unroll
        for (int n = 0; n < 32; ++n) { float s_ = my[n]; const bool forced = (n == 0) || (n == cur) || (n == cur - 1); const bool fut = 64 * n > tq;
            v[n] = forced ? __builtin_huge_valf() : (fut ? NEG_INF : s_); }
        unsigned mk = 0u;
#pragma unroll
        for (int i = 0; i < 32; ++i) {
            int rank = 0;
#pragma unroll
            for (int n = 0; n < 32; ++n) { if (n < i) rank += (v[n] >= v[i]) ? 1 : 0; else if (n > i) rank += (v[n] > v[i]) ? 1 : 0; }
            if (rank < 16 && 64 * i <= tq) mk |= 1u << i;
        }
        sel = mk;
    }
    unsigned wsel = sel;
#pragma unroll
    for (int o = 16; o >= 1; o >>= 1) wsel |= __shfl_xor(wsel, o);
    if (lane == 0) uni[w] = wsel;
    __syncthreads();
    const unsigned bsel = uni[0] | uni[1] | uni[2] | uni[3];
    const float* gs = (const float*)(p.ws + WS_GSIG) + ((size_t)b * S + tq) * 20;
    const float g0 = gs[0 * 6 + g * 3 + j], g1 = gs[1 * 6 + g * 3 + j], g2 = gs[2 * 6 + g * 3 + j];
    f32x16 ot0, ot1;
    {
        bf16x8 qf[4]; load_qf(H + (size_t)tq * HP + C_NSAQ + 64 * (3 * g + j), h, qf);
        float m = NEG_INF, l = 0.f; f32x16 o0, o1;
#pragma unroll
        for (int r = 0; r < 16; ++r) { o0[r] = 0.f; o1[r] = 0.f; }
#pragma unroll 1
        for (int n = 0; n < 4; ++n) {
            f32x16 st = qk32(kcs + n * 32 * KP * 2, qf, r32, h);
            int lim = climh - 32 * n; OPAQUE_V(lim);
#pragma unroll
            for (int r = 0; r < 16; ++r) st[r] = CR(r) <= lim ? st[r] : NEG_INF;
            flash_update32(st, m, l, o0, o1, vcs, 32 * n, 8192, lane);
        }
        l += __shfl_xor(l, 32);
        const float sc_ = l > 0.f ? g0 / l : 0.f;
#pragma unroll
        for (int r = 0; r < 16; ++r) { ot0[r] = o0[r] * sc_; ot1[r] = o1[r] * sc_; }
    }
    bf16x8 qr[4]; load_qf((const bf16_t*)(p.ws + WS_QROT) + ((size_t)b * S + tq) * 384 + 64 * (3 * g + j), h, qr);
    {
        FlashSt st; flash_init(st);
        f32x16 negm; fill16(negm, 0.f);
        unsigned rem = bsel;
        KVRegs kvr; kv_load(kvr, H + C_KS + 64 * g, H + C_VS + 64 * g, HP, tid);
        const int wt0 = q0 + 32 * w;
        while (rem) {
            const int nb = __ffs(rem) - 1; rem &= rem - 1u;
            __syncthreads();
            kv_store(kvr, ksm, vsm, tid);
            __syncthreads();
            if (rem) { const int nx = __ffs(rem) - 1; kv_load(kvr, H + (size_t)nx * 64 * HP + C_KS + 64 * g, H + (size_t)nx * 64 * HP + C_VS + 64 * g, HP, tid); }
            if ((wsel >> nb) & 1u) {
                f32x16 s0, s1; qk_tile_c(ksm, qr, r32, h, negm, negm, s0, s1);
                int lim = ((sel >> nb) & 1u) ? tq - 64 * nb - 4 * h : -1; OPAQUE_V(lim);
#pragma unroll
                for (int r = 0; r < 16; ++r) { s0[r] = CR(r) <= lim ? s0[r] : NEG_INF; s1[r] = (CR(r) + 32) <= lim ? s1[r] : NEG_INF; }
                if (flash_lazy(s0, s1, st, vsm, lane)) fill16(negm, -st.mref);
            }
        }
        float l = st.l; l += __shfl_xor(l, 32);
        const float sc_ = l > 0.f ? g1 / l : 0.f;
#pragma unroll
        for (int r = 0; r < 16; ++r) { ot0[r] = fmaf(st.o0[r], sc_, ot0[r]); ot1[r] = fmaf(st.o1[r], sc_, ot1[r]); }
    }
    {
        FlashSt st; flash_init(st);
        f32x16 negm; fill16(negm, 0.f);
        const int kfirst = q0 >= 512 ? (q0 - 512) >> 6 : 0, klast = (q0 + 127) >> 6;
        const int wt0 = q0 + 32 * w;
        const int wfirst = wt0 >= 511 ? (wt0 - 511) >> 6 : 0, wlast = (wt0 + 31) >> 6;
        KVRegs kvr; kv_load(kvr, H + (size_t)kfirst * 64 * HP + C_KW + 64 * g, H + (size_t)kfirst * 64 * HP + C_VW + 64 * g, HP, tid);
        for (int kt = kfirst; kt <= klast; ++kt) {
            __syncthreads();
            kv_store(kvr, ksm, vsm, tid);
            __syncthreads();
            if (kt < klast) kv_load(kvr, H + (size_t)(kt + 1) * 64 * HP + C_KW + 64 * g, H + (size_t)(kt + 1) * 64 * HP + C_VW + 64 * g, HP, tid);
            if (kt >= wfirst && kt <= wlast) {
                f32x16 s0, s1; qk_tile_c(ksm, qr, r32, h, negm, negm, s0, s1);
                if (!(64 * kt + 63 <= wt0 && 64 * kt > wt0 + 31 - 512)) {
                    int lim = tq - 64 * kt - 4 * h; OPAQUE_V(lim);
#pragma unroll
                    for (int r = 0; r < 16; ++r) { s0[r] = (unsigned)(lim - CR(r)) < 512u ? s0[r] : NEG_INF; s1[r] = (unsigned)(lim - CR(r) - 32) < 512u ? s1[r] : NEG_INF; }
                }
                if (flash_lazy(s0, s1, st, vsm, lane)) fill16(negm, -st.mref);
            }
        }
        float l = st.l; l += __shfl_xor(l, 32);
        const float sc_ = l > 0.f ? g2 / l : 0.f;
#pragma unroll
        for (int r = 0; r < 16; ++r) { ot0[r] = fmaf(st.o0[r], sc_, ot0[r]); ot1[r] = fmaf(st.o1[r], sc_, ot1[r]); }
    }
    write_mix(p, (size_t)b * S + tq, 640 + 64 * (3 * g + j), ot0, ot1, h);
    __syncthreads();
}


#define XB_TMO      128
#define XB_XCNT(j)  (256  + 64 * (j))
#define XB_XSUB(j)  (1280 + 64 * (j))
#define XB_XGEN(j)  (2304 + 64 * (j))
#define XB_TOP      3328
#define XB_TOPGEN   3392
#define XCD_BAR_WORDS 3456
#define XB_SPIN_CAP (1u << 22)
DEV unsigned xb_ld(unsigned* p) { return __hip_atomic_load(p, __ATOMIC_RELAXED, __HIP_MEMORY_SCOPE_AGENT); }
DEV unsigned xb_add(unsigned* p, unsigned v) { return __hip_atomic_fetch_add(p, v, __ATOMIC_RELAXED, __HIP_MEMORY_SCOPE_AGENT); }
DEV unsigned xb_xcc_id() { return (unsigned)__builtin_amdgcn_s_getreg((3 << 11) | 20) & 0xFu; }
#define XB_SPIN(cond, bar) do { unsigned _sp = 0; while (cond) { __builtin_amdgcn_s_sleep(1); \
    if ((++_sp & 255u) == 0u) { if (xb_ld(&(bar)[XB_TMO])) break; if (_sp > XB_SPIN_CAP) { atomicAdd(&(bar)[XB_TMO], 1u); break; } } } } while (0)
struct XcdBarrier { unsigned* bar; unsigned x; volatile LDSAS unsigned* st; };
DEV XcdBarrier xcd_barrier_post(unsigned* bar, volatile LDSAS unsigned* st) {
    XcdBarrier b; b.bar = bar; b.x = xb_xcc_id(); b.st = st;
    if (threadIdx.x == 0) (void)xb_add(&bar[XB_XCNT(b.x)], 1u);
    return b;
}
DEV void xcd_barrier_complete(unsigned* bar, unsigned x, unsigned& nloc, unsigned& nx) {
    const unsigned G = gridDim.x * gridDim.y * gridDim.z;
    unsigned sum, cnt, mine, sp = 0u;
    for (;;) {
        sum = 0u; cnt = 0u; mine = 0u;
#pragma unroll
        for (unsigned j = 0; j < 16; ++j) { const unsigned c = xb_ld(&bar[XB_XCNT(j)]); sum += c; cnt += (c > 0u) ? 1u : 0u; mine = (j == x) ? c : mine; }
        if (sum == G) break;
        __builtin_amdgcn_s_sleep(1);
        if ((++sp & 255u) == 0u) { if (xb_ld(&bar[XB_TMO])) break; if (sp > XB_SPIN_CAP) { atomicAdd(&bar[XB_TMO], 1u); break; } }
    }
    nloc = mine > 0u ? mine : 1u; nx = cnt > 0u ? cnt : 1u;
}
DEV void xcd_barrier(const XcdBarrier& b) {
    asm volatile("s_waitcnt vmcnt(0)" ::: "memory");
    __syncthreads();
    if (threadIdx.x == 0) {
        unsigned* bar = b.bar;
        __builtin_amdgcn_s_waitcnt(0);
        unsigned nloc = b.st[0], nx = b.st[1];
        if (nloc == 0u) { xcd_barrier_complete(bar, b.x, nloc, nx); b.st[0] = nloc; b.st[1] = nx; }
        const unsigned old = xb_add(&bar[XB_XSUB(b.x)], 1u);
        const unsigned gen = old / nloc;
        if (old + 1u == (gen + 1u) * nloc) {
            __builtin_amdgcn_fence(__ATOMIC_RELEASE, "agent");
            asm volatile("s_waitcnt vmcnt(0)" ::: "memory");
            const unsigned og = xb_add(&bar[XB_TOP], 1u);
            const unsigned tg = og / nx;
            if (og + 1u == (tg + 1u) * nx) xb_add(&bar[XB_TOPGEN], 1u);
            else XB_SPIN(xb_ld(&bar[XB_TOPGEN]) == tg, bar);
            __builtin_amdgcn_fence(__ATOMIC_ACQUIRE, "agent");
            xb_add(&bar[XB_XGEN(b.x)], 1u);
            asm volatile("s_waitcnt vmcnt(0)" ::: "memory");
        } else {
            XB_SPIN(xb_ld(&bar[XB_XGEN(b.x)]) == gen, bar);
            __builtin_amdgcn_fence(__ATOMIC_ACQUIRE, "agent");
            asm volatile("s_waitcnt vmcnt(0)" ::: "memory");
        }
    }
    __syncthreads();
}
DEV int grab_unit(unsigned* ctr, char* smem) {
    volatile LDSAS unsigned* st = (volatile LDSAS unsigned*)(smem + SMEM_BYTES - 16);
    __syncthreads();
    if (threadIdx.x == 0) st[2] = __hip_atomic_fetch_add(ctr, 1u, __ATOMIC_RELAXED, __HIP_MEMORY_SCOPE_AGENT);
    __syncthreads();
    return (int)st[2];
}
DEV void phase_mid(const Params& p, int L, char* smem, unsigned* ctr, int tmask = 7) {
    constexpr int N_CMP = 128, N_FOX = 768, N_IDX = 2048;
    for (;;) {
        const int u = grab_unit(ctr, smem);
        if (u >= N_CMP + N_FOX + N_IDX) break;
        int v = u;
        if (v < N_CMP) { const int kv = v & 1, g = (v >> 1) & 1, cc = (v >> 2) & 3, b = v >> 4; if (tmask & 4) cmp_unit(p, L, kv, b, g, cc, smem); continue; }
        v -= N_CMP;
        if (v < N_FOX) { const int qb = 15 - v / 48, r = v % 48; if (tmask & 2) fox_unit(p, r / 6, r % 6, qb, smem); continue; }
        v -= N_FOX;
        { const int sb8 = 255 - (v >> 3), b = v & 7; if (tmask & 1) dsa_index_unit(p, b, sb8, smem); }
    }
}
DEV void phase_nsa(const Params& p, char* smem, unsigned* ctr) {
    for (;;) {
        const int u = grab_unit(ctr, smem);
        if (u >= 768 + 512) break;
        const int sI = 15 - u / 80, r = u % 80;
        if (r < 48) { const int b = r / 6, g = (r % 6) / 3, j = r % 3; nsa_unit(p, b, g, sI, j, smem); }
        else { const int r2 = r - 48, qb = 4 * sI + 3 - (r2 >> 3), b = r2 & 7; dsa_attn_unit(p, b, qb, smem); }
    }
}
#ifndef PHASE_MASK
#define PHASE_MASK 0xffff
#endif
DEV void run_phase(const Params& p, int ph, char* smem, int rep = 0) {
    unsigned* ctr = (unsigned*)(p.ws + WS_CTRL) + 3584 + 16 * (ph + 12 * rep);
    if (ph == 0) { if (PHASE_MASK & 1) phase_prep(p, smem); return; }
    if (ph == 1) { if (PHASE_MASK & 2) phase_u1(p); return; }
    const int L = (ph - 2) / 5, k = (ph - 2) % 5;
    if (k == 0) { if (PHASE_MASK & 4) phase_gemm_in(p, L, smem); }
    else if (k == 1) { if (PHASE_MASK & 8) phase_mid(p, L, smem, ctr); }
    else if (k == 2) { if (PHASE_MASK & 16) phase_nsa(p, smem, ctr); }
    else if (k == 3) { if (PHASE_MASK & 32) phase_out(p, L, smem); }
    else { if (PHASE_MASK & 64) phase_ln(p, L); }
}
constexpr int N_PHASES = 12;

#ifndef REPEAT_KIND
#define REPEAT_KIND -1
#endif
DEV int phase_kind(int ph) { return ph < 2 ? ph : 2 + (ph - 2) % 5; }
template <bool COOP>
__global__ void __launch_bounds__(256, 2) mega(Params p, int ph_lo, int ph_hi) {
    extern __shared__ __attribute__((aligned(16))) char smem[];
    volatile LDSAS unsigned* st = (volatile LDSAS unsigned*)(smem + SMEM_BYTES - 16);
    XcdBarrier xb;
    if (COOP) {
        if (threadIdx.x == 0) { st[0] = 0u; st[1] = 0u; }
        __syncthreads();
        xb = xcd_barrier_post((unsigned*)(p.ws + WS_CTRL), st);
    }
    for (int ph = ph_lo; ph < ph_hi; ++ph) {
        run_phase(p, ph, smem);
        if (COOP) {
            if (REPEAT_KIND >= 0 && REPEAT_KIND < 7 && phase_kind(ph) == REPEAT_KIND) { xcd_barrier(xb); run_phase(p, ph, smem, 1); }
            if (REPEAT_KIND >= 7 && REPEAT_KIND <= 9 && phase_kind(ph) == 3) { xcd_barrier(xb); phase_mid(p, (ph - 2) / 5, smem, (unsigned*)(p.ws + WS_CTRL) + 3584 + 16 * (ph + 12), 1 << (REPEAT_KIND - 7)); }
            if (ph + 1 < ph_hi) xcd_barrier(xb);
        }
    }
}

#ifndef N_LAUNCH_MODE
#define N_LAUNCH_MODE 1
#endif

extern "C" void kernel_launch(void* const* d_in, const int* in_sizes, int n_in, void* d_out, int out_size, void* d_ws, size_t ws_size, hipStream_t stream) {
    static int grid = 0;
    if (grid == 0) {
        int dev = 0, cus = 0, per_cu = 0;
        hipGetDevice(&dev);
        hipDeviceGetAttribute(&cus, hipDeviceAttributeMultiprocessorCount, dev);
        hipFuncSetAttribute((const void*)mega<true>, hipFuncAttributeMaxDynamicSharedMemorySize, SMEM_BYTES);
        hipFuncSetAttribute((const void*)mega<false>, hipFuncAttributeMaxDynamicSharedMemorySize, SMEM_BYTES);
        hipOccupancyMaxActiveBlocksPerMultiprocessor(&per_cu, (const void*)mega<true>, 256, SMEM_BYTES);
        if (per_cu < 1) per_cu = 1;
        if (per_cu > 2) per_cu = 2;
        grid = cus * per_cu;
        if (ws_size < WS_END) { fprintf(stderr, "workspace too small: %zu < %zu\n", ws_size, (size_t)WS_END); grid = -1; }
    }
    if (grid < 0) return;
    Params p{};
    p.x = (const float*)d_in[0]; p.c = (const float*)d_in[1]; p.w_ada = (const float*)d_in[2]; p.b_ada = (const float*)d_in[3];
    p.w_in = (const float*)d_in[4]; p.b_f = (const float*)d_in[5]; p.cmp_pe = (const float*)d_in[6]; p.cmp_w1 = (const float*)d_in[7];
    p.cmp_w2 = (const float*)d_in[8]; p.w_out = (const float*)d_in[9]; p.ln_g = (const float*)d_in[10]; p.ln_b = (const float*)d_in[11];
    p.out = (float*)d_out; p.ws = (char*)d_ws;
    (void)hipMemsetAsync((char*)d_ws + WS_CTRL, 0, 16384, stream);
#if N_LAUNCH_MODE == 1
    hipLaunchKernelGGL(mega<true>, dim3(grid), dim3(256), SMEM_BYTES, stream, p, 0, N_PHASES);
#else
    for (int ph = 0; ph < N_PHASES; ++ph) hipLaunchKernelGGL(mega<false>, dim3(grid), dim3(256), SMEM_BYTES, stream, p, ph, ph + 1);
#endif
}
```

```cpp
#include <hip/hip_runtime.h>
#include <hip/hip_cooperative_groups.h>
#include <stdint.h>
#include <stdio.h>
namespace cg = cooperative_groups;

#define DEV __device__ __forceinline__
typedef unsigned short bf16_t;
typedef short bf16x8 __attribute__((ext_vector_type(8)));
typedef short s16x4 __attribute__((ext_vector_type(4)));
typedef float f32x16 __attribute__((ext_vector_type(16)));
typedef float f32x4 __attribute__((ext_vector_type(4)));
typedef float f32x2 __attribute__((ext_vector_type(2)));
typedef unsigned u32x4 __attribute__((ext_vector_type(4)));
typedef unsigned u32x2 __attribute__((ext_vector_type(2)));
typedef short v4i16_t __attribute__((ext_vector_type(4)));
#define LDSAS __attribute__((address_space(3)))

constexpr int NB = 8, S = 2048, DM = 1024, NTOK = NB * S;
constexpr int HP = 4160, UP = 1088, WP = 1088, ZP = 1088, W1P = 2112;
constexpr int C_DSAQ = 0, C_DSAK = 256, C_DSAV = 320, C_IDXQ = 384, C_IDXK = 640, C_MISC = 672, C_FOXQ = 704, C_FOXK = 1088, C_FOXV = 1472,
              C_NSAQ = 1856, C_KC = 2240, C_VC = 2368, C_KS = 2496, C_VS = 2624, C_KW = 2752, C_VW = 2880, C_GATE = 3008;
constexpr float LOG2E = 1.4426950408889634f;
constexpr float QS = 0.125f * LOG2E;
constexpr float ALPHA = 1.4142135623730951f;
constexpr float NEG_INF = -__builtin_huge_valf();

constexpr size_t WS_CTRL = 0;
constexpr size_t WS_MOD = 16384;
constexpr size_t WS_CS64 = WS_MOD + 2 * 8 * 3072 * 4;
constexpr size_t WS_CS32 = WS_CS64 + 2048 * 32 * 8;
constexpr size_t WS_WINT = WS_CS32 + 2048 * 16 * 8;
constexpr size_t WS_WOUTT = WS_WINT + (size_t)2 * 4096 * WP * 2;
constexpr size_t WS_W1T = WS_WOUTT + (size_t)2 * 1024 * WP * 2;
constexpr size_t WS_U = WS_W1T + (size_t)2 * 2 * 64 * W1P * 2;
constexpr size_t WS_MIX = WS_U + (size_t)NTOK * UP * 2;
constexpr size_t WS_QROT = WS_MIX + (size_t)NTOK * UP * 2;
constexpr size_t WS_IW = WS_QROT + (size_t)NTOK * 384 * 2;
constexpr size_t WS_GSIG = WS_IW + (size_t)NTOK * 8 * 4;
constexpr size_t WS_LOGF = WS_GSIG + (size_t)NTOK * 20 * 4;
constexpr size_t WS_KC = WS_LOGF + (size_t)8 * 6 * 2048 * 4;
constexpr size_t WS_VC = WS_KC + (size_t)8 * 2 * 128 * 64 * 2;
constexpr size_t WS_H = WS_VC + (size_t)8 * 2 * 128 * 64 * 2;
constexpr size_t WS_BM = WS_H + (size_t)NTOK * HP * 2;
constexpr size_t WS_END = WS_BM + (size_t)NTOK * 64 * 4;
static_assert(WS_END <= (size_t)256 * 1024 * 1024, "workspace");

constexpr int SMEM_BYTES = 78848;

struct Params {
    const float *x, *c, *w_ada, *b_ada, *w_in, *b_f, *cmp_pe, *cmp_w1, *cmp_w2, *w_out, *ln_g, *ln_b;
    float* out; char* ws;
};

#define OPAQUE_V(x) asm volatile("" : "+v"(x))
#define CR(r) (((r) & 3) + 8 * ((r) >> 2))
DEV int crow(int r, int h) { return (r & 3) + 8 * (r >> 2) + 4 * h; }
typedef __bf16 bf16x2_t __attribute__((ext_vector_type(2)));
DEV unsigned cvt_pk(float lo, float hi) { const f32x2 v = {lo, hi}; return __builtin_bit_cast(unsigned, __builtin_convertvector(v, bf16x2_t)); }
DEV float bf_lo(unsigned v) { return __uint_as_float(v << 16); }
DEV float bf_hi(unsigned v) { return __uint_as_float(v & 0xffff0000u); }
DEV f32x16 mfma(bf16x8 a, bf16x8 b, f32x16 c) { return __builtin_amdgcn_mfma_f32_32x32x16_bf16(a, b, c, 0, 0, 0); }
DEV float fexp2(float x) { return __builtin_amdgcn_exp2f(x); }
DEV s16x4 vtr(const char* p) { return __builtin_bit_cast(s16x4, __builtin_amdgcn_ds_read_tr16_b64_v4i16((LDSAS v4i16_t*)p)); }
DEV bf16x8 cat4(s16x4 a, s16x4 b) { bf16x8 r; r[0] = a[0]; r[1] = a[1]; r[2] = a[2]; r[3] = a[3]; r[4] = b[0]; r[5] = b[1]; r[6] = b[2]; r[7] = b[3]; return r; }
DEV u32x4 pack8(const float* v) { u32x4 r; r.x = cvt_pk(v[0], v[1]); r.y = cvt_pk(v[2], v[3]); r.z = cvt_pk(v[4], v[5]); r.w = cvt_pk(v[6], v[7]); return r; }
DEV float sigmoidf_(float v) { return 1.0f / (1.0f + __expf(-v)); }

DEV void sincos_acc(float a, float& sn, float& cs) {
    const float q = rintf(a * 0.6366197723675814f);
    float y = fmaf(-q, 1.5703125f, a); y = fmaf(-q, 4.837512969970703125e-4f, y); y = fmaf(-q, 7.54978995489188216e-8f, y);
    const float z = y * y;
    const float sp = y + y * z * (-1.6666654611e-1f + z * (8.3321608736e-3f + z * (-1.9515295891e-4f)));
    const float cp = 1.0f + z * (-0.5f + z * (4.166664568298827e-2f + z * (-1.388731625493765e-3f + z * 2.443315711809948e-5f)));
    const int qi = ((int)q) & 3;
    sn = (qi == 0) ? sp : (qi == 1) ? cp : (qi == 2) ? -sp : -cp;
    cs = (qi == 0) ? cp : (qi == 1) ? -sp : (qi == 2) ? -cp : sp;
}

DEV int win_srccol(int n) {
    if (n < 672) return n;
    if (n < 704) { const int j = n - 672; return j < 8 ? 672 + j : (j < 14 ? 1832 + (j - 8) : 2990 + (j - 14)); }
    if (n < 1856) return 680 + (n - 704);
    if (n < 3008) return 1838 + (n - 1856);
    if (n < 4032) return n;
    return -1;
}
DEV void transpose_unit(const float* __restrict__ src, int ldsrc, bf16_t* __restrict__ dst, int ldd, int n0, int k0, bool winmap, char* smem) {
    float* t = (float*)smem;
    int tid_ = threadIdx.x; OPAQUE_V(tid_); const int tid = tid_;
    {
        const int nn = tid & 63, n = n0 + nn; const int sc = winmap ? win_srccol(n) : n;
#pragma unroll
        for (int i = 0; i < 16; ++i) { const int kk = (tid >> 6) + 4 * i; t[kk * 65 + nn] = sc >= 0 ? src[(size_t)(k0 + kk) * ldsrc + sc] : 0.f; }
    }
    __syncthreads();
    {
        const int nn = tid >> 2, kq = tid & 3; float v[16];
#pragma unroll
        for (int j = 0; j < 16; ++j) v[j] = t[(kq * 16 + j) * 65 + nn];
        u32x4* d = (u32x4*)(dst + (size_t)(n0 + nn) * ldd + k0 + kq * 16);
        d[0] = pack8(v); d[1] = pack8(v + 8);
    }
    __syncthreads();
}
DEV void mod_unit(const Params& p, int L, int cgi, char* smem) {
    float* cs = (float*)smem;
    float* red = (float*)(smem + 32768);
    int tid_ = threadIdx.x; OPAQUE_V(tid_); const int tid = tid_;
#pragma unroll
    for (int i = 0; i < 32; ++i) cs[tid + 256 * i] = p.c[tid + 256 * i];
    __syncthreads();
    const int cc = tid & 31, kk = tid >> 5, col = cgi * 32 + cc;
    float acc[8];
#pragma unroll
    for (int b = 0; b < 8; ++b) acc[b] = 0.f;
    const float* w = p.w_ada + ((size_t)L * 1024 + kk * 128) * 3072 + col;
#pragma unroll 8
    for (int k = 0; k < 128; ++k) {
        const float wv = w[(size_t)k * 3072];
#pragma unroll
        for (int b = 0; b < 8; ++b) acc[b] = fmaf(cs[b * 1024 + kk * 128 + k], wv, acc[b]);
    }
#pragma unroll
    for (int b = 0; b < 8; ++b) red[(kk * 8 + b) * 32 + cc] = acc[b];
    __syncthreads();
    {
        const int b = tid >> 5; float s = p.b_ada[L * 3072 + col];
#pragma unroll
        for (int k2 = 0; k2 < 8; ++k2) s += red[(k2 * 8 + b) * 32 + cc];
        ((float*)(p.ws + WS_MOD))[(L * 8 + b) * 3072 + col] = s;
    }
    __syncthreads();
}
DEV void phase_prep(const Params& p, char* smem) {
    constexpr int N_MOD = 192, N_TAB = 384, N_WIN = 1024;
    constexpr int TOT = N_MOD + N_TAB + N_WIN;
    for (int u = blockIdx.x; u < TOT; u += gridDim.x) {
        int v = u;
        if (v < N_MOD) { mod_unit(p, v / 96, v % 96, smem); continue; }
        v -= N_MOD;
        if (v < N_TAB) {
            int tx_ = threadIdx.x; OPAQUE_V(tx_); const int idx = v * 256 + tx_;
            if (idx < 65536) {
                const int pos = idx >> 5, i = idx & 31; const float inv = powf(10000.0f, -(float)i / 32.0f);
                float sn, cs; sincos_acc((float)pos * inv, sn, cs);
                ((f32x2*)(p.ws + WS_CS64))[idx] = (f32x2){cs, sn};
            } else {
                const int id2 = idx - 65536; const int pos = id2 >> 4, i = id2 & 15; const float inv = powf(10000.0f, -(float)i / 16.0f);
                float sn, cs; sincos_acc((float)pos * inv, sn, cs);
                ((f32x2*)(p.ws + WS_CS32))[id2] = (f32x2){cs, sn};
            }
            continue;
        }
        v -= N_TAB;
        { const int nt = v >> 4, kt = v & 15;
            transpose_unit(p.w_in, 4032, (bf16_t*)(p.ws + WS_WINT), WP, nt * 64, kt * 64, true, smem); }
    }
}
DEV void prep_late_unit(const Params& p, int v, char* smem) {
    if (v < 1024) { const int nt = v >> 4, kt = v & 15;
        transpose_unit(p.w_in + (size_t)1024 * 4032, 4032, (bf16_t*)(p.ws + WS_WINT) + (size_t)4096 * WP, WP, nt * 64, kt * 64, true, smem); return; }
    v -= 1024;
    if (v < 512) { const int L = v >> 8, r = v & 255, nt = r >> 4, kt = r & 15;
        transpose_unit(p.w_out + (size_t)L * 1024 * 1024, 1024, (bf16_t*)(p.ws + WS_WOUTT) + (size_t)L * 1024 * WP, WP, nt * 64, kt * 64, false, smem); return; }
    v -= 512;
    { const int lk = v >> 5, kt = v & 31;
        transpose_unit(p.cmp_w1 + (size_t)lk * 2048 * 64, 64, (bf16_t*)(p.ws + WS_W1T) + (size_t)lk * 64 * W1P, W1P, 0, kt * 64, false, smem); }
}
DEV void phase_u1(const Params& p, char* smem) {
    const float* mod = (const float*)(p.ws + WS_MOD);
    bf16_t* U = (bf16_t*)(p.ws + WS_U);
    for (int u0 = blockIdx.x; u0 < 2048 + 1664; u0 += gridDim.x) {
        if (u0 >= 2048) { prep_late_unit(p, u0 - 2048, smem); continue; }
        const int u = u0;
        int tx_ = threadIdx.x; OPAQUE_V(tx_);
#pragma unroll
        for (int i = 0; i < 4; ++i) {
            const int e = tx_ + 256 * i, row = 8 * u + (e >> 7), c8 = (e & 127) * 8, b = row >> 11;
            const f32x4* xp = (const f32x4*)(p.x + (size_t)row * 1024 + c8);
            const f32x4* sh = (const f32x4*)(mod + (size_t)b * 3072 + c8);
            const f32x4* sc = (const f32x4*)(mod + (size_t)b * 3072 + 1024 + c8);
            float v[8];
#pragma unroll
            for (int q = 0; q < 2; ++q) { const f32x4 xv = xp[q], s1 = sc[q], s0 = sh[q];
#pragma unroll
                for (int k = 0; k < 4; ++k) v[4 * q + k] = fmaf(xv[k], 1.0f + s1[k], s0[k]); }
            *(u32x4*)(U + (size_t)row * UP + c8) = pack8(v);
        }
    }
}

constexpr int KP = 72, CTP = 132;
constexpr int GST = 24576;
DEV void gemm_kloop(const bf16_t* __restrict__ X, int ldx, const bf16_t* __restrict__ W, int ldw, int K, int m0, int n0, char* smem, f32x16 (&acc)[2][4], int tid) {
    const int lane = tid & 63, w = __builtin_amdgcn_readfirstlane(tid >> 6), wm = w >> 1, wn = w & 1, r32 = lane & 31, h = lane >> 5;
    const bf16_t* xg[4]; const bf16_t* wg[2];
#pragma unroll
    for (int i = 0; i < 4; ++i) { const int row = 16 * (4 * w + i) + (lane >> 2), kc = (lane & 3) ^ ((row >> 2) & 3); xg[i] = X + (size_t)(m0 + row) * ldx + kc * 8; }
#pragma unroll
    for (int i = 0; i < 2; ++i) { const int row = 16 * (2 * w + i) + (lane >> 2), kc = (lane & 3) ^ ((row >> 2) & 3); wg[i] = W + (size_t)(n0 + row) * ldw + kc * 8; }
#define GEMM_STAGE(kt, stb) do { \
        _Pragma("unroll") for (int i = 0; i < 4; ++i) __builtin_amdgcn_global_load_lds((const unsigned*)(xg[i] + (kt) * 32), (LDSAS unsigned*)(smem + (stb) + (4 * w + i) * 1024), 16, 0, 0); \
        _Pragma("unroll") for (int i = 0; i < 2; ++i) __builtin_amdgcn_global_load_lds((const unsigned*)(wg[i] + (kt) * 32), (LDSAS unsigned*)(smem + (stb) + 16384 + (2 * w + i) * 1024), 16, 0, 0); } while (0)
#pragma unroll
    for (int i = 0; i < 2; ++i)
#pragma unroll
        for (int j = 0; j < 4; ++j)
#pragma unroll
            for (int r = 0; r < 16; ++r) acc[i][j][r] = 0.f;
    const int nk = K / 32;
    int offA[2], offB[4];
#pragma unroll
    for (int i = 0; i < 2; ++i) { const int ra = wm * 64 + 32 * i + r32; offA[i] = 16384 + ra * 64 + ((h ^ ((ra >> 2) & 3)) << 4); }
#pragma unroll
    for (int j = 0; j < 4; ++j) { const int rb = wn * 128 + 32 * j + r32; offB[j] = rb * 64 + ((h ^ ((rb >> 2) & 3)) << 4); }
    GEMM_STAGE(0, 0); GEMM_STAGE(1, GST);
    int cur = 0, nxt = 2 * GST;
    for (int kt = 0; kt < nk; ++kt) {
        if (kt + 1 < nk) asm volatile("s_waitcnt vmcnt(6)" ::: "memory");
        else asm volatile("s_waitcnt vmcnt(0)" ::: "memory");
        __builtin_amdgcn_s_barrier();
        asm volatile("" ::: "memory");
        const char* st = smem + cur;
        bf16x8 a0[2], b0[4], a1[2], b1[4];
#pragma unroll
        for (int i = 0; i < 2; ++i) a0[i] = *(const bf16x8*)(st + offA[i]);
#pragma unroll
        for (int j = 0; j < 4; ++j) b0[j] = *(const bf16x8*)(st + offB[j]);
#pragma unroll
        for (int i = 0; i < 2; ++i) a1[i] = *(const bf16x8*)(st + (offA[i] ^ 32));
#pragma unroll
        for (int j = 0; j < 4; ++j) b1[j] = *(const bf16x8*)(st + (offB[j] ^ 32));
        __builtin_amdgcn_sched_barrier(0);
        const bool more = kt + 2 < nk;
        if (more) {
#pragma unroll
            for (int i = 0; i < 3; ++i) __builtin_amdgcn_global_load_lds((const unsigned*)(xg[i] + (kt + 2) * 32), (LDSAS unsigned*)(smem + nxt + (4 * w + i) * 1024), 16, 0, 0);
        }
        __builtin_amdgcn_sched_barrier(0);
#pragma unroll
        for (int i = 0; i < 2; ++i)
#pragma unroll
            for (int j = 0; j < 4; ++j) acc[i][j] = mfma(a0[i], b0[j], acc[i][j]);
        __builtin_amdgcn_sched_barrier(0);
        if (more) {
            __builtin_amdgcn_global_load_lds((const unsigned*)(xg[3] + (kt + 2) * 32), (LDSAS unsigned*)(smem + nxt + (4 * w + 3) * 1024), 16, 0, 0);
#pragma unroll
            for (int i = 0; i < 2; ++i) __builtin_amdgcn_global_load_lds((const unsigned*)(wg[i] + (kt + 2) * 32), (LDSAS unsigned*)(smem + nxt + 16384 + (2 * w + i) * 1024), 16, 0, 0);
        }
        __builtin_amdgcn_sched_barrier(0);
#pragma unroll
        for (int i = 0; i < 2; ++i)
#pragma unroll
            for (int j = 0; j < 4; ++j) acc[i][j] = mfma(a1[i], b1[j], acc[i][j]);
        nxt = cur; cur = cur == 2 * GST ? 0 : cur + GST;
    }
#undef GEMM_STAGE
    __syncthreads();
}

constexpr int CSP = 136;
DEV float silu_fast(float a) { return a * __builtin_amdgcn_rcpf(1.0f + fexp2(-LOG2E * a)); }
DEV void cs_store4(bf16_t* Cs, int row, int col, float a, float b, float c, float d) { u32x2 v; v.x = cvt_pk(a, b); v.y = cvt_pk(c, d); *(u32x2*)(Cs + row * CSP + col) = v; }
DEV void cs_flush(const bf16_t* Cs, bf16_t* dst, size_t ldd, int tid) {
#pragma unroll
    for (int it = 0; it < 16; ++it) { const int row = (tid >> 4) + 16 * it, ch = tid & 15;
        *(u32x4*)(dst + (size_t)row * ldd + ch * 8) = *(const u32x4*)(Cs + row * CSP + ch * 8); }
}
DEV void phase_gemm_in(const Params& p, int L, char* smem) {
    const bf16_t* U = (const bf16_t*)(p.ws + WS_U);
    const bf16_t* W = (const bf16_t*)(p.ws + WS_WINT) + (size_t)L * 4096 * WP;
    bf16_t* H = (bf16_t*)(p.ws + WS_H);
    bf16_t* Cs = (bf16_t*)smem;
    const int VGRID_ = gridDim.x;
    for (int u = blockIdx.x; u < 2048; u += gridDim.x) {
        int tid_ = threadIdx.x; OPAQUE_V(tid_); const int tid = tid_;
        const int lane = tid & 63, w = __builtin_amdgcn_readfirstlane(tid >> 6), wm = w >> 1, wn = w & 1, r32 = lane & 31, h = lane >> 5;
        const int mt = u >> 5, nt = ((u & 31) + 8 * (u / (int)VGRID_)) & 31, m0 = mt * 256, c64 = 2 * nt + wm;
        f32x16 acc[2][4];
        gemm_kloop(U, UP, W, WP, 1024, m0, nt * 128, smem, acc, tid);
        const bool is_rope64 = c64 <= 4 || (c64 >= 29 && c64 <= 34) || c64 == 39 || c64 == 40 || c64 == 43 || c64 == 44;
        const bool is_nsaq = c64 >= 29 && c64 <= 34;
#pragma unroll
        for (int j = 0; j < 4; ++j) {
            const int trow = 128 * wn + 32 * j + r32, token = m0 + trow, pos = token & 2047;
            f32x16& A0 = acc[0][j]; f32x16& A1 = acc[1][j];
            if (is_rope64) {
                if (is_nsaq) {
#pragma unroll
                    for (int r = 0; r < 16; ++r) { A0[r] *= QS; A1[r] *= QS; }
                } else {
                    const float sc = c64 <= 3 ? QS : 1.0f;
                    const f32x2* ct = (const f32x2*)(p.ws + WS_CS64) + pos * 32 + 4 * h;
#pragma unroll
                    for (int a = 0; a < 4; ++a) {
                        const f32x4 c01 = *(const f32x4*)(ct + 8 * a), c23 = *(const f32x4*)(ct + 8 * a + 2);
                        const float cs_[4] = {c01[0], c01[2], c23[0], c23[2]}, sn_[4] = {c01[1], c01[3], c23[1], c23[3]};
#pragma unroll
                        for (int k = 0; k < 4; ++k) { const float x1 = A0[4 * a + k], x2 = A1[4 * a + k];
                            A0[4 * a + k] = (x1 * cs_[k] - x2 * sn_[k]) * sc; A1[4 * a + k] = (x1 * sn_[k] + x2 * cs_[k]) * sc; }
                    }
                }
            } else if ((c64 >= 6 && c64 <= 10)) {
                const f32x2* ct = (const f32x2*)(p.ws + WS_CS32) + pos * 16 + 4 * h;
#pragma unroll
                for (int a = 0; a < 2; ++a) {
                    const f32x4 c01 = *(const f32x4*)(ct + 8 * a), c23 = *(const f32x4*)(ct + 8 * a + 2);
                    const float cs_[4] = {c01[0], c01[2], c23[0], c23[2]}, sn_[4] = {c01[1], c01[3], c23[1], c23[3]};
#pragma unroll
                    for (int k = 0; k < 4; ++k) {
                        { const float x1 = A0[4 * a + k], x2 = A0[4 * (a + 2) + k]; A0[4 * a + k] = x1 * cs_[k] - x2 * sn_[k]; A0[4 * (a + 2) + k] = x1 * sn_[k] + x2 * cs_[k]; }
                        if (c64 != 10) { const float x1 = A1[4 * a + k], x2 = A1[4 * (a + 2) + k]; A1[4 * a + k] = x1 * cs_[k] - x2 * sn_[k]; A1[4 * (a + 2) + k] = x1 * sn_[k] + x2 * cs_[k]; }
                    }
                }
                if (c64 == 10) {
                    const int b = token >> 11;
                    float* iw = (float*)(p.ws + WS_IW) + (size_t)token * 8 + 4 * h;
                    *(f32x4*)iw = (f32x4){A1[0], A1[1], A1[2], A1[3]} * 0.35355339059327373f;
                    float* lf = (float*)(p.ws + WS_LOGF) + (size_t)b * 6 * 2048 + pos; float* gs = (float*)(p.ws + WS_GSIG) + (size_t)token * 20;
#pragma unroll
                    for (int a = 1; a < 4; ++a)
#pragma unroll
                        for (int k = 0; k < 4; ++k) {
                            const int f = 8 * a + k;
                            const float v = A1[4 * a + k];
                            if (a == 1) {
                                if (h == 0 || k < 2) { const int e = 4 * h + k; const float x = v + p.b_f[L * 6 + e]; lf[(size_t)e * 2048] = fminf(x, 0.f) - 0.6931471805599453f * __builtin_amdgcn_logf(1.0f + fexp2(-LOG2E * fabsf(x))); }
                                else gs[k - 2] = __builtin_amdgcn_rcpf(1.0f + fexp2(-LOG2E * v));
                            } else gs[f + 4 * h - 14] = __builtin_amdgcn_rcpf(1.0f + fexp2(-LOG2E * v));
                        }
                }
            } else {
                const bool isq = (c64 >= 11 && c64 <= 16), silu = c64 >= 47;
#pragma unroll
                for (int r = 0; r < 16; ++r) {
                    if (silu) { A0[r] = silu_fast(A0[r]); A1[r] = silu_fast(A1[r]); }
                    else if (isq) { A0[r] *= QS; A1[r] *= QS; }
                }
            }
#pragma unroll
            for (int a = 0; a < 4; ++a) {
                cs_store4(Cs, trow, 64 * wm + 8 * a + 4 * h, A0[4 * a], A0[4 * a + 1], A0[4 * a + 2], A0[4 * a + 3]);
                cs_store4(Cs, trow, 64 * wm + 32 + 8 * a + 4 * h, A1[4 * a], A1[4 * a + 1], A1[4 * a + 2], A1[4 * a + 3]);
            }
        }
        __syncthreads();
        cs_flush(Cs, H + (size_t)m0 * HP + nt * 128, HP, tid);
        if (nt >= 14 && nt <= 17) {
            __syncthreads();
            if (is_nsaq) {
#pragma unroll
                for (int j = 0; j < 4; ++j) { const int trow = 128 * wn + 32 * j + r32, pos = (m0 + trow) & 2047;
                    const f32x16& A0 = acc[0][j]; const f32x16& A1 = acc[1][j];
                    const f32x2* ct = (const f32x2*)(p.ws + WS_CS64) + pos * 32 + 4 * h;
#pragma unroll
                    for (int a = 0; a < 4; ++a) {
                        const f32x4 c01 = *(const f32x4*)(ct + 8 * a), c23 = *(const f32x4*)(ct + 8 * a + 2);
                        const float cs_[4] = {c01[0], c01[2], c23[0], c23[2]}, sn_[4] = {c01[1], c01[3], c23[1], c23[3]};
                        float o1[4], o2[4];
#pragma unroll
                        for (int k = 0; k < 4; ++k) { const float x1 = A0[4 * a + k], x2 = A1[4 * a + k]; o1[k] = x1 * cs_[k] - x2 * sn_[k]; o2[k] = x1 * sn_[k] + x2 * cs_[k]; }
                        cs_store4(Cs, trow, 64 * wm + 8 * a + 4 * h, o1[0], o1[1], o1[2], o1[3]);
                        cs_store4(Cs, trow, 64 * wm + 32 + 8 * a + 4 * h, o2[0], o2[1], o2[2], o2[3]);
                    } }
            }
            __syncthreads();
            bf16_t* QR = (bf16_t*)(p.ws + WS_QROT);
#pragma unroll
            for (int it = 0; it < 16; ++it) { const int row = (tid >> 4) + 16 * it, ch = tid & 15; const int cc = 2 * nt + (ch >> 3);
                if (cc >= 29 && cc <= 34) *(u32x4*)(QR + (size_t)(m0 + row) * 384 + (cc - 29) * 64 + (ch & 7) * 8) = *(const u32x4*)(Cs + row * CSP + ch * 8); }
        }
        __syncthreads();
    }
}
DEV void phase_out(const Params& p, int L, char* smem) {
    const bf16_t* A = (const bf16_t*)(p.ws + WS_MIX);
    const bf16_t* W = (const bf16_t*)(p.ws + WS_WOUTT) + (size_t)L * 1024 * WP;
    bf16_t* Z = (bf16_t*)(p.ws + WS_H);
    const float* mod = (const float*)(p.ws + WS_MOD) + (size_t)L * 8 * 3072;
    bf16_t* Cs = (bf16_t*)smem;
    for (int u = blockIdx.x; u < 512; u += gridDim.x) {
        int tid_ = threadIdx.x; OPAQUE_V(tid_); const int tid = tid_;
        const int lane = tid & 63, w = __builtin_amdgcn_readfirstlane(tid >> 6), wm = w >> 1, wn = w & 1, r32 = lane & 31, h = lane >> 5;
        const int mt = u >> 3, nt = u & 7, m0 = mt * 256, n0 = nt * 128, b = m0 >> 11;
        f32x16 acc[2][4];
        gemm_kloop(A, UP, W, WP, 1024, m0, n0, smem, acc, tid);
        f32x4 g1[2][4];
#pragma unroll
        for (int i = 0; i < 2; ++i)
#pragma unroll
            for (int a = 0; a < 4; ++a) g1[i][a] = *(const f32x4*)(mod + (size_t)b * 3072 + 2048 + n0 + 64 * wm + 32 * i + 8 * a + 4 * h) + 1.0f;
#pragma unroll
        for (int j = 0; j < 4; ++j) { const int trow = 128 * wn + 32 * j + r32;
#pragma unroll
            for (int i = 0; i < 2; ++i)
#pragma unroll
                for (int a = 0; a < 4; ++a) cs_store4(Cs, trow, 64 * wm + 32 * i + 8 * a + 4 * h, acc[i][j][4 * a] * g1[i][a][0], acc[i][j][4 * a + 1] * g1[i][a][1], acc[i][j][4 * a + 2] * g1[i][a][2], acc[i][j][4 * a + 3] * g1[i][a][3]);
        }
        __syncthreads();
        cs_flush(Cs, Z + (size_t)m0 * ZP + n0, ZP, tid);
        __syncthreads();
    }
}
DEV void phase_ln(const Params& p, int L) {
    const bf16_t* Z = (const bf16_t*)(p.ws + WS_H);
    const float* xin = L == 0 ? p.x : p.out;
    const float* mod = (const float*)(p.ws + WS_MOD) + (size_t)8 * 3072;
    bf16_t* U = (bf16_t*)(p.ws + WS_U);
    for (int u = blockIdx.x; u < 1024; u += gridDim.x) {
        int tx_ = threadIdx.x; OPAQUE_V(tx_);
        const int lane = tx_ & 63, w = __builtin_amdgcn_readfirstlane(tx_ >> 6);
        for (int rr = 0; rr < 4; ++rr) {
            const int row = u * 16 + w * 4 + rr, b = row >> 11;
            f32x4 v[4]; float s = 0.f;
#pragma unroll
            for (int i = 0; i < 4; ++i) { const f32x4 xv = *(const f32x4*)(xin + (size_t)row * 1024 + 256 * i + 4 * lane);
                const u32x2 zz = *(const u32x2*)(Z + (size_t)row * ZP + 256 * i + 4 * lane);
                v[i] = (f32x4){bf_lo(zz.x), bf_hi(zz.x), bf_lo(zz.y), bf_hi(zz.y)} + ALPHA * xv; s += (v[i][0] + v[i][1]) + (v[i][2] + v[i][3]); }
#pragma unroll
            for (int o = 32; o >= 1; o >>= 1) s += __shfl_xor(s, o);
            const float mean = s * (1.0f / 1024.0f); float q = 0.f;
#pragma unroll
            for (int i = 0; i < 4; ++i)
#pragma unroll
                for (int k = 0; k < 4; ++k) { const float d = v[i][k] - mean; q = fmaf(d, d, q); }
#pragma unroll
            for (int o = 32; o >= 1; o >>= 1) q += __shfl_xor(q, o);
            const float rstd = rsqrtf(q * (1.0f / 1024.0f) + 1e-5f);
#pragma unroll
            for (int i = 0; i < 4; ++i) {
                const int col = 256 * i + 4 * lane;
                const f32x4 g = *(const f32x4*)(p.ln_g + L * 1024 + col), bb = *(const f32x4*)(p.ln_b + L * 1024 + col);
                f32x4 o;
#pragma unroll
                for (int k = 0; k < 4; ++k) o[k] = (v[i][k] - mean) * rstd * g[k] + bb[k];
                *(f32x4*)(p.out + (size_t)row * 1024 + col) = o;
                if (L == 0) {
                    const f32x4 sh = *(const f32x4*)(mod + (size_t)b * 3072 + col), sc = *(const f32x4*)(mod + (size_t)b * 3072 + 1024 + col);
                    u32x2 pk; pk.x = cvt_pk(fmaf(o[0], 1.0f + sc[0], sh[0]), fmaf(o[1], 1.0f + sc[1], sh[1])); pk.y = cvt_pk(fmaf(o[2], 1.0f + sc[2], sh[2]), fmaf(o[3], 1.0f + sc[3], sh[3]));
                    *(u32x2*)(U + (size_t)row * UP + col) = pk;
                }
            }
        }
    }
}

constexpr int KT_BYTES = 64 * KP * 2, VT_BYTES = 8192;
struct KVRegs { u32x4 k[2], v[2]; };
DEV void kv_load(KVRegs& r, const bf16_t* __restrict__ kg, const bf16_t* __restrict__ vg, size_t pitch, int tid) {
#pragma unroll
    for (int i = 0; i < 2; ++i) { const int c = tid + 256 * i, row = c >> 3, ch = c & 7;
        r.k[i] = *(const u32x4*)(kg + (size_t)row * pitch + ch * 8); r.v[i] = *(const u32x4*)(vg + (size_t)row * pitch + ch * 8); }
}
DEV void kv_store(const KVRegs& r, char* ksm, char* vsm, int tid) {
#pragma unroll
    for (int i = 0; i < 2; ++i) { const int c = tid + 256 * i, row = c >> 3, ch = c & 7;
        *(u32x4*)(ksm + (row * KP + ch * 8) * 2) = r.k[i];
        *(u32x4*)(vsm + (ch >> 2) * 4096 + row * 64 + (ch & 3) * 16) = r.v[i]; }
}
DEV void load_qf(const bf16_t* q  , int h, bf16x8* qf) {
#pragma unroll
    for (int s = 0; s < 4; ++s) qf[s] = *(const bf16x8*)(q + 16 * s + 8 * h);
}
DEV void qk_tile(const char* ksm, const bf16x8* qf, int r32, int h, f32x16& s0, f32x16& s1) {
#pragma unroll
    for (int r = 0; r < 16; ++r) { s0[r] = 0.f; s1[r] = 0.f; }
#pragma unroll
    for (int s = 0; s < 4; ++s) {
        const bf16x8 a0 = *(const bf16x8*)(ksm + (r32 * KP + 16 * s + 8 * h) * 2);
        const bf16x8 a1 = *(const bf16x8*)(ksm + ((32 + r32) * KP + 16 * s + 8 * h) * 2);
        s0 = mfma(a0, qf[s], s0); s1 = mfma(a1, qf[s], s1);
    }
}
DEV void pv_tile(const char* vsm, int kofs, const f32x16& pt, int lane, f32x16& o0, f32x16& o1) {
    const int h = lane >> 5;
    const char* vb = vsm + ((lane >> 4) & 1) * 32 + (lane & 3) * 8 + (4 * h + ((lane & 15) >> 2) + kofs) * 64;
#pragma unroll
    for (int sp = 0; sp < 2; ++sp) {
        bf16x8 pb;
        { u32x4 t; t.x = cvt_pk(pt[8 * sp], pt[8 * sp + 1]); t.y = cvt_pk(pt[8 * sp + 2], pt[8 * sp + 3]); t.z = cvt_pk(pt[8 * sp + 4], pt[8 * sp + 5]); t.w = cvt_pk(pt[8 * sp + 6], pt[8 * sp + 7]); pb = __builtin_bit_cast(bf16x8, t); }
        const bf16x8 a0 = cat4(vtr(vb + (16 * sp) * 64), vtr(vb + (16 * sp + 8) * 64));
        const bf16x8 a1 = cat4(vtr(vb + 4096 + (16 * sp) * 64), vtr(vb + 4096 + (16 * sp + 8) * 64));
        o0 = mfma(a0, pb, o0); o1 = mfma(a1, pb, o1);
    }
}
DEV void flash_update(f32x16& s0, f32x16& s1, float& m, float& l, f32x16& o0, f32x16& o1, const char* vsm, int lane) {
    float mx = NEG_INF;
#pragma unroll
    for (int r = 0; r < 16; ++r) mx = fmaxf(mx, fmaxf(s0[r], s1[r]));
    mx = fmaxf(mx, __shfl_xor(mx, 32));
    const float mn = fmaxf(m, mx), mu = (mn == NEG_INF) ? 0.f : mn;
    const float alpha = fexp2(m - mu);
    m = mn;
    float ps = 0.f;
#pragma unroll
    for (int r = 0; r < 16; ++r) { s0[r] = fexp2(s0[r] - mu); s1[r] = fexp2(s1[r] - mu); ps += s0[r] + s1[r]; }
    l = fmaf(l, alpha, ps);
#pragma unroll
    for (int r = 0; r < 16; ++r) { o0[r] *= alpha; o1[r] *= alpha; }
    pv_tile(vsm, 0, s0, lane, o0, o1);
    pv_tile(vsm, 32, s1, lane, o0, o1);
}
DEV f32x16 qk32(const char* kbase, const bf16x8* qf, int r32, int h) {
    f32x16 s;
#pragma unroll
    for (int r = 0; r < 16; ++r) s[r] = 0.f;
#pragma unroll
    for (int k = 0; k < 4; ++k) { const bf16x8 a = *(const bf16x8*)(kbase + (r32 * KP + 16 * k + 8 * h) * 2); s = mfma(a, qf[k], s); }
    return s;
}
DEV void flash_update32(f32x16& s, float& m, float& l, f32x16& o0, f32x16& o1, const char* vsm, int kofs, int hstride, int lane) {
    float mx = NEG_INF;
#pragma unroll
    for (int r = 0; r < 16; ++r) mx = fmaxf(mx, s[r]);
    mx = fmaxf(mx, __shfl_xor(mx, 32));
    const float mn = fmaxf(m, mx), mu = (mn == NEG_INF) ? 0.f : mn;
    const float alpha = fexp2(m - mu);
    m = mn;
    float ps = 0.f;
#pragma unroll
    for (int r = 0; r < 16; ++r) { s[r] = fexp2(s[r] - mu); ps += s[r]; }
    l = fmaf(l, alpha, ps);
#pragma unroll
    for (int r = 0; r < 16; ++r) { o0[r] *= alpha; o1[r] *= alpha; }
    const int h = lane >> 5;
    const char* vb = vsm + ((lane >> 4) & 1) * 32 + (lane & 3) * 8 + (4 * h + ((lane & 15) >> 2) + kofs) * 64;
#pragma unroll
    for (int sp = 0; sp < 2; ++sp) {
        u32x4 t; t.x = cvt_pk(s[8 * sp], s[8 * sp + 1]); t.y = cvt_pk(s[8 * sp + 2], s[8 * sp + 3]); t.z = cvt_pk(s[8 * sp + 4], s[8 * sp + 5]); t.w = cvt_pk(s[8 * sp + 6], s[8 * sp + 7]);
        const bf16x8 pb = __builtin_bit_cast(bf16x8, t);
        const bf16x8 a0 = cat4(vtr(vb + (16 * sp) * 64), vtr(vb + (16 * sp + 8) * 64));
        const bf16x8 a1 = cat4(vtr(vb + hstride + (16 * sp) * 64), vtr(vb + hstride + (16 * sp + 8) * 64));
        o0 = mfma(a0, pb, o0); o1 = mfma(a1, pb, o1);
    }
}
DEV void qk_tile_c(const char* ksm, const bf16x8* qf, int r32, int h, const f32x16& c0, const f32x16& c1, f32x16& s0, f32x16& s1) {
    s0 = c0; s1 = c1;
#pragma unroll
    for (int s = 0; s < 4; ++s) {
        const bf16x8 a0 = *(const bf16x8*)(ksm + (r32 * KP + 16 * s + 8 * h) * 2);
        const bf16x8 a1 = *(const bf16x8*)(ksm + ((32 + r32) * KP + 16 * s + 8 * h) * 2);
        s0 = mfma(a0, qf[s], s0); s1 = mfma(a1, qf[s], s1);
    }
}
DEV float max3f(float a, float b, float c) { return fmaxf(fmaxf(a, b), c); }
struct FlashSt { float mref, l; bool unset; f32x16 o0, o1; };
DEV void flash_init(FlashSt& st) { st.mref = 0.f; st.l = 0.f; st.unset = true;
#pragma unroll
    for (int r = 0; r < 16; ++r) { st.o0[r] = 0.f; st.o1[r] = 0.f; } }
DEV bool flash_lazy(f32x16& s0, f32x16& s1, FlashSt& st, const char* vsm, int lane) {
    float mx = max3f(s0[0], s0[1], s1[0]);
#pragma unroll
    for (int r = 1; r < 16; r += 1) mx = (r & 1) ? max3f(mx, s0[r], s1[r]) : mx;
#pragma unroll
    for (int r = 2; r < 16; r += 2) mx = max3f(mx, s0[r], s1[r]);
    mx = fmaxf(mx, __shfl_xor(mx, 32));
    const bool fin = mx > NEG_INF;
    const bool need = fin && (st.unset || mx > 8.0f);
    bool moved = false;
    if (__any(need)) {
        const bool upd = fin && (st.unset || mx > 0.f);
        const float delta = upd ? mx : 0.f;
        const float alpha = st.unset ? 1.0f : fexp2(-delta);
        st.mref += delta; st.l *= alpha;
#pragma unroll
        for (int r = 0; r < 16; ++r) { st.o0[r] *= alpha; st.o1[r] *= alpha; s0[r] -= delta; s1[r] -= delta; }
        st.unset = st.unset && !fin;
        moved = true;
    }
    float ps = 0.f;
#pragma unroll
    for (int r = 0; r < 16; ++r) { s0[r] = fexp2(s0[r]); s1[r] = fexp2(s1[r]); ps += s0[r] + s1[r]; }
    st.l += ps;
    pv_tile(vsm, 0, s0, lane, st.o0, st.o1);
    pv_tile(vsm, 32, s1, lane, st.o0, st.o1);
    return moved;
}
DEV void fill16(f32x16& t, float v) {
#pragma unroll
    for (int r = 0; r < 16; ++r) t[r] = v; }
DEV void write_mix(const Params& p, size_t token, int mixcol0, const f32x16& o0, const f32x16& o1, int h) {
    const bf16_t* G = (const bf16_t*)(p.ws + WS_H) + token * HP + C_GATE + mixcol0;
    bf16_t* M = (bf16_t*)(p.ws + WS_MIX) + token * UP + mixcol0;
#pragma unroll
    for (int dt = 0; dt < 2; ++dt)
#pragma unroll
        for (int a = 0; a < 4; ++a) {
            const int d = 32 * dt + 8 * a + 4 * h;
            const u32x2 g = *(const u32x2*)(G + d);
            const f32x16& o = dt ? o1 : o0;
            u32x2 r; r.x = cvt_pk(o[4 * a] * bf_lo(g.x), o[4 * a + 1] * bf_hi(g.x)); r.y = cvt_pk(o[4 * a + 2] * bf_lo(g.y), o[4 * a + 3] * bf_hi(g.y));
            *(u32x2*)(M + d) = r;
        }
}

DEV void fox_unit(const Params& p, int b, int hh, int qb, char* smem) {
    char* ksm = smem; char* vsm = smem + KT_BYTES; float* cum = (float*)(smem + KT_BYTES + VT_BYTES);
    float* wtot = cum + 2048;
    int tid_ = threadIdx.x; OPAQUE_V(tid_); const int tid = tid_, lane = tid & 63, w = __builtin_amdgcn_readfirstlane(tid >> 6), r32 = lane & 31, h = lane >> 5;
    const int q0 = qb * 128, nneed = q0 + 128;
    const bf16_t* H = (const bf16_t*)(p.ws + WS_H) + (size_t)b * S * HP;
    {
        const float* lf = (const float*)(p.ws + WS_LOGF) + ((size_t)b * 6 + hh) * 2048;
        float v[8]; float s = 0.f;
        if (tid * 8 < nneed) { const f32x4 a = *(const f32x4*)(lf + tid * 8), c = *(const f32x4*)(lf + tid * 8 + 4);
            v[0] = a[0]; v[1] = a[1]; v[2] = a[2]; v[3] = a[3]; v[4] = c[0]; v[5] = c[1]; v[6] = c[2]; v[7] = c[3]; }
        else {
#pragma unroll
            for (int e = 0; e < 8; ++e) v[e] = 0.f; }
#pragma unroll
        for (int e = 0; e < 8; ++e) { s += v[e]; v[e] = s; }
        float inc = s;
#pragma unroll
        for (int o = 1; o < 64; o <<= 1) { const float t = __shfl_up(inc, o); if (lane >= o) inc += t; }
        if (lane == 63) wtot[w] = inc;
        __syncthreads();
        float base = inc - s;
        for (int k = 0; k < w; ++k) base += wtot[k];
        if (tid * 8 < nneed) {
#pragma unroll
            for (int e = 0; e < 8; ++e) cum[tid * 8 + e] = (base + v[e]) * LOG2E; }
        __syncthreads();
    }
    const int tq = q0 + 32 * w + r32;
    bf16x8 qf[4]; load_qf(H + (size_t)tq * HP + C_FOXQ + 64 * hh, h, qf);
    const float cb = cum[tq];
    FlashSt st; flash_init(st);
    const int ntiles = nneed / 64, mylast = (q0 + 32 * w + 31) >> 6, wt0 = q0 + 32 * w;
    KVRegs kvr; kv_load(kvr, H + (size_t)(ntiles - 1) * 64 * HP + C_FOXK + 64 * hh, H + (size_t)(ntiles - 1) * 64 * HP + C_FOXV + 64 * hh, HP, tid);
    for (int kt = ntiles - 1; kt >= 0; --kt) {
        __syncthreads();
        kv_store(kvr, ksm, vsm, tid);
        __syncthreads();
        if (kt > 0) kv_load(kvr, H + (size_t)(kt - 1) * 64 * HP + C_FOXK + 64 * hh, H + (size_t)(kt - 1) * 64 * HP + C_FOXV + 64 * hh, HP, tid);
        if (kt <= mylast) {
            const float cbm = cb - st.mref;
            f32x16 c0, c1;
#pragma unroll
            for (int a = 0; a < 4; ++a) {
                const f32x4 k0 = *(const f32x4*)(cum + kt * 64 + 8 * a + 4 * h), k1 = *(const f32x4*)(cum + kt * 64 + 32 + 8 * a + 4 * h);
#pragma unroll
                for (int k = 0; k < 4; ++k) { c0[4 * a + k] = cbm - k0[k]; c1[4 * a + k] = cbm - k1[k]; }
            }
            if (kt * 64 + 63 > wt0) {
                int lim = tq - 64 * kt - 4 * h; OPAQUE_V(lim);
#pragma unroll
                for (int r = 0; r < 16; ++r) { c0[r] = CR(r) <= lim ? c0[r] : NEG_INF; c1[r] = (CR(r) + 32) <= lim ? c1[r] : NEG_INF; }
            }
            f32x16 s0, s1; qk_tile_c(ksm, qf, r32, h, c0, c1, s0, s1);
            flash_lazy(s0, s1, st, vsm, lane);
        }
    }
    float l = st.l; l += __shfl_xor(l, 32);
    const float inv = 1.0f / l;
    f32x16 o0, o1;
#pragma unroll
    for (int r = 0; r < 16; ++r) { o0[r] = st.o0[r] * inv; o1[r] = st.o1[r] * inv; }
    write_mix(p, (size_t)b * S + tq, 256 + 64 * hh, o0, o1, h);
    __syncthreads();
}

constexpr int BMP = 65;
#ifndef DSA_PROBE_STG
#define DSA_PROBE_STG 0
#endif
#ifndef DSA_REP_IDX
#define DSA_REP_IDX 1
#endif
DEV unsigned ford(float f) { const unsigned u = __float_as_uint(f); return u ^ ((u >> 31) ? 0xffffffffu : 0x80000000u); }
constexpr int TK_NB = 256;
DEV unsigned funord(unsigned k) { return k ^ ((k >> 31) ? 0x80000000u : 0xffffffffu); }
template <int STG>
DEV void topk_row(const float* sc, int n, unsigned* bmrow, unsigned* hist  , int lane) {
    const int nch = (n + 63) >> 6;
    if (n <= 256) {
        if (lane < 32) { const int lo = 64 * lane; unsigned long long msk = 0ull;
            if (lo < n) { const int c = n - lo; msk = c >= 64 ? ~0ull : ((1ull << c) - 1ull); }
            bmrow[2 * lane] = (unsigned)msk; bmrow[2 * lane + 1] = (unsigned)(msk >> 32); }
        return;
    }
    const float PINF = __builtin_huge_valf();
    float v[32]; float vmax = NEG_INF, vmin = PINF;
#pragma unroll
    for (int i = 0; i < 32; ++i) {
        v[i] = NEG_INF;
        if (i < nch) { v[i] = sc[64 * i + lane]; vmax = fmaxf(vmax, v[i]);
            if (i < nch - 1) vmin = fminf(vmin, v[i]); else vmin = fminf(vmin, v[i] == NEG_INF ? PINF : v[i]); }
    }
#pragma unroll
    for (int o = 32; o >= 1; o >>= 1) { vmax = fmaxf(vmax, __shfl_xor(vmax, o)); vmin = fminf(vmin, __shfl_xor(vmin, o)); }
    if (STG <= 1) { if (lane == 0) bmrow[0] = __float_as_uint(vmax + vmin); return; }
    float Tf; bool tiecut = false; int need_eq = 0;
    if (!(vmax > vmin)) { Tf = vmax; tiecut = true; }
    else {
        const float scale = (float)(TK_NB - 1) / (vmax - vmin);
        int bn[32];
#pragma unroll
        for (int q = 0; q < TK_NB / 64; ++q) hist[64 * q + lane] = 0u;
        __builtin_amdgcn_wave_barrier();
#pragma unroll
        for (int i = 0; i < 32; ++i) { bn[i] = TK_NB - 1;
            if (i < nch) { int b = (int)((vmax - v[i]) * scale); b = b > TK_NB - 1 ? TK_NB - 1 : b; bn[i] = b; atomicAdd(&hist[b], 1u); } }
        __builtin_amdgcn_wave_barrier();
        if (STG <= 2) { if (lane == 0) bmrow[0] = hist[3] + bn[7]; return; }
        unsigned hb[4]; unsigned sl = 0u;
#pragma unroll
        for (int q = 0; q < 4; ++q) { hb[q] = hist[4 * lane + q]; sl += hb[q]; }
        unsigned pre = sl;
#pragma unroll
        for (int o = 1; o < 64; o <<= 1) { const unsigned t = __shfl_up(pre, o); if (lane >= o) pre += t; }
        const unsigned long long ge = __ballot(pre >= 256u);
        const int Ls = __ffsll((long long)ge) - 1;
        int bstar = 4 * lane; unsigned abv = pre - sl;
        { unsigned cum = pre - sl; bool found = false;
#pragma unroll
          for (int q = 0; q < 4; ++q) { if (!found && cum + hb[q] >= 256u) { bstar = 4 * lane + q; abv = cum; found = true; } cum += hb[q]; } }
        bstar = __shfl(bstar, Ls); abv = __shfl(abv, Ls);
        const int need = 256 - (int)abv;
        const unsigned cntb = hist[bstar];
        __builtin_amdgcn_wave_barrier();
        if (STG <= 3) { if (lane == 0) bmrow[0] = cntb + need; return; }
        unsigned T;
        if (cntb > (unsigned)TK_NB) {
            T = 0u;
            for (int bit = 31; bit >= 0; --bit) {
                const unsigned cand = T | (1u << bit); int cnt = 0;
#pragma unroll
                for (int i = 0; i < 32; ++i) if (i < nch) cnt += __popcll(__ballot(ford(v[i]) >= cand));
                if (cnt >= 256) T = cand;
            }
            tiecut = true;
        } else {
            int base = 0;
            const unsigned long long lt = (1ull << lane) - 1ull;
#pragma unroll
            for (int i = 0; i < 32; ++i) if (i < nch) {
                const bool isb = bn[i] == bstar;
                const unsigned long long bal = __ballot(isb);
                if (bal) { if (isb) hist[base + __popcll(bal & lt)] = ford(v[i]); base += __popcll(bal); }
            }
            __builtin_amdgcn_wave_barrier();
            unsigned c[TK_NB / 64];
#pragma unroll
            for (int q = 0; q < TK_NB / 64; ++q) c[q] = (64 * q + lane < (int)cntb) ? hist[64 * q + lane] : 0u;
            const int ncq = ((int)cntb + 63) >> 6;
            T = 0u;
            for (int bit = 31; bit >= 0; --bit) {
                const unsigned cand = T | (1u << bit); int cnt = 0;
#pragma unroll
                for (int q = 0; q < TK_NB / 64; ++q) if (q < ncq) cnt += __popcll(__ballot(c[q] >= cand));
                if (cnt >= need) T = cand;
            }
            int cgt = 0, ceq = 0;
#pragma unroll
            for (int q = 0; q < TK_NB / 64; ++q) if (q < ncq) { cgt += __popcll(__ballot(c[q] > T)); ceq += __popcll(__ballot(c[q] == T)); }
            need_eq = need - cgt;
            tiecut = ceq != need_eq;
            __builtin_amdgcn_wave_barrier();
        }
        Tf = __uint_as_float(funord(T));
    }
    if (STG <= 4) { if (lane == 0) bmrow[0] = __float_as_uint(Tf) + (tiecut ? 1 : 0); return; }
    if (!tiecut) {
#pragma unroll
        for (int i = 0; i < 32; ++i) { unsigned long long sm = 0ull; if (i < nch) sm = __ballot(v[i] >= Tf);
            bmrow[2 * i] = (unsigned)sm; bmrow[2 * i + 1] = (unsigned)(sm >> 32); }
    } else {
        int ngt = 0;
#pragma unroll
        for (int i = 0; i < 32; ++i) if (i < nch) ngt += __popcll(__ballot(v[i] > Tf));
        const int need = 256 - ngt; int running = 0;
        const unsigned long long lt = (1ull << lane) - 1ull;
#pragma unroll
        for (int i = 0; i < 32; ++i) {
            unsigned long long sm = 0ull;
            if (i < nch) {
                const bool eq = v[i] == Tf; const unsigned long long bal = __ballot(eq);
                const int pre = running + __popcll(bal & lt);
                const bool sel = (v[i] > Tf) || (eq && pre < need);
                running += __popcll(bal);
                sm = __ballot(sel);
            }
            bmrow[2 * i] = (unsigned)sm; bmrow[2 * i + 1] = (unsigned)(sm >> 32);
        }
    }
}
DEV void dsa_index_unit(const Params& p, int b, int sb8, char* smem) {
    float* sc = (float*)smem;
    unsigned* hist = (unsigned*)(smem + 65536) + __builtin_amdgcn_readfirstlane(threadIdx.x >> 6) * TK_NB;
    int tid_ = threadIdx.x; OPAQUE_V(tid_); const int tid = tid_, lane = tid & 63, w = __builtin_amdgcn_readfirstlane(tid >> 6), r32 = lane & 31, h = lane >> 5;
    const bf16_t* H = (const bf16_t*)(p.ws + WS_H) + (size_t)b * S * HP;
    const float* IW = (const float*)(p.ws + WS_IW) + (size_t)b * S * 8;
    unsigned* BM = (unsigned*)(p.ws + WS_BM) + (size_t)b * S * 64;
    {
        const int ts = 8 * sb8, nkeys = ts + 8, nkt = ((nkeys + 63) >> 6) << 1;
        const int tl = 2 * ((r32 >> 2) & 1) + (r32 >> 4), head = ((r32 >> 3) & 1) * 4 + (r32 & 3);
        bf16x8 af[2][2]; f32x4 wv[2][4];
#pragma unroll
        for (int mt = 0; mt < 2; ++mt) {
#pragma unroll
            for (int ks = 0; ks < 2; ++ks) af[mt][ks] = *(const bf16x8*)(H + (size_t)(ts + 4 * mt + tl) * HP + C_IDXQ + 32 * head + 16 * ks + 8 * h);
#pragma unroll
            for (int a = 0; a < 4; ++a) wv[mt][a] = *(const f32x4*)(IW + (size_t)(ts + 4 * mt + 2 * h + (a >> 1)) * 8 + (a & 1) * 4);
        }
        bf16x8 bfn[2];
        if (w < nkt) {
#pragma unroll
            for (int ks = 0; ks < 2; ++ks) bfn[ks] = *(const bf16x8*)(H + (size_t)(32 * w + r32) * HP + C_IDXK + 16 * ks + 8 * h); }
        for (int kt = w; kt < nkt; kt += 4) {
            const int key = 32 * kt + r32;
            bf16x8 bf[2]; bf[0] = bfn[0]; bf[1] = bfn[1];
            if (kt + 4 < nkt) {
#pragma unroll
                for (int ks = 0; ks < 2; ++ks) bfn[ks] = *(const bf16x8*)(H + (size_t)(key + 128) * HP + C_IDXK + 16 * ks + 8 * h); }
#pragma unroll
            for (int mt = 0; mt < 2; ++mt) {
                f32x16 acc;
#pragma unroll
                for (int r = 0; r < 16; ++r) acc[r] = 0.f;
                acc = mfma(af[mt][0], bf[0], acc); acc = mfma(af[mt][1], bf[1], acc);
                float sA = 0.f, sB = 0.f;
#pragma unroll
                for (int a = 0; a < 2; ++a)
#pragma unroll
                    for (int k = 0; k < 4; ++k) { sA = fmaf(wv[mt][a][k], fmaxf(acc[4 * a + k], 0.f), sA); sB = fmaf(wv[mt][a + 2][k], fmaxf(acc[4 * (a + 2) + k], 0.f), sB); }
                const int rowA = 4 * mt + 2 * h, tokA = ts + rowA;
                sc[rowA * 2048 + key] = key <= tokA ? sA + 0.0f : NEG_INF;
                sc[(rowA + 1) * 2048 + key] = key <= tokA + 1 ? sB + 0.0f : NEG_INF;
            }
        }
        __syncthreads();
#pragma unroll 1
        for (int rr = 0; rr < 2; ++rr) { const int row = 2 * w + rr; topk_row<9>(sc + row * 2048, ts + row + 1, BM + (size_t)(ts + row) * 64, hist, lane); }
        __syncthreads();
    }
}
DEV void dsa_attn_unit(const Params& p, int b, int qb, char* smem) {
    char* ksm = smem; char* vsm = smem + KT_BYTES;
    unsigned* bm = (unsigned*)(smem + KT_BYTES + VT_BYTES);
    int tid_ = threadIdx.x; OPAQUE_V(tid_); const int tid = tid_, lane = tid & 63, w = __builtin_amdgcn_readfirstlane(tid >> 6), r32 = lane & 31, h = lane >> 5;
    const int t0 = qb * 32;
    const bf16_t* H = (const bf16_t*)(p.ws + WS_H) + (size_t)b * S * HP;
    {
        const unsigned* BM = (const unsigned*)(p.ws + WS_BM) + ((size_t)b * S + t0) * 64;
#pragma unroll
        for (int i = 0; i < 8; ++i) { const int e = tid + 256 * i; bm[(e >> 6) * BMP + (e & 63)] = BM[e]; }
    }
    const int tq = t0 + r32;
    bf16x8 qf[4]; load_qf(H + (size_t)tq * HP + C_DSAQ + 64 * w, h, qf);
    FlashSt st; flash_init(st);
    f32x16 negm; fill16(negm, 0.f);
    const int ntiles = ((t0 + 31) >> 6) + 1;
    KVRegs kvr; kv_load(kvr, H + C_DSAK, H + C_DSAV, HP, tid);
    for (int kt = 0; kt < ntiles; ++kt) {
        __syncthreads();
        kv_store(kvr, ksm, vsm, tid);
        __syncthreads();
        if (kt + 1 < ntiles) kv_load(kvr, H + (size_t)(kt + 1) * 64 * HP + C_DSAK, H + (size_t)(kt + 1) * 64 * HP + C_DSAV, HP, tid);
        f32x16 s0, s1; qk_tile_c(ksm, qf, r32, h, negm, negm, s0, s1);
        const unsigned w0 = bm[r32 * BMP + 2 * kt] >> (4 * h), w1 = bm[r32 * BMP + 2 * kt + 1] >> (4 * h);
#pragma unroll
        for (int r = 0; r < 16; ++r) { const int bit = (r & 3) + 8 * (r >> 2);
            s0[r] = ((w0 >> bit) & 1u) ? s0[r] : NEG_INF; s1[r] = ((w1 >> bit) & 1u) ? s1[r] : NEG_INF; }
        if (flash_lazy(s0, s1, st, vsm, lane)) fill16(negm, -st.mref);
    }
    float l = st.l; l += __shfl_xor(l, 32);
    const float inv = l > 0.f ? 1.0f / l : 0.f;
    f32x16 o0, o1;
#pragma unroll
    for (int r = 0; r < 16; ++r) { o0[r] = st.o0[r] * inv; o1[r] = st.o1[r] * inv; }
    write_mix(p, (size_t)b * S + tq, 64 * w, o0, o1, h);
    __syncthreads();
}

DEV void cmp_unit(const Params& p, int L, int kv, int b, int g, int cc, char* smem) {
    float* red = (float*)smem;
    float* hid = (float*)(smem + 32768);
    int tid_ = threadIdx.x; OPAQUE_V(tid_); const int tid = tid_, lane = tid & 63, w = __builtin_amdgcn_readfirstlane(tid >> 6), r32 = lane & 31, h = lane >> 5;
    const bf16_t* H = (const bf16_t*)(p.ws + WS_H) + (size_t)b * S * HP + (kv ? C_VC : C_KC) + 64 * g;
    const bf16_t* W1 = (const bf16_t*)(p.ws + WS_W1T) + (size_t)(L * 2 + kv) * 64 * W1P;
    const float* pe = p.cmp_pe + (size_t)(L * 2 + kv) * 32 * 64;
    int c = cc * 32 + r32; if (c > 126) c = 126;
    f32x16 acc[2];
#pragma unroll
    for (int r = 0; r < 16; ++r) { acc[0][r] = 0.f; acc[1][r] = 0.f; }
#pragma unroll 4
    for (int ks = w * 32; ks < w * 32 + 32; ++ks) {
        const int li = ks >> 2, d0 = (ks & 3) * 16 + 8 * h;
        const u32x4 raw = *(const u32x4*)(H + (size_t)(16 * c + li) * HP + d0);
        const f32x4 p0 = *(const f32x4*)(pe + li * 64 + d0), p1 = *(const f32x4*)(pe + li * 64 + d0 + 4);
        u32x4 t; t.x = cvt_pk(bf_lo(raw.x) + p0[0], bf_hi(raw.x) + p0[1]); t.y = cvt_pk(bf_lo(raw.y) + p0[2], bf_hi(raw.y) + p0[3]);
        t.z = cvt_pk(bf_lo(raw.z) + p1[0], bf_hi(raw.z) + p1[1]); t.w = cvt_pk(bf_lo(raw.w) + p1[2], bf_hi(raw.w) + p1[3]);
        const bf16x8 a = __builtin_bit_cast(bf16x8, t);
#pragma unroll
        for (int nt = 0; nt < 2; ++nt) { const bf16x8 bw = *(const bf16x8*)(W1 + (size_t)(32 * nt + r32) * W1P + 16 * ks + 8 * h); acc[nt] = mfma(a, bw, acc[nt]); }
    }
#pragma unroll
    for (int nt = 0; nt < 2; ++nt)
#pragma unroll
        for (int r = 0; r < 16; ++r) red[(w * 32 + crow(r, h)) * 64 + 32 * nt + r32] = acc[nt][r];
    __syncthreads();
#pragma unroll
    for (int i = 0; i < 8; ++i) { const int e = tid + 256 * i; const float v = red[e] + red[2048 + e] + red[4096 + e] + red[6144 + e]; hid[e] = v / (1.0f + __expf(-v)); }
    __syncthreads();
    {
        const int cl = tid >> 3, n2 = (tid & 7) * 8; const float* w2 = p.cmp_w2 + (size_t)(L * 2 + kv) * 64 * 64;
        float o[8];
#pragma unroll
        for (int e = 0; e < 8; ++e) o[e] = 0.f;
        for (int n = 0; n < 64; ++n) { const float hv = hid[cl * 64 + n]; const f32x4 wa = *(const f32x4*)(w2 + n * 64 + n2), wb = *(const f32x4*)(w2 + n * 64 + n2 + 4);
#pragma unroll
            for (int e = 0; e < 4; ++e) { o[e] = fmaf(hv, wa[e], o[e]); o[4 + e] = fmaf(hv, wb[e], o[4 + e]); } }
        const int cg_ = cc * 32 + cl;
        if (cg_ >= 127) {
#pragma unroll
            for (int e = 0; e < 8; ++e) o[e] = 0.f; }
        bf16_t* dst = (bf16_t*)(p.ws + (kv ? WS_VC : WS_KC)) + ((size_t)(b * 2 + g) * 128 + cg_) * 64 + n2;
        *(u32x4*)dst = pack8(o);
    }
    __syncthreads();
}

constexpr int KC_BYTES = 128 * KP * 2;
DEV void nsa_unit(const Params& p, int b, int g, int qb, int j, char* smem) {
    char* kcs = smem;
    char* vcs = smem + KC_BYTES;
    char* ksm = smem + KC_BYTES + 16384;
    char* vsm = ksm + KT_BYTES;
    float* scr = (float*)(vsm + VT_BYTES);
    unsigned* uni = (unsigned*)(scr + 4 * 32 * 33);
    int tid_ = threadIdx.x; OPAQUE_V(tid_); const int tid = tid_, lane = tid & 63, w = __builtin_amdgcn_readfirstlane(tid >> 6), r32 = lane & 31, h = lane >> 5;
    const int q0 = qb * 128, tq = q0 + 32 * w + r32;
    const bf16_t* H = (const bf16_t*)(p.ws + WS_H) + (size_t)b * S * HP;
    {
        const bf16_t* kc = (const bf16_t*)(p.ws + WS_KC) + (size_t)(b * 2 + g) * 128 * 64;
        const bf16_t* vc = (const bf16_t*)(p.ws + WS_VC) + (size_t)(b * 2 + g) * 128 * 64;
#pragma unroll
        for (int i = 0; i < 4; ++i) { const int c = tid + 256 * i, row = c >> 3, ch = c & 7;
            *(u32x4*)(kcs + (row * KP + ch * 8) * 2) = *(const u32x4*)(kc + row * 64 + ch * 8);
            *(u32x4*)(vcs + (ch >> 2) * 8192 + row * 64 + (ch & 3) * 16) = *(const u32x4*)(vc + row * 64 + ch * 8); }
    }
    __syncthreads();
    const int clim_ = tq >= 31 ? ((tq - 31) >> 4) : -1;
    const int climh = (clim_ > 126 ? 126 : clim_) - 4 * h;
    float B4[16], E[16];
#pragma unroll
    for (int i = 0; i < 16; ++i) { B4[i] = 0.f; E[i] = 0.f; }
#pragma unroll 1
    for (int jj = 0; jj < 3; ++jj) {
        bf16x8 qf[4]; load_qf(H + (size_t)tq * HP + C_NSAQ + 64 * (3 * g + jj), h, qf);
        float mrun = NEG_INF, lrun = 0.f;
#pragma unroll
        for (int n = 0; n < 4; ++n) {
            f32x16 st = qk32(kcs + n * 32 * KP * 2, qf, r32, h);
            float mx = NEG_INF;
            int lim = climh; OPAQUE_V(lim);
#pragma unroll
            for (int r = 0; r < 16; ++r) { st[r] = (32 * n + CR(r)) <= lim ? st[r] : NEG_INF; mx = fmaxf(mx, st[r]); }
            const float mn = fmaxf(mrun, mx), mu = mn == NEG_INF ? 0.f : mn;
            float ps = 0.f;
#pragma unroll
            for (int r = 0; r < 16; ++r) ps += fexp2(st[r] - mu);
            lrun = fmaf(lrun, fexp2(mrun - mu), ps); mrun = mn;
            __builtin_amdgcn_sched_barrier(0);
        }
        const float mo = __shfl_xor(mrun, 32), lo = __shfl_xor(lrun, 32);
        const float M = fmaxf(mrun, mo), Mu = M == NEG_INF ? 0.f : M;
        const float Lt = lrun * fexp2(mrun - Mu) + lo * fexp2(mo - Mu);
        const float inv = 1.0f / fmaxf(Lt, 1e-30f);
#pragma unroll
        for (int n = 0; n < 4; ++n) {
            f32x16 st = qk32(kcs + n * 32 * KP * 2, qf, r32, h);
            int lim = climh; OPAQUE_V(lim);
#pragma unroll
            for (int a = 0; a < 4; ++a) {
                float pr[4];
#pragma unroll
                for (int k = 0; k < 4; ++k) pr[k] = (32 * n + 8 * a + k) <= lim ? fexp2(st[4 * a + k] - Mu) * inv : 0.f;
                B4[4 * n + a] += (pr[0] + pr[1]) + (pr[2] + pr[3]); E[4 * n + a] += pr[3];
            }
            __builtin_amdgcn_sched_barrier(0);
        }
    }
    {
        float* my = scr + (w * 32 + r32) * 33;
#pragma unroll
        for (int i = 0; i < 16; ++i) { const float eo = __shfl_xor(E[i], 32); E[i] = eo; }
#pragma unroll
        for (int i = 0; i < 16; ++i) { const float prev = h ? E[i] : (i > 0 ? E[i - 1] : 0.f); my[2 * i + h] = B4[i] + prev; }
    }
    __builtin_amdgcn_wave_barrier();
    unsigned sel;
    {
        const float* my = scr + (w * 32 + r32) * 33; const int cur = tq >> 6;
        float v[32];
#pragma unroll
        for (int n = 0; n < 32; ++n) { float s_ = my[n]; const bool forced = (n == 0) || (n == cur) || (n == cur - 1); const bool fut = 64 * n > tq;
            v[n] = forced ? __builtin_huge_valf() : (fut ? NEG_INF : s_); }
        unsigned mk = 0u;
#pragma unroll
        for (int i = 0; i < 32; ++i) {
            int rank = 0;
#pragma unroll
            for (int n = 0; n < 32; ++n) { if (n < i) rank += (v[n] >= v[i]) ? 1 : 0; else if (n > i) rank += (v[n] > v[i]) ? 1 : 0; }
            if (rank < 16 && 64 * i <= tq) mk |= 1u << i;
        }
        sel = mk;
    }
    unsigned wsel = sel;
#pragma unroll
    for (int o = 16; o >= 1; o >>= 1) wsel |= __shfl_xor(wsel, o);
    if (lane == 0) uni[w] = wsel;
    __syncthreads();
    const unsigned bsel = uni[0] | uni[1] | uni[2] | uni[3];
    const float* gs = (const float*)(p.ws + WS_GSIG) + ((size_t)b * S + tq) * 20;
    const float g0 = gs[0 * 6 + g * 3 + j], g1 = gs[1 * 6 + g * 3 + j], g2 = gs[2 * 6 + g * 3 + j];
    f32x16 ot0, ot1;
    {
        bf16x8 qf[4]; load_qf(H + (size_t)tq * HP + C_NSAQ + 64 * (3 * g + j), h, qf);
        float m = NEG_INF, l = 0.f; f32x16 o0, o1;
#pragma unroll
        for (int r = 0; r < 16; ++r) { o0[r] = 0.f; o1[r] = 0.f; }
#pragma unroll 1
        for (int n = 0; n < 4; ++n) {
            f32x16 st = qk32(kcs + n * 32 * KP * 2, qf, r32, h);
            int lim = climh - 32 * n; OPAQUE_V(lim);
#pragma unroll
            for (int r = 0; r < 16; ++r) st[r] = CR(r) <= lim ? st[r] : NEG_INF;
            flash_update32(st, m, l, o0, o1, vcs, 32 * n, 8192, lane);
        }
        l += __shfl_xor(l, 32);
        const float sc_ = l > 0.f ? g0 / l : 0.f;
#pragma unroll
        for (int r = 0; r < 16; ++r) { ot0[r] = o0[r] * sc_; ot1[r] = o1[r] * sc_; }
    }
    bf16x8 qr[4]; load_qf((const bf16_t*)(p.ws + WS_QROT) + ((size_t)b * S + tq) * 384 + 64 * (3 * g + j), h, qr);
    {
        FlashSt st; flash_init(st);
        f32x16 negm; fill16(negm, 0.f);
        unsigned rem = bsel;
        KVRegs kvr; kv_load(kvr, H + C_KS + 64 * g, H + C_VS + 64 * g, HP, tid);
        const int wt0 = q0 + 32 * w;
        while (rem) {
            const int nb = __ffs(rem) - 1; rem &= rem - 1u;
            __syncthreads();
            kv_store(kvr, ksm, vsm, tid);
            __syncthreads();
            if (rem) { const int nx = __ffs(rem) - 1; kv_load(kvr, H + (size_t)nx * 64 * HP + C_KS + 64 * g, H + (size_t)nx * 64 * HP + C_VS + 64 * g, HP, tid); }
            if ((wsel >> nb) & 1u) {
                f32x16 s0, s1; qk_tile_c(ksm, qr, r32, h, negm, negm, s0, s1);
                int lim = ((sel >> nb) & 1u) ? tq - 64 * nb - 4 * h : -1; OPAQUE_V(lim);
#pragma unroll
                for (int r = 0; r < 16; ++r) { s0[r] = CR(r) <= lim ? s0[r] : NEG_INF; s1[r] = (CR(r) + 32) <= lim ? s1[r] : NEG_INF; }
                if (flash_lazy(s0, s1, st, vsm, lane)) fill16(negm, -st.mref);
            }
        }
        float l = st.l; l += __shfl_xor(l, 32);
        const float sc_ = l > 0.f ? g1 / l : 0.f;
#pragma unroll
        for (int r = 0; r < 16; ++r) { ot0[r] = fmaf(st.o0[r], sc_, ot0[r]); ot1[r] = fmaf(st.o1[r], sc_, ot1[r]); }
    }
    {
        FlashSt st; flash_init(st);
        f32x16 negm; fill16(negm, 0.f);
        const int kfirst = q0 >= 512 ? (q0 - 512) >> 6 : 0, klast = (q0 + 127) >> 6;
        const int wt0 = q0 + 32 * w;
        const int wfirst = wt0 >= 511 ? (wt0 - 511) >> 6 : 0, wlast = (wt0 + 31) >> 6;
        KVRegs kvr; kv_load(kvr, H + (size_t)kfirst * 64 * HP + C_KW + 64 * g, H + (size_t)kfirst * 64 * HP + C_VW + 64 * g, HP, tid);
        for (int kt = kfirst; kt <= klast; ++kt) {
            __syncthreads();
            kv_store(kvr, ksm, vsm, tid);
            __syncthreads();
            if (kt < klast) kv_load(kvr, H + (size_t)(kt + 1) * 64 * HP + C_KW + 64 * g, H + (size_t)(kt + 1) * 64 * HP + C_VW + 64 * g, HP, tid);
            if (kt >= wfirst && kt <= wlast) {
                f32x16 s0, s1; qk_tile_c(ksm, qr, r32, h, negm, negm, s0, s1);
                if (!(64 * kt + 63 <= wt0 && 64 * kt > wt0 + 31 - 512)) {
                    int lim = tq - 64 * kt - 4 * h; OPAQUE_V(lim);
#pragma unroll
                    for (int r = 0; r < 16; ++r) { s0[r] = (unsigned)(lim - CR(r)) < 512u ? s0[r] : NEG_INF; s1[r] = (unsigned)(lim - CR(r) - 32) < 512u ? s1[r] : NEG_INF; }
                }
                if (flash_lazy(s0, s1, st, vsm, lane)) fill16(negm, -st.mref);
            }
        }
        float l = st.l; l += __shfl_xor(l, 32);
        const float sc_ = l > 0.f ? g2 / l : 0.f;
#pragma unroll
        for (int r = 0; r < 16; ++r) { ot0[r] = fmaf(st.o0[r], sc_, ot0[r]); ot1[r] = fmaf(st.o1[r], sc_, ot1[r]); }
    }
    write_mix(p, (size_t)b * S + tq, 640 + 64 * (3 * g + j), ot0, ot1, h);
    __syncthreads();
}


#define XB_TMO      128
#define XB_XCNT(j)  (256  + 64 * (j))
#define XB_XSUB(j)  (1280 + 64 * (j))
#define XB_XGEN(j)  (2304 + 64 * (j))
#define XB_TOP      3328
#define XB_TOPGEN   3392
#define XCD_BAR_WORDS 3456
#define XB_SPIN_CAP (1u << 22)
DEV unsigned xb_ld(unsigned* p) { return __hip_atomic_load(p, __ATOMIC_RELAXED, __HIP_MEMORY_SCOPE_AGENT); }
DEV unsigned xb_add(unsigned* p, unsigned v) { return __hip_atomic_fetch_add(p, v, __ATOMIC_RELAXED, __HIP_MEMORY_SCOPE_AGENT); }
DEV unsigned xb_xcc_id() { return (unsigned)__builtin_amdgcn_s_getreg((3 << 11) | 20) & 0xFu; }
#define XB_SPIN(cond, bar) do { unsigned _sp = 0; while (cond) { __builtin_amdgcn_s_sleep(1); \
    if ((++_sp & 255u) == 0u) { if (xb_ld(&(bar)[XB_TMO])) break; if (_sp > XB_SPIN_CAP) { atomicAdd(&(bar)[XB_TMO], 1u); break; } } } } while (0)
struct XcdBarrier { unsigned* bar; unsigned x; volatile LDSAS unsigned* st; };
DEV XcdBarrier xcd_barrier_post(unsigned* bar, volatile LDSAS unsigned* st) {
    XcdBarrier b; b.bar = bar; b.x = xb_xcc_id(); b.st = st;
    if (threadIdx.x == 0) (void)xb_add(&bar[XB_XCNT(b.x)], 1u);
    return b;
}
DEV void xcd_barrier_complete(unsigned* bar, unsigned x, unsigned& nloc, unsigned& nx) {
    const unsigned G = gridDim.x * gridDim.y * gridDim.z;
    unsigned sum, cnt, mine, sp = 0u;
    for (;;) {
        sum = 0u; cnt = 0u; mine = 0u;
#pragma unroll
        for (unsigned j = 0; j < 16; ++j) { const unsigned c = xb_ld(&bar[XB_XCNT(j)]); sum += c; cnt += (c > 0u) ? 1u : 0u; mine = (j == x) ? c : mine; }
        if (sum == G) break;
        __builtin_amdgcn_s_sleep(1);
        if ((++sp & 255u) == 0u) { if (xb_ld(&bar[XB_TMO])) break; if (sp > XB_SPIN_CAP) { atomicAdd(&bar[XB_TMO], 1u); break; } }
    }
    nloc = mine > 0u ? mine : 1u; nx = cnt > 0u ? cnt : 1u;
}
DEV void xcd_barrier(const XcdBarrier& b) {
    asm volatile("s_waitcnt vmcnt(0)" ::: "memory");
    __syncthreads();
    if (threadIdx.x == 0) {
        unsigned* bar = b.bar;
        __builtin_amdgcn_s_waitcnt(0);
        unsigned nloc = b.st[0], nx = b.st[1];
        if (nloc == 0u) { xcd_barrier_complete(bar, b.x, nloc, nx); b.st[0] = nloc; b.st[1] = nx; }
        const unsigned old = xb_add(&bar[XB_XSUB(b.x)], 1u);
        const unsigned gen = old / nloc;
        if (old + 1u == (gen + 1u) * nloc) {
            __builtin_amdgcn_fence(__ATOMIC_RELEASE, "agent");
            asm volatile("s_waitcnt vmcnt(0)" ::: "memory");
            const unsigned og = xb_add(&bar[XB_TOP], 1u);
            const unsigned tg = og / nx;
            if (og + 1u == (tg + 1u) * nx) xb_add(&bar[XB_TOPGEN], 1u);
            else XB_SPIN(xb_ld(&bar[XB_TOPGEN]) == tg, bar);
            __builtin_amdgcn_fence(__ATOMIC_ACQUIRE, "agent");
            xb_add(&bar[XB_XGEN(b.x)], 1u);
            asm volatile("s_waitcnt vmcnt(0)" ::: "memory");
        } else {
            XB_SPIN(xb_ld(&bar[XB_XGEN(b.x)]) == gen, bar);
            __builtin_amdgcn_fence(__ATOMIC_ACQUIRE, "agent");
            asm volatile("s_waitcnt vmcnt(0)" ::: "memory");
        }
    }
    __syncthreads();
}
DEV int grab_unit(unsigned* ctr, char* smem) {
    volatile LDSAS unsigned* st = (volatile LDSAS unsigned*)(smem + SMEM_BYTES - 16);
    __syncthreads();
    if (threadIdx.x == 0) st[2] = __hip_atomic_fetch_add(ctr, 1u, __ATOMIC_RELAXED, __HIP_MEMORY_SCOPE_AGENT);
    __syncthreads();
    return (int)st[2];
}
DEV void phase_mid(const Params& p, int L, char* smem, unsigned* ctr, int tmask = 7) {
    constexpr int N_CMP = 128, N_FOX = 768, N_IDX = 2048;
    for (;;) {
        const int u = grab_unit(ctr, smem);
        if (u >= N_CMP + N_FOX + N_IDX) break;
        int v = u;
        if (v < N_CMP) { const int kv = v & 1, g = (v >> 1) & 1, cc = (v >> 2) & 3, b = v >> 4; if (tmask & 4) cmp_unit(p, L, kv, b, g, cc, smem); continue; }
        v -= N_CMP;
        if (v < N_FOX) { const int qb = 15 - v / 48, r = v % 48; if (tmask & 2) fox_unit(p, r / 6, r % 6, qb, smem); continue; }
        v -= N_FOX;
        { const int sb8 = 255 - (v >> 3), b = v & 7; if (tmask & 1) dsa_index_unit(p, b, sb8, smem); }
    }
}
DEV void phase_nsa(const Params& p, char* smem, unsigned* ctr) {
    for (;;) {
        const int u = grab_unit(ctr, smem);
        if (u >= 768 + 512) break;
        const int sI = 15 - u / 80, r = u % 80;
        if (r < 48) { const int b = r / 6, g = (r % 6) / 3, j = r % 3; nsa_unit(p, b, g, sI, j, smem); }
        else { const int r2 = r - 48, qb = 4 * sI + 3 - (r2 >> 3), b = r2 & 7; dsa_attn_unit(p, b, qb, smem); }
    }
}
#ifndef PHASE_MASK
#define PHASE_MASK 0xffff
#endif
DEV void run_phase(const Params& p, int ph, char* smem, int rep = 0) {
    unsigned* ctr = (unsigned*)(p.ws + WS_CTRL) + 3584 + 16 * (ph + 12 * rep);
    if (ph == 0) { if (PHASE_MASK & 1) phase_prep(p, smem); return; }
    if (ph == 1) { if (PHASE_MASK & 2) phase_u1(p, smem); return; }
    const int L = (ph - 2) / 5, k = (ph - 2) % 5;
    if (k == 0) { if (PHASE_MASK & 4) phase_gemm_in(p, L, smem); }
    else if (k == 1) { if (PHASE_MASK & 8) phase_mid(p, L, smem, ctr); }
    else if (k == 2) { if (PHASE_MASK & 16) phase_nsa(p, smem, ctr); }
    else if (k == 3) { if (PHASE_MASK & 32) phase_out(p, L, smem); }
    else { if (PHASE_MASK & 64) phase_ln(p, L); }
}
constexpr int N_PHASES = 12;

#ifndef REPEAT_KIND
#define REPEAT_KIND -1
#endif
DEV int phase_kind(int ph) { return ph < 2 ? ph : 2 + (ph - 2) % 5; }
template <bool COOP>
__global__ void __launch_bounds__(256, 2) mega(Params p, int ph_lo, int ph_hi) {
    extern __shared__ __attribute__((aligned(16))) char smem[];
    volatile LDSAS unsigned* st = (volatile LDSAS unsigned*)(smem + SMEM_BYTES - 16);
    XcdBarrier xb;
    if (COOP) {
        if (threadIdx.x == 0) { st[0] = 0u; st[1] = 0u; }
        __syncthreads();
        xb = xcd_barrier_post((unsigned*)(p.ws + WS_CTRL), st);
    }
    for (int ph = ph_lo; ph < ph_hi; ++ph) {
        run_phase(p, ph, smem);
        if (COOP) {
            if (REPEAT_KIND >= 0 && REPEAT_KIND < 7 && phase_kind(ph) == REPEAT_KIND) { xcd_barrier(xb); run_phase(p, ph, smem, 1); }
            if (REPEAT_KIND >= 7 && REPEAT_KIND <= 9 && phase_kind(ph) == 3) { xcd_barrier(xb); phase_mid(p, (ph - 2) / 5, smem, (unsigned*)(p.ws + WS_CTRL) + 3584 + 16 * (ph + 12), 1 << (REPEAT_KIND - 7)); }
            if (ph + 1 < ph_hi) xcd_barrier(xb);
        }
    }
}

#ifndef N_LAUNCH_MODE
#define N_LAUNCH_MODE 1
#endif

extern "C" void kernel_launch(void* const* d_in, const int* in_sizes, int n_in, void* d_out, int out_size, void* d_ws, size_t ws_size, hipStream_t stream) {
    static int grid = 0;
    if (grid == 0) {
        int dev = 0, cus = 0, per_cu = 0;
        hipGetDevice(&dev);
        hipDeviceGetAttribute(&cus, hipDeviceAttributeMultiprocessorCount, dev);
        hipFuncSetAttribute((const void*)mega<true>, hipFuncAttributeMaxDynamicSharedMemorySize, SMEM_BYTES);
        hipFuncSetAttribute((const void*)mega<false>, hipFuncAttributeMaxDynamicSharedMemorySize, SMEM_BYTES);
        hipOccupancyMaxActiveBlocksPerMultiprocessor(&per_cu, (const void*)mega<true>, 256, SMEM_BYTES);
        if (per_cu < 1) per_cu = 1;
        if (per_cu > 2) per_cu = 2;
        grid = cus * per_cu;
        if (ws_size < WS_END) { fprintf(stderr, "workspace too small: %zu < %zu\n", ws_size, (size_t)WS_END); grid = -1; }
    }
    if (grid < 0) return;
    Params p{};
    p.x = (const float*)d_in[0]; p.c = (const float*)d_in[1]; p.w_ada = (const float*)d_in[2]; p.b_ada = (const float*)d_in[3];
    p.w_in = (const float*)d_in[4]; p.b_f = (const float*)d_in[5]; p.cmp_pe = (const float*)d_in[6]; p.cmp_w1 = (const float*)d_in[7];
    p.cmp_w2 = (const float*)d_in[8]; p.w_out = (const float*)d_in[9]; p.ln_g = (const float*)d_in[10]; p.ln_b = (const float*)d_in[11];
    p.out = (float*)d_out; p.ws = (char*)d_ws;
    (void)hipMemsetAsync((char*)d_ws + WS_CTRL, 0, 16384, stream);
#if N_LAUNCH_MODE == 1
    hipLaunchKernelGGL(mega<true>, dim3(grid), dim3(256), SMEM_BYTES, stream, p, 0, N_PHASES);
#else
    for (int ph = 0; ph < N_PHASES; ++ph) hipLaunchKernelGGL(mega<false>, dim3(grid), dim3(256), SMEM_BYTES, stream, p, ph, ph + 1);
#endif
}
```

```cpp
#include <hip/hip_runtime.h>
#include <hip/hip_cooperative_groups.h>
#include <stdint.h>
#include <stdio.h>
namespace cg = cooperative_groups;

#define DEV __device__ __forceinline__
typedef unsigned short bf16_t;
typedef short bf16x8 __attribute__((ext_vector_type(8)));
typedef short s16x4 __attribute__((ext_vector_type(4)));
typedef float f32x16 __attribute__((ext_vector_type(16)));
typedef float f32x4 __attribute__((ext_vector_type(4)));
typedef float f32x2 __attribute__((ext_vector_type(2)));
typedef unsigned u32x4 __attribute__((ext_vector_type(4)));
typedef unsigned u32x2 __attribute__((ext_vector_type(2)));
typedef short v4i16_t __attribute__((ext_vector_type(4)));
#define LDSAS __attribute__((address_space(3)))

constexpr int NB = 8, S = 2048, DM = 1024, NTOK = NB * S;
constexpr int HP = 4160, UP = 1088, WP = 1088, ZP = 1088, W1P = 2112;
constexpr int C_DSAQ = 0, C_DSAK = 256, C_DSAV = 320, C_IDXQ = 384, C_IDXK = 640, C_MISC = 672, C_FOXQ = 704, C_FOXK = 1088, C_FOXV = 1472,
              C_NSAQ = 1856, C_KC = 2240, C_VC = 2368, C_KS = 2496, C_VS = 2624, C_KW = 2752, C_VW = 2880, C_GATE = 3008;
constexpr float LOG2E = 1.4426950408889634f;
constexpr float QS = 0.125f * LOG2E;
constexpr float ALPHA = 1.4142135623730951f;
constexpr float NEG_INF = -__builtin_huge_valf();

constexpr size_t WS_CTRL = 0;
constexpr size_t WS_MOD = 16384;
constexpr size_t WS_CS64 = WS_MOD + 2 * 8 * 3072 * 4;
constexpr size_t WS_CS32 = WS_CS64 + 2048 * 32 * 8;
constexpr size_t WS_WINT = WS_CS32 + 2048 * 16 * 8;
constexpr size_t WS_WOUTT = WS_WINT + (size_t)2 * 4096 * WP * 2;
constexpr size_t WS_W1T = WS_WOUTT + (size_t)2 * 1024 * WP * 2;
constexpr size_t WS_U = WS_W1T + (size_t)2 * 2 * 64 * W1P * 2;
constexpr size_t WS_MIX = WS_U + (size_t)NTOK * UP * 2;
constexpr size_t WS_QROT = WS_MIX + (size_t)NTOK * UP * 2;
constexpr size_t WS_IW = WS_QROT + (size_t)NTOK * 384 * 2;
constexpr size_t WS_GSIG = WS_IW + (size_t)NTOK * 8 * 4;
constexpr size_t WS_LOGF = WS_GSIG + (size_t)NTOK * 20 * 4;
constexpr size_t WS_KC = WS_LOGF + (size_t)8 * 6 * 2048 * 4;
constexpr size_t WS_VC = WS_KC + (size_t)8 * 2 * 128 * 64 * 2;
constexpr size_t WS_H = WS_VC + (size_t)8 * 2 * 128 * 64 * 2;
constexpr size_t WS_BM = WS_H + (size_t)NTOK * HP * 2;
constexpr size_t WS_END = WS_BM + (size_t)NTOK * 64 * 4;
static_assert(WS_END <= (size_t)256 * 1024 * 1024, "workspace");

constexpr int SMEM_BYTES = 78848;

struct Params {
    const float *x, *c, *w_ada, *b_ada, *w_in, *b_f, *cmp_pe, *cmp_w1, *cmp_w2, *w_out, *ln_g, *ln_b;
    float* out; char* ws;
};

#define OPAQUE_V(x) asm volatile("" : "+v"(x))
#define CR(r) (((r) & 3) + 8 * ((r) >> 2))
DEV int crow(int r, int h) { return (r & 3) + 8 * (r >> 2) + 4 * h; }
typedef __bf16 bf16x2_t __attribute__((ext_vector_type(2)));
DEV unsigned cvt_pk(float lo, float hi) { const f32x2 v = {lo, hi}; return __builtin_bit_cast(unsigned, __builtin_convertvector(v, bf16x2_t)); }
DEV float bf_lo(unsigned v) { return __uint_as_float(v << 16); }
DEV float bf_hi(unsigned v) { return __uint_as_float(v & 0xffff0000u); }
DEV f32x16 mfma(bf16x8 a, bf16x8 b, f32x16 c) { return __builtin_amdgcn_mfma_f32_32x32x16_bf16(a, b, c, 0, 0, 0); }
DEV float fexp2(float x) { return __builtin_amdgcn_exp2f(x); }
DEV s16x4 vtr(const char* p) { return __builtin_bit_cast(s16x4, __builtin_amdgcn_ds_read_tr16_b64_v4i16((LDSAS v4i16_t*)p)); }
DEV bf16x8 cat4(s16x4 a, s16x4 b) { bf16x8 r; r[0] = a[0]; r[1] = a[1]; r[2] = a[2]; r[3] = a[3]; r[4] = b[0]; r[5] = b[1]; r[6] = b[2]; r[7] = b[3]; return r; }
DEV u32x4 pack8(const float* v) { u32x4 r; r.x = cvt_pk(v[0], v[1]); r.y = cvt_pk(v[2], v[3]); r.z = cvt_pk(v[4], v[5]); r.w = cvt_pk(v[6], v[7]); return r; }
DEV float sigmoidf_(float v) { return 1.0f / (1.0f + __expf(-v)); }

DEV void sincos_acc(float a, float& sn, float& cs) {
    const float q = rintf(a * 0.6366197723675814f);
    float y = fmaf(-q, 1.5703125f, a); y = fmaf(-q, 4.837512969970703125e-4f, y); y = fmaf(-q, 7.54978995489188216e-8f, y);
    const float z = y * y;
    const float sp = y + y * z * (-1.6666654611e-1f + z * (8.3321608736e-3f + z * (-1.9515295891e-4f)));
    const float cp = 1.0f + z * (-0.5f + z * (4.166664568298827e-2f + z * (-1.388731625493765e-3f + z * 2.443315711809948e-5f)));
    const int qi = ((int)q) & 3;
    sn = (qi == 0) ? sp : (qi == 1) ? cp : (qi == 2) ? -sp : -cp;
    cs = (qi == 0) ? cp : (qi == 1) ? -sp : (qi == 2) ? -cp : sp;
}

DEV int win_srccol(int n) {
    if (n < 672) return n;
    if (n < 704) { const int j = n - 672; return j < 8 ? 672 + j : (j < 14 ? 1832 + (j - 8) : 2990 + (j - 14)); }
    if (n < 1856) return 680 + (n - 704);
    if (n < 3008) return 1838 + (n - 1856);
    if (n < 4032) return n;
    return -1;
}
DEV void transpose_unit(const float* __restrict__ src, int ldsrc, bf16_t* __restrict__ dst, int ldd, int n0, int k0, bool winmap, char* smem) {
    float* t = (float*)smem;
    int tid_ = threadIdx.x; OPAQUE_V(tid_); const int tid = tid_;
    {
        const int nn = tid & 63, n = n0 + nn; const int sc = winmap ? win_srccol(n) : n;
#pragma unroll
        for (int i = 0; i < 16; ++i) { const int kk = (tid >> 6) + 4 * i; t[kk * 65 + nn] = sc >= 0 ? src[(size_t)(k0 + kk) * ldsrc + sc] : 0.f; }
    }
    __syncthreads();
    {
        const int nn = tid >> 2, kq = tid & 3; float v[16];
#pragma unroll
        for (int j = 0; j < 16; ++j) v[j] = t[(kq * 16 + j) * 65 + nn];
        u32x4* d = (u32x4*)(dst + (size_t)(n0 + nn) * ldd + k0 + kq * 16);
        d[0] = pack8(v); d[1] = pack8(v + 8);
    }
    __syncthreads();
}
DEV void mod_unit(const Params& p, int L, int cgi, char* smem) {
    float* cs = (float*)smem;
    float* red = (float*)(smem + 32768);
    int tid_ = threadIdx.x; OPAQUE_V(tid_); const int tid = tid_;
#pragma unroll
    for (int i = 0; i < 32; ++i) cs[tid + 256 * i] = p.c[tid + 256 * i];
    __syncthreads();
    const int cc = tid & 31, kk = tid >> 5, col = cgi * 32 + cc;
    float acc[8];
#pragma unroll
    for (int b = 0; b < 8; ++b) acc[b] = 0.f;
    const float* w = p.w_ada + ((size_t)L * 1024 + kk * 128) * 3072 + col;
#pragma unroll 8
    for (int k = 0; k < 128; ++k) {
        const float wv = w[(size_t)k * 3072];
#pragma unroll
        for (int b = 0; b < 8; ++b) acc[b] = fmaf(cs[b * 1024 + kk * 128 + k], wv, acc[b]);
    }
#pragma unroll
    for (int b = 0; b < 8; ++b) red[(kk * 8 + b) * 32 + cc] = acc[b];
    __syncthreads();
    {
        const int b = tid >> 5; float s = p.b_ada[L * 3072 + col];
#pragma unroll
        for (int k2 = 0; k2 < 8; ++k2) s += red[(k2 * 8 + b) * 32 + cc];
        ((float*)(p.ws + WS_MOD))[(L * 8 + b) * 3072 + col] = s;
    }
    __syncthreads();
}
DEV void phase_prep(const Params& p, char* smem) {
    constexpr int N_MOD = 192, N_TAB = 0, N_WIN = 1024;
    constexpr int TOT = N_MOD + N_TAB + N_WIN;
    for (int u = blockIdx.x; u < TOT; u += gridDim.x) {
        int v = u;
        if (v < N_MOD) { mod_unit(p, v / 96, v % 96, smem); continue; }
        v -= N_MOD;
        if (v < N_TAB) {
            int tx_ = threadIdx.x; OPAQUE_V(tx_); const int idx = v * 256 + tx_;
            if (idx < 65536) {
                const int pos = idx >> 5, i = idx & 31; const float inv = powf(10000.0f, -(float)i / 32.0f);
                float sn, cs; sincos_acc((float)pos * inv, sn, cs);
                ((f32x2*)(p.ws + WS_CS64))[idx] = (f32x2){cs, sn};
            } else {
                const int id2 = idx - 65536; const int pos = id2 >> 4, i = id2 & 15; const float inv = powf(10000.0f, -(float)i / 16.0f);
                float sn, cs; sincos_acc((float)pos * inv, sn, cs);
                ((f32x2*)(p.ws + WS_CS32))[id2] = (f32x2){cs, sn};
            }
            continue;
        }
        v -= N_TAB;
        { const int nt = v >> 4, kt = v & 15;
            transpose_unit(p.w_in, 4032, (bf16_t*)(p.ws + WS_WINT), WP, nt * 64, kt * 64, true, smem); }
    }
}
DEV void prep_late_unit(const Params& p, int v, char* smem) {
    if (v < 1024) { const int nt = v >> 4, kt = v & 15;
        transpose_unit(p.w_in + (size_t)1024 * 4032, 4032, (bf16_t*)(p.ws + WS_WINT) + (size_t)4096 * WP, WP, nt * 64, kt * 64, true, smem); return; }
    v -= 1024;
    if (v < 512) { const int L = v >> 8, r = v & 255, nt = r >> 4, kt = r & 15;
        transpose_unit(p.w_out + (size_t)L * 1024 * 1024, 1024, (bf16_t*)(p.ws + WS_WOUTT) + (size_t)L * 1024 * WP, WP, nt * 64, kt * 64, false, smem); return; }
    v -= 512;
    { const int lk = v >> 5, kt = v & 31;
        transpose_unit(p.cmp_w1 + (size_t)lk * 2048 * 64, 64, (bf16_t*)(p.ws + WS_W1T) + (size_t)lk * 64 * W1P, W1P, 0, kt * 64, false, smem); }
}
DEV void phase_u1(const Params& p, char* smem) {
    const float* mod = (const float*)(p.ws + WS_MOD);
    bf16_t* U = (bf16_t*)(p.ws + WS_U);
    for (int u0 = blockIdx.x; u0 < 2048 + 1664; u0 += gridDim.x) {
        if (u0 >= 2048) { prep_late_unit(p, u0 - 2048, smem); continue; }
        const int u = u0;
        int tx_ = threadIdx.x; OPAQUE_V(tx_);
#pragma unroll
        for (int i = 0; i < 4; ++i) {
            const int e = tx_ + 256 * i, row = 8 * u + (e >> 7), c8 = (e & 127) * 8, b = row >> 11;
            const f32x4* xp = (const f32x4*)(p.x + (size_t)row * 1024 + c8);
            const f32x4* sh = (const f32x4*)(mod + (size_t)b * 3072 + c8);
            const f32x4* sc = (const f32x4*)(mod + (size_t)b * 3072 + 1024 + c8);
            float v[8];
#pragma unroll
            for (int q = 0; q < 2; ++q) { const f32x4 xv = xp[q], s1 = sc[q], s0 = sh[q];
#pragma unroll
                for (int k = 0; k < 4; ++k) v[4 * q + k] = fmaf(xv[k], 1.0f + s1[k], s0[k]); }
            *(u32x4*)(U + (size_t)row * UP + c8) = pack8(v);
        }
    }
}

constexpr int KP = 72, CTP = 132;
constexpr int GST = 24576;
DEV void gemm_kloop(const bf16_t* __restrict__ X, int ldx, const bf16_t* __restrict__ W, int ldw, int K, int m0, int n0, char* smem, f32x16 (&acc)[2][4], int tid) {
    const int lane = tid & 63, w = __builtin_amdgcn_readfirstlane(tid >> 6), wm = w >> 1, wn = w & 1, r32 = lane & 31, h = lane >> 5;
    const bf16_t* xg[4]; const bf16_t* wg[2];
#pragma unroll
    for (int i = 0; i < 4; ++i) { const int row = 16 * (4 * w + i) + (lane >> 2), kc = (lane & 3) ^ ((row >> 2) & 3); xg[i] = X + (size_t)(m0 + row) * ldx + kc * 8; }
#pragma unroll
    for (int i = 0; i < 2; ++i) { const int row = 16 * (2 * w + i) + (lane >> 2), kc = (lane & 3) ^ ((row >> 2) & 3); wg[i] = W + (size_t)(n0 + row) * ldw + kc * 8; }
#define GEMM_STAGE(kt, stb) do { \
        _Pragma("unroll") for (int i = 0; i < 4; ++i) __builtin_amdgcn_global_load_lds((const unsigned*)(xg[i] + (kt) * 32), (LDSAS unsigned*)(smem + (stb) + (4 * w + i) * 1024), 16, 0, 0); \
        _Pragma("unroll") for (int i = 0; i < 2; ++i) __builtin_amdgcn_global_load_lds((const unsigned*)(wg[i] + (kt) * 32), (LDSAS unsigned*)(smem + (stb) + 16384 + (2 * w + i) * 1024), 16, 0, 0); } while (0)
#pragma unroll
    for (int i = 0; i < 2; ++i)
#pragma unroll
        for (int j = 0; j < 4; ++j)
#pragma unroll
            for (int r = 0; r < 16; ++r) acc[i][j][r] = 0.f;
    const int nk = K / 32;
    int offA[2], offB[4];
#pragma unroll
    for (int i = 0; i < 2; ++i) { const int ra = wm * 64 + 32 * i + r32; offA[i] = 16384 + ra * 64 + ((h ^ ((ra >> 2) & 3)) << 4); }
#pragma unroll
    for (int j = 0; j < 4; ++j) { const int rb = wn * 128 + 32 * j + r32; offB[j] = rb * 64 + ((h ^ ((rb >> 2) & 3)) << 4); }
    GEMM_STAGE(0, 0); GEMM_STAGE(1, GST);
    int cur = 0, nxt = 2 * GST;
    for (int kt = 0; kt < nk; ++kt) {
        if (kt + 1 < nk) asm volatile("s_waitcnt vmcnt(6)" ::: "memory");
        else asm volatile("s_waitcnt vmcnt(0)" ::: "memory");
        __builtin_amdgcn_s_barrier();
        asm volatile("" ::: "memory");
        const char* st = smem + cur;
        bf16x8 a0[2], b0[4], a1[2], b1[4];
#pragma unroll
        for (int i = 0; i < 2; ++i) a0[i] = *(const bf16x8*)(st + offA[i]);
#pragma unroll
        for (int j = 0; j < 4; ++j) b0[j] = *(const bf16x8*)(st + offB[j]);
#pragma unroll
        for (int i = 0; i < 2; ++i) a1[i] = *(const bf16x8*)(st + (offA[i] ^ 32));
#pragma unroll
        for (int j = 0; j < 4; ++j) b1[j] = *(const bf16x8*)(st + (offB[j] ^ 32));
        __builtin_amdgcn_sched_barrier(0);
        const bool more = kt + 2 < nk;
        if (more) {
#pragma unroll
            for (int i = 0; i < 3; ++i) __builtin_amdgcn_global_load_lds((const unsigned*)(xg[i] + (kt + 2) * 32), (LDSAS unsigned*)(smem + nxt + (4 * w + i) * 1024), 16, 0, 0);
        }
        __builtin_amdgcn_sched_barrier(0);
#pragma unroll
        for (int i = 0; i < 2; ++i)
#pragma unroll
            for (int j = 0; j < 4; ++j) acc[i][j] = mfma(a0[i], b0[j], acc[i][j]);
        __builtin_amdgcn_sched_barrier(0);
        if (more) {
            __builtin_amdgcn_global_load_lds((const unsigned*)(xg[3] + (kt + 2) * 32), (LDSAS unsigned*)(smem + nxt + (4 * w + 3) * 1024), 16, 0, 0);
#pragma unroll
            for (int i = 0; i < 2; ++i) __builtin_amdgcn_global_load_lds((const unsigned*)(wg[i] + (kt + 2) * 32), (LDSAS unsigned*)(smem + nxt + 16384 + (2 * w + i) * 1024), 16, 0, 0);
        }
        __builtin_amdgcn_sched_barrier(0);
#pragma unroll
        for (int i = 0; i < 2; ++i)
#pragma unroll
            for (int j = 0; j < 4; ++j) acc[i][j] = mfma(a1[i], b1[j], acc[i][j]);
        nxt = cur; cur = cur == 2 * GST ? 0 : cur + GST;
    }
#undef GEMM_STAGE
    __syncthreads();
}

constexpr int CSP = 136;
DEV float silu_fast(float a) { return a * __builtin_amdgcn_rcpf(1.0f + fexp2(-LOG2E * a)); }
DEV void cs_store4(bf16_t* Cs, int row, int col, float a, float b, float c, float d) { u32x2 v; v.x = cvt_pk(a, b); v.y = cvt_pk(c, d); *(u32x2*)(Cs + row * CSP + col) = v; }
DEV void cs_flush(const bf16_t* Cs, bf16_t* dst, size_t ldd, int tid) {
#pragma unroll
    for (int it = 0; it < 16; ++it) { const int row = (tid >> 4) + 16 * it, ch = tid & 15;
        *(u32x4*)(dst + (size_t)row * ldd + ch * 8) = *(const u32x4*)(Cs + row * CSP + ch * 8); }
}
DEV float irev(int i, float c) { return fexp2(-(float)i * c) * 0.15915494309189535f; }
DEV void rope_sc(float rev, float& sn, float& cs) { const float f = __builtin_amdgcn_fractf(rev); sn = __builtin_amdgcn_sinf(f); cs = __builtin_amdgcn_cosf(f); }
DEV void phase_gemm_in(const Params& p, int L, char* smem) {
    const bf16_t* U = (const bf16_t*)(p.ws + WS_U);
    const bf16_t* W = (const bf16_t*)(p.ws + WS_WINT) + (size_t)L * 4096 * WP;
    bf16_t* H = (bf16_t*)(p.ws + WS_H);
    bf16_t* Cs = (bf16_t*)smem;
    const int VGRID_ = gridDim.x;
    for (int u = blockIdx.x; u < 2048; u += gridDim.x) {
        int tid_ = threadIdx.x; OPAQUE_V(tid_); const int tid = tid_;
        const int lane = tid & 63, w = __builtin_amdgcn_readfirstlane(tid >> 6), wm = w >> 1, wn = w & 1, r32 = lane & 31, h = lane >> 5;
        const int mt = u >> 5, nt = ((u & 31) + 8 * (u / (int)VGRID_)) & 31, m0 = mt * 256, c64 = 2 * nt + wm;
        f32x16 acc[2][4];
        gemm_kloop(U, UP, W, WP, 1024, m0, nt * 128, smem, acc, tid);
        const bool is_rope64 = c64 <= 4 || (c64 >= 29 && c64 <= 34) || c64 == 39 || c64 == 40 || c64 == 43 || c64 == 44;
        const bool is_nsaq = c64 >= 29 && c64 <= 34;
#pragma unroll
        for (int j = 0; j < 4; ++j) {
            const int trow = 128 * wn + 32 * j + r32, token = m0 + trow, pos = token & 2047;
            f32x16& A0 = acc[0][j]; f32x16& A1 = acc[1][j];
            if (is_rope64) {
                if (is_nsaq) {
#pragma unroll
                    for (int r = 0; r < 16; ++r) { A0[r] *= QS; A1[r] *= QS; }
                } else {
                    const float sc = c64 <= 3 ? QS : 1.0f, posf = (float)pos;
#pragma unroll
                    for (int a = 0; a < 4; ++a)
#pragma unroll
                        for (int k = 0; k < 4; ++k) { float sn_, cs_; rope_sc(posf * irev(8 * a + 4 * h + k, 13.287712379549449f / 32.0f), sn_, cs_);
                            const float x1 = A0[4 * a + k], x2 = A1[4 * a + k];
                            A0[4 * a + k] = (x1 * cs_ - x2 * sn_) * sc; A1[4 * a + k] = (x1 * sn_ + x2 * cs_) * sc; }
                }
            } else if ((c64 >= 6 && c64 <= 10)) {
                const float posf = (float)pos;
#pragma unroll
                for (int a = 0; a < 2; ++a)
#pragma unroll
                    for (int k = 0; k < 4; ++k) {
                        float sn_, cs_; rope_sc(posf * irev(8 * a + 4 * h + k, 13.287712379549449f / 16.0f), sn_, cs_);
                        { const float x1 = A0[4 * a + k], x2 = A0[4 * (a + 2) + k]; A0[4 * a + k] = x1 * cs_ - x2 * sn_; A0[4 * (a + 2) + k] = x1 * sn_ + x2 * cs_; }
                        if (c64 != 10) { const float x1 = A1[4 * a + k], x2 = A1[4 * (a + 2) + k]; A1[4 * a + k] = x1 * cs_ - x2 * sn_; A1[4 * (a + 2) + k] = x1 * sn_ + x2 * cs_; }
                    }
                if (c64 == 10) {
                    const int b = token >> 11;
                    float* iw = (float*)(p.ws + WS_IW) + (size_t)token * 8 + 4 * h;
                    *(f32x4*)iw = (f32x4){A1[0], A1[1], A1[2], A1[3]} * 0.35355339059327373f;
                    float* lf = (float*)(p.ws + WS_LOGF) + (size_t)b * 6 * 2048 + pos; float* gs = (float*)(p.ws + WS_GSIG) + (size_t)token * 20;
#pragma unroll
                    for (int a = 1; a < 4; ++a)
#pragma unroll
                        for (int k = 0; k < 4; ++k) {
                            const int f = 8 * a + k;
                            const float v = A1[4 * a + k];
                            if (a == 1) {
                                if (h == 0 || k < 2) { const int e = 4 * h + k; const float x = v + p.b_f[L * 6 + e]; lf[(size_t)e * 2048] = fminf(x, 0.f) - 0.6931471805599453f * __builtin_amdgcn_logf(1.0f + fexp2(-LOG2E * fabsf(x))); }
                                else gs[k - 2] = __builtin_amdgcn_rcpf(1.0f + fexp2(-LOG2E * v));
                            } else gs[f + 4 * h - 14] = __builtin_amdgcn_rcpf(1.0f + fexp2(-LOG2E * v));
                        }
                }
            } else {
                const bool isq = (c64 >= 11 && c64 <= 16), silu = c64 >= 47;
#pragma unroll
                for (int r = 0; r < 16; ++r) {
                    if (silu) { A0[r] = silu_fast(A0[r]); A1[r] = silu_fast(A1[r]); }
                    else if (isq) { A0[r] *= QS; A1[r] *= QS; }
                }
            }
#pragma unroll
            for (int a = 0; a < 4; ++a) {
                cs_store4(Cs, trow, 64 * wm + 8 * a + 4 * h, A0[4 * a], A0[4 * a + 1], A0[4 * a + 2], A0[4 * a + 3]);
                cs_store4(Cs, trow, 64 * wm + 32 + 8 * a + 4 * h, A1[4 * a], A1[4 * a + 1], A1[4 * a + 2], A1[4 * a + 3]);
            }
        }
        __syncthreads();
        cs_flush(Cs, H + (size_t)m0 * HP + nt * 128, HP, tid);
        if (nt >= 14 && nt <= 17) {
            __syncthreads();
            if (is_nsaq) {
#pragma unroll
                for (int j = 0; j < 4; ++j) { const int trow = 128 * wn + 32 * j + r32, pos = (m0 + trow) & 2047;
                    const f32x16& A0 = acc[0][j]; const f32x16& A1 = acc[1][j];
                    const float posf = (float)pos;
#pragma unroll
                    for (int a = 0; a < 4; ++a) {
                        float o1[4], o2[4];
#pragma unroll
                        for (int k = 0; k < 4; ++k) { float sn_, cs_; rope_sc(posf * irev(8 * a + 4 * h + k, 13.287712379549449f / 32.0f), sn_, cs_);
                            const float x1 = A0[4 * a + k], x2 = A1[4 * a + k]; o1[k] = x1 * cs_ - x2 * sn_; o2[k] = x1 * sn_ + x2 * cs_; }
                        cs_store4(Cs, trow, 64 * wm + 8 * a + 4 * h, o1[0], o1[1], o1[2], o1[3]);
                        cs_store4(Cs, trow, 64 * wm + 32 + 8 * a + 4 * h, o2[0], o2[1], o2[2], o2[3]);
                    } }
            }
            __syncthreads();
            bf16_t* QR = (bf16_t*)(p.ws + WS_QROT);
#pragma unroll
            for (int it = 0; it < 16; ++it) { const int row = (tid >> 4) + 16 * it, ch = tid & 15; const int cc = 2 * nt + (ch >> 3);
                if (cc >= 29 && cc <= 34) *(u32x4*)(QR + (size_t)(m0 + row) * 384 + (cc - 29) * 64 + (ch & 7) * 8) = *(const u32x4*)(Cs + row * CSP + ch * 8); }
        }
        __syncthreads();
    }
}
DEV void phase_out(const Params& p, int L, char* smem) {
    const bf16_t* A = (const bf16_t*)(p.ws + WS_MIX);
    const bf16_t* W = (const bf16_t*)(p.ws + WS_WOUTT) + (size_t)L * 1024 * WP;
    bf16_t* Z = (bf16_t*)(p.ws + WS_H);
    const float* mod = (const float*)(p.ws + WS_MOD) + (size_t)L * 8 * 3072;
    bf16_t* Cs = (bf16_t*)smem;
    for (int u = blockIdx.x; u < 512; u += gridDim.x) {
        int tid_ = threadIdx.x; OPAQUE_V(tid_); const int tid = tid_;
        const int lane = tid & 63, w = __builtin_amdgcn_readfirstlane(tid >> 6), wm = w >> 1, wn = w & 1, r32 = lane & 31, h = lane >> 5;
        const int mt = u >> 3, nt = u & 7, m0 = mt * 256, n0 = nt * 128, b = m0 >> 11;
        f32x16 acc[2][4];
        gemm_kloop(A, UP, W, WP, 1024, m0, n0, smem, acc, tid);
        f32x4 g1[2][4];
#pragma unroll
        for (int i = 0; i < 2; ++i)
#pragma unroll
            for (int a = 0; a < 4; ++a) g1[i][a] = *(const f32x4*)(mod + (size_t)b * 3072 + 2048 + n0 + 64 * wm + 32 * i + 8 * a + 4 * h) + 1.0f;
#pragma unroll
        for (int j = 0; j < 4; ++j) { const int trow = 128 * wn + 32 * j + r32;
#pragma unroll
            for (int i = 0; i < 2; ++i)
#pragma unroll
                for (int a = 0; a < 4; ++a) cs_store4(Cs, trow, 64 * wm + 32 * i + 8 * a + 4 * h, acc[i][j][4 * a] * g1[i][a][0], acc[i][j][4 * a + 1] * g1[i][a][1], acc[i][j][4 * a + 2] * g1[i][a][2], acc[i][j][4 * a + 3] * g1[i][a][3]);
        }
        __syncthreads();
        cs_flush(Cs, Z + (size_t)m0 * ZP + n0, ZP, tid);
        __syncthreads();
    }
}
DEV void phase_ln(const Params& p, int L) {
    const bf16_t* Z = (const bf16_t*)(p.ws + WS_H);
    const float* xin = L == 0 ? p.x : p.out;
    const float* mod = (const float*)(p.ws + WS_MOD) + (size_t)8 * 3072;
    bf16_t* U = (bf16_t*)(p.ws + WS_U);
    for (int u = blockIdx.x; u < 1024; u += gridDim.x) {
        int tx_ = threadIdx.x; OPAQUE_V(tx_);
        const int lane = tx_ & 63, w = __builtin_amdgcn_readfirstlane(tx_ >> 6);
        for (int rr = 0; rr < 4; ++rr) {
            const int row = u * 16 + w * 4 + rr, b = row >> 11;
            f32x4 v[4]; float s = 0.f;
#pragma unroll
            for (int i = 0; i < 4; ++i) { const f32x4 xv = *(const f32x4*)(xin + (size_t)row * 1024 + 256 * i + 4 * lane);
                const u32x2 zz = *(const u32x2*)(Z + (size_t)row * ZP + 256 * i + 4 * lane);
                v[i] = (f32x4){bf_lo(zz.x), bf_hi(zz.x), bf_lo(zz.y), bf_hi(zz.y)} + ALPHA * xv; s += (v[i][0] + v[i][1]) + (v[i][2] + v[i][3]); }
#pragma unroll
            for (int o = 32; o >= 1; o >>= 1) s += __shfl_xor(s, o);
            const float mean = s * (1.0f / 1024.0f); float q = 0.f;
#pragma unroll
            for (int i = 0; i < 4; ++i)
#pragma unroll
                for (int k = 0; k < 4; ++k) { const float d = v[i][k] - mean; q = fmaf(d, d, q); }
#pragma unroll
            for (int o = 32; o >= 1; o >>= 1) q += __shfl_xor(q, o);
            const float rstd = rsqrtf(q * (1.0f / 1024.0f) + 1e-5f);
#pragma unroll
            for (int i = 0; i < 4; ++i) {
                const int col = 256 * i + 4 * lane;
                const f32x4 g = *(const f32x4*)(p.ln_g + L * 1024 + col), bb = *(const f32x4*)(p.ln_b + L * 1024 + col);
                f32x4 o;
#pragma unroll
                for (int k = 0; k < 4; ++k) o[k] = (v[i][k] - mean) * rstd * g[k] + bb[k];
                *(f32x4*)(p.out + (size_t)row * 1024 + col) = o;
                if (L == 0) {
                    const f32x4 sh = *(const f32x4*)(mod + (size_t)b * 3072 + col), sc = *(const f32x4*)(mod + (size_t)b * 3072 + 1024 + col);
                    u32x2 pk; pk.x = cvt_pk(fmaf(o[0], 1.0f + sc[0], sh[0]), fmaf(o[1], 1.0f + sc[1], sh[1])); pk.y = cvt_pk(fmaf(o[2], 1.0f + sc[2], sh[2]), fmaf(o[3], 1.0f + sc[3], sh[3]));
                    *(u32x2*)(U + (size_t)row * UP + col) = pk;
                }
            }
        }
    }
}

constexpr int KT_BYTES = 64 * KP * 2, VT_BYTES = 8192;
struct KVRegs { u32x4 k[2], v[2]; };
DEV void kv_load(KVRegs& r, const bf16_t* __restrict__ kg, const bf16_t* __restrict__ vg, size_t pitch, int tid) {
#pragma unroll
    for (int i = 0; i < 2; ++i) { const int c = tid + 256 * i, row = c >> 3, ch = c & 7;
        r.k[i] = *(const u32x4*)(kg + (size_t)row * pitch + ch * 8); r.v[i] = *(const u32x4*)(vg + (size_t)row * pitch + ch * 8); }
}
DEV void kv_store(const KVRegs& r, char* ksm, char* vsm, int tid) {
#pragma unroll
    for (int i = 0; i < 2; ++i) { const int c = tid + 256 * i, row = c >> 3, ch = c & 7;
        *(u32x4*)(ksm + (row * KP + ch * 8) * 2) = r.k[i];
        *(u32x4*)(vsm + (ch >> 2) * 4096 + row * 64 + (ch & 3) * 16) = r.v[i]; }
}
DEV void load_qf(const bf16_t* q  , int h, bf16x8* qf) {
#pragma unroll
    for (int s = 0; s < 4; ++s) qf[s] = *(const bf16x8*)(q + 16 * s + 8 * h);
}
DEV void qk_tile(const char* ksm, const bf16x8* qf, int r32, int h, f32x16& s0, f32x16& s1) {
#pragma unroll
    for (int r = 0; r < 16; ++r) { s0[r] = 0.f; s1[r] = 0.f; }
#pragma unroll
    for (int s = 0; s < 4; ++s) {
        const bf16x8 a0 = *(const bf16x8*)(ksm + (r32 * KP + 16 * s + 8 * h) * 2);
        const bf16x8 a1 = *(const bf16x8*)(ksm + ((32 + r32) * KP + 16 * s + 8 * h) * 2);
        s0 = mfma(a0, qf[s], s0); s1 = mfma(a1, qf[s], s1);
    }
}
DEV void pv_tile(const char* vsm, int kofs, const f32x16& pt, int lane, f32x16& o0, f32x16& o1) {
    const int h = lane >> 5;
    const char* vb = vsm + ((lane >> 4) & 1) * 32 + (lane & 3) * 8 + (4 * h + ((lane & 15) >> 2) + kofs) * 64;
#pragma unroll
    for (int sp = 0; sp < 2; ++sp) {
        bf16x8 pb;
        { u32x4 t; t.x = cvt_pk(pt[8 * sp], pt[8 * sp + 1]); t.y = cvt_pk(pt[8 * sp + 2], pt[8 * sp + 3]); t.z = cvt_pk(pt[8 * sp + 4], pt[8 * sp + 5]); t.w = cvt_pk(pt[8 * sp + 6], pt[8 * sp + 7]); pb = __builtin_bit_cast(bf16x8, t); }
        const bf16x8 a0 = cat4(vtr(vb + (16 * sp) * 64), vtr(vb + (16 * sp + 8) * 64));
        const bf16x8 a1 = cat4(vtr(vb + 4096 + (16 * sp) * 64), vtr(vb + 4096 + (16 * sp + 8) * 64));
        o0 = mfma(a0, pb, o0); o1 = mfma(a1, pb, o1);
    }
}
DEV void flash_update(f32x16& s0, f32x16& s1, float& m, float& l, f32x16& o0, f32x16& o1, const char* vsm, int lane) {
    float mx = NEG_INF;
#pragma unroll
    for (int r = 0; r < 16; ++r) mx = fmaxf(mx, fmaxf(s0[r], s1[r]));
    mx = fmaxf(mx, __shfl_xor(mx, 32));
    const float mn = fmaxf(m, mx), mu = (mn == NEG_INF) ? 0.f : mn;
    const float alpha = fexp2(m - mu);
    m = mn;
    float ps = 0.f;
#pragma unroll
    for (int r = 0; r < 16; ++r) { s0[r] = fexp2(s0[r] - mu); s1[r] = fexp2(s1[r] - mu); ps += s0[r] + s1[r]; }
    l = fmaf(l, alpha, ps);
#pragma unroll
    for (int r = 0; r < 16; ++r) { o0[r] *= alpha; o1[r] *= alpha; }
    pv_tile(vsm, 0, s0, lane, o0, o1);
    pv_tile(vsm, 32, s1, lane, o0, o1);
}
DEV f32x16 qk32(const char* kbase, const bf16x8* qf, int r32, int h) {
    f32x16 s;
#pragma unroll
    for (int r = 0; r < 16; ++r) s[r] = 0.f;
#pragma unroll
    for (int k = 0; k < 4; ++k) { const bf16x8 a = *(const bf16x8*)(kbase + (r32 * KP + 16 * k + 8 * h) * 2); s = mfma(a, qf[k], s); }
    return s;
}
DEV void flash_update32(f32x16& s, float& m, float& l, f32x16& o0, f32x16& o1, const char* vsm, int kofs, int hstride, int lane) {
    float mx = NEG_INF;
#pragma unroll
    for (int r = 0; r < 16; ++r) mx = fmaxf(mx, s[r]);
    mx = fmaxf(mx, __shfl_xor(mx, 32));
    const float mn = fmaxf(m, mx), mu = (mn == NEG_INF) ? 0.f : mn;
    const float alpha = fexp2(m - mu);
    m = mn;
    float ps = 0.f;
#pragma unroll
    for (int r = 0; r < 16; ++r) { s[r] = fexp2(s[r] - mu); ps += s[r]; }
    l = fmaf(l, alpha, ps);
#pragma unroll
    for (int r = 0; r < 16; ++r) { o0[r] *= alpha; o1[r] *= alpha; }
    const int h = lane >> 5;
    const char* vb = vsm + ((lane >> 4) & 1) * 32 + (lane & 3) * 8 + (4 * h + ((lane & 15) >> 2) + kofs) * 64;
#pragma unroll
    for (int sp = 0; sp < 2; ++sp) {
        u32x4 t; t.x = cvt_pk(s[8 * sp], s[8 * sp + 1]); t.y = cvt_pk(s[8 * sp + 2], s[8 * sp + 3]); t.z = cvt_pk(s[8 * sp + 4], s[8 * sp + 5]); t.w = cvt_pk(s[8 * sp + 6], s[8 * sp + 7]);
        const bf16x8 pb = __builtin_bit_cast(bf16x8, t);
        const bf16x8 a0 = cat4(vtr(vb + (16 * sp) * 64), vtr(vb + (16 * sp + 8) * 64));
        const bf16x8 a1 = cat4(vtr(vb + hstride + (16 * sp) * 64), vtr(vb + hstride + (16 * sp + 8) * 64));
        o0 = mfma(a0, pb, o0); o1 = mfma(a1, pb, o1);
    }
}
DEV void qk_tile_c(const char* ksm, const bf16x8* qf, int r32, int h, const f32x16& c0, const f32x16& c1, f32x16& s0, f32x16& s1) {
    s0 = c0; s1 = c1;
#pragma unroll
    for (int s = 0; s < 4; ++s) {
        const bf16x8 a0 = *(const bf16x8*)(ksm + (r32 * KP + 16 * s + 8 * h) * 2);
        const bf16x8 a1 = *(const bf16x8*)(ksm + ((32 + r32) * KP + 16 * s + 8 * h) * 2);
        s0 = mfma(a0, qf[s], s0); s1 = mfma(a1, qf[s], s1);
    }
}
DEV float max3f(float a, float b, float c) { return fmaxf(fmaxf(a, b), c); }
struct FlashSt { float mref, l; bool unset; f32x16 o0, o1; };
DEV void flash_init(FlashSt& st) { st.mref = 0.f; st.l = 0.f; st.unset = true;
#pragma unroll
    for (int r = 0; r < 16; ++r) { st.o0[r] = 0.f; st.o1[r] = 0.f; } }
DEV bool flash_lazy(f32x16& s0, f32x16& s1, FlashSt& st, const char* vsm, int lane) {
    float mx = max3f(s0[0], s0[1], s1[0]);
#pragma unroll
    for (int r = 1; r < 16; r += 1) mx = (r & 1) ? max3f(mx, s0[r], s1[r]) : mx;
#pragma unroll
    for (int r = 2; r < 16; r += 2) mx = max3f(mx, s0[r], s1[r]);
    mx = fmaxf(mx, __shfl_xor(mx, 32));
    const bool fin = mx > NEG_INF;
    const bool need = fin && (st.unset || mx > 8.0f);
    bool moved = false;
    if (__any(need)) {
        const bool upd = fin && (st.unset || mx > 0.f);
        const float delta = upd ? mx : 0.f;
        const float alpha = st.unset ? 1.0f : fexp2(-delta);
        st.mref += delta; st.l *= alpha;
#pragma unroll
        for (int r = 0; r < 16; ++r) { st.o0[r] *= alpha; st.o1[r] *= alpha; s0[r] -= delta; s1[r] -= delta; }
        st.unset = st.unset && !fin;
        moved = true;
    }
    float ps = 0.f;
#pragma unroll
    for (int r = 0; r < 16; ++r) { s0[r] = fexp2(s0[r]); s1[r] = fexp2(s1[r]); ps += s0[r] + s1[r]; }
    st.l += ps;
    pv_tile(vsm, 0, s0, lane, st.o0, st.o1);
    pv_tile(vsm, 32, s1, lane, st.o0, st.o1);
    return moved;
}
DEV void fill16(f32x16& t, float v) {
#pragma unroll
    for (int r = 0; r < 16; ++r) t[r] = v; }
DEV void write_mix(const Params& p, size_t token, int mixcol0, const f32x16& o0, const f32x16& o1, int h) {
    const bf16_t* G = (const bf16_t*)(p.ws + WS_H) + token * HP + C_GATE + mixcol0;
    bf16_t* M = (bf16_t*)(p.ws + WS_MIX) + token * UP + mixcol0;
#pragma unroll
    for (int dt = 0; dt < 2; ++dt)
#pragma unroll
        for (int a = 0; a < 4; ++a) {
            const int d = 32 * dt + 8 * a + 4 * h;
            const u32x2 g = *(const u32x2*)(G + d);
            const f32x16& o = dt ? o1 : o0;
            u32x2 r; r.x = cvt_pk(o[4 * a] * bf_lo(g.x), o[4 * a + 1] * bf_hi(g.x)); r.y = cvt_pk(o[4 * a + 2] * bf_lo(g.y), o[4 * a + 3] * bf_hi(g.y));
            *(u32x2*)(M + d) = r;
        }
}

DEV void fox_unit(const Params& p, int b, int hh, int qb, char* smem) {
    char* ksm = smem; char* vsm = smem + KT_BYTES; float* cum = (float*)(smem + KT_BYTES + VT_BYTES);
    float* wtot = cum + 2048;
    int tid_ = threadIdx.x; OPAQUE_V(tid_); const int tid = tid_, lane = tid & 63, w = __builtin_amdgcn_readfirstlane(tid >> 6), r32 = lane & 31, h = lane >> 5;
    const int q0 = qb * 128, nneed = q0 + 128;
    const bf16_t* H = (const bf16_t*)(p.ws + WS_H) + (size_t)b * S * HP;
    {
        const float* lf = (const float*)(p.ws + WS_LOGF) + ((size_t)b * 6 + hh) * 2048;
        float v[8]; float s = 0.f;
        if (tid * 8 < nneed) { const f32x4 a = *(const f32x4*)(lf + tid * 8), c = *(const f32x4*)(lf + tid * 8 + 4);
            v[0] = a[0]; v[1] = a[1]; v[2] = a[2]; v[3] = a[3]; v[4] = c[0]; v[5] = c[1]; v[6] = c[2]; v[7] = c[3]; }
        else {
#pragma unroll
            for (int e = 0; e < 8; ++e) v[e] = 0.f; }
#pragma unroll
        for (int e = 0; e < 8; ++e) { s += v[e]; v[e] = s; }
        float inc = s;
#pragma unroll
        for (int o = 1; o < 64; o <<= 1) { const float t = __shfl_up(inc, o); if (lane >= o) inc += t; }
        if (lane == 63) wtot[w] = inc;
        __syncthreads();
        float base = inc - s;
        for (int k = 0; k < w; ++k) base += wtot[k];
        if (tid * 8 < nneed) {
#pragma unroll
            for (int e = 0; e < 8; ++e) cum[tid * 8 + e] = (base + v[e]) * LOG2E; }
        __syncthreads();
    }
    const int tq = q0 + 32 * w + r32;
    bf16x8 qf[4]; load_qf(H + (size_t)tq * HP + C_FOXQ + 64 * hh, h, qf);
    const float cb = cum[tq];
    FlashSt st; flash_init(st);
    const int ntiles = nneed / 64, mylast = (q0 + 32 * w + 31) >> 6, wt0 = q0 + 32 * w;
    KVRegs kvr; kv_load(kvr, H + (size_t)(ntiles - 1) * 64 * HP + C_FOXK + 64 * hh, H + (size_t)(ntiles - 1) * 64 * HP + C_FOXV + 64 * hh, HP, tid);
    for (int kt = ntiles - 1; kt >= 0; --kt) {
        __syncthreads();
        kv_store(kvr, ksm, vsm, tid);
        __syncthreads();
        if (kt > 0) kv_load(kvr, H + (size_t)(kt - 1) * 64 * HP + C_FOXK + 64 * hh, H + (size_t)(kt - 1) * 64 * HP + C_FOXV + 64 * hh, HP, tid);
        if (kt <= mylast) {
            const float cbm = cb - st.mref;
            f32x16 c0, c1;
#pragma unroll
            for (int a = 0; a < 4; ++a) {
                const f32x4 k0 = *(const f32x4*)(cum + kt * 64 + 8 * a + 4 * h), k1 = *(const f32x4*)(cum + kt * 64 + 32 + 8 * a + 4 * h);
#pragma unroll
                for (int k = 0; k < 4; ++k) { c0[4 * a + k] = cbm - k0[k]; c1[4 * a + k] = cbm - k1[k]; }
            }
            if (kt * 64 + 63 > wt0) {
                int lim = tq - 64 * kt - 4 * h; OPAQUE_V(lim);
#pragma unroll
                for (int r = 0; r < 16; ++r) { c0[r] = CR(r) <= lim ? c0[r] : NEG_INF; c1[r] = (CR(r) + 32) <= lim ? c1[r] : NEG_INF; }
            }
            f32x16 s0, s1; qk_tile_c(ksm, qf, r32, h, c0, c1, s0, s1);
            flash_lazy(s0, s1, st, vsm, lane);
        }
    }
    float l = st.l; l += __shfl_xor(l, 32);
    const float inv = 1.0f / l;
    f32x16 o0, o1;
#pragma unroll
    for (int r = 0; r < 16; ++r) { o0[r] = st.o0[r] * inv; o1[r] = st.o1[r] * inv; }
    write_mix(p, (size_t)b * S + tq, 256 + 64 * hh, o0, o1, h);
    __syncthreads();
}

constexpr int BMP = 65;
#ifndef DSA_PROBE_STG
#define DSA_PROBE_STG 0
#endif
#ifndef DSA_REP_IDX
#define DSA_REP_IDX 1
#endif
DEV unsigned ford(float f) { const unsigned u = __float_as_uint(f); return u ^ ((u >> 31) ? 0xffffffffu : 0x80000000u); }
constexpr int TK_NB = 256;
DEV unsigned funord(unsigned k) { return k ^ ((k >> 31) ? 0x80000000u : 0xffffffffu); }
template <int STG>
DEV void topk_row(const float* sc, int n, unsigned* bmrow, unsigned* hist  , int lane) {
    const int nch = (n + 63) >> 6;
    if (n <= 256) {
        if (lane < 32) { const int lo = 64 * lane; unsigned long long msk = 0ull;
            if (lo < n) { const int c = n - lo; msk = c >= 64 ? ~0ull : ((1ull << c) - 1ull); }
            bmrow[2 * lane] = (unsigned)msk; bmrow[2 * lane + 1] = (unsigned)(msk >> 32); }
        return;
    }
    const float PINF = __builtin_huge_valf();
    float v[32]; float vmax = NEG_INF, vmin = PINF;
#pragma unroll
    for (int i = 0; i < 32; ++i) {
        v[i] = NEG_INF;
        if (i < nch) { v[i] = sc[64 * i + lane]; vmax = fmaxf(vmax, v[i]);
            if (i < nch - 1) vmin = fminf(vmin, v[i]); else vmin = fminf(vmin, v[i] == NEG_INF ? PINF : v[i]); }
    }
#pragma unroll
    for (int o = 32; o >= 1; o >>= 1) { vmax = fmaxf(vmax, __shfl_xor(vmax, o)); vmin = fminf(vmin, __shfl_xor(vmin, o)); }
    if (STG <= 1) { if (lane == 0) bmrow[0] = __float_as_uint(vmax + vmin); return; }
    float Tf; bool tiecut = false; int need_eq = 0;
    if (!(vmax > vmin)) { Tf = vmax; tiecut = true; }
    else {
        const float scale = (float)(TK_NB - 1) / (vmax - vmin);
        int bn[32];
#pragma unroll
        for (int q = 0; q < TK_NB / 64; ++q) hist[64 * q + lane] = 0u;
        __builtin_amdgcn_wave_barrier();
#pragma unroll
        for (int i = 0; i < 32; ++i) { bn[i] = TK_NB - 1;
            if (i < nch) { int b = (int)((vmax - v[i]) * scale); b = b > TK_NB - 1 ? TK_NB - 1 : b; bn[i] = b; atomicAdd(&hist[b], 1u); } }
        __builtin_amdgcn_wave_barrier();
        if (STG <= 2) { if (lane == 0) bmrow[0] = hist[3] + bn[7]; return; }
        unsigned hb[4]; unsigned sl = 0u;
#pragma unroll
        for (int q = 0; q < 4; ++q) { hb[q] = hist[4 * lane + q]; sl += hb[q]; }
        unsigned pre = sl;
#pragma unroll
        for (int o = 1; o < 64; o <<= 1) { const unsigned t = __shfl_up(pre, o); if (lane >= o) pre += t; }
        const unsigned long long ge = __ballot(pre >= 256u);
        const int Ls = __ffsll((long long)ge) - 1;
        int bstar = 4 * lane; unsigned abv = pre - sl;
        { unsigned cum = pre - sl; bool found = false;
#pragma unroll
          for (int q = 0; q < 4; ++q) { if (!found && cum + hb[q] >= 256u) { bstar = 4 * lane + q; abv = cum; found = true; } cum += hb[q]; } }
        bstar = __shfl(bstar, Ls); abv = __shfl(abv, Ls);
        const int need = 256 - (int)abv;
        const unsigned cntb = hist[bstar];
        __builtin_amdgcn_wave_barrier();
        if (STG <= 3) { if (lane == 0) bmrow[0] = cntb + need; return; }
        unsigned T;
        if (cntb > (unsigned)TK_NB) {
            T = 0u;
            for (int bit = 31; bit >= 0; --bit) {
                const unsigned cand = T | (1u << bit); int cnt = 0;
#pragma unroll
                for (int i = 0; i < 32; ++i) if (i < nch) cnt += __popcll(__ballot(ford(v[i]) >= cand));
                if (cnt >= 256) T = cand;
            }
            tiecut = true;
        } else {
            int base = 0;
            const unsigned long long lt = (1ull << lane) - 1ull;
#pragma unroll
            for (int i = 0; i < 32; ++i) if (i < nch) {
                const bool isb = bn[i] == bstar;
                const unsigned long long bal = __ballot(isb);
                if (bal) { if (isb) hist[base + __popcll(bal & lt)] = ford(v[i]); base += __popcll(bal); }
            }
            __builtin_amdgcn_wave_barrier();
            unsigned c[TK_NB / 64];
#pragma unroll
            for (int q = 0; q < TK_NB / 64; ++q) c[q] = (64 * q + lane < (int)cntb) ? hist[64 * q + lane] : 0u;
            const int ncq = ((int)cntb + 63) >> 6;
            int cgt = 0, ceq = 0;
            if (cntb <= 64u) {
                const unsigned mine = c[0]; int gt = 0, ge = 0;
                for (int jq = 0; jq < (int)cntb; ++jq) { const unsigned cj = (unsigned)__builtin_amdgcn_readlane((int)mine, jq); gt += cj > mine ? 1 : 0; ge += cj >= mine ? 1 : 0; }
                const unsigned long long hit = __ballot(lane < (int)cntb && gt < need && need <= ge);
                const int src = __ffsll((long long)hit) - 1;
                T = (unsigned)__builtin_amdgcn_readlane((int)mine, src);
                cgt = __builtin_amdgcn_readlane(gt, src); ceq = __builtin_amdgcn_readlane(ge, src) - cgt;
            } else {
                T = 0u;
                for (int bit = 31; bit >= 0; --bit) {
                    const unsigned cand = T | (1u << bit); int cnt = 0;
#pragma unroll
                    for (int q = 0; q < TK_NB / 64; ++q) if (q < ncq) cnt += __popcll(__ballot(c[q] >= cand));
                    if (cnt >= need) T = cand;
                }
#pragma unroll
                for (int q = 0; q < TK_NB / 64; ++q) if (q < ncq) { cgt += __popcll(__ballot(c[q] > T)); ceq += __popcll(__ballot(c[q] == T)); }
            }
            need_eq = need - cgt;
            tiecut = ceq != need_eq;
            __builtin_amdgcn_wave_barrier();
        }
        Tf = __uint_as_float(funord(T));
    }
    if (STG <= 4) { if (lane == 0) bmrow[0] = __float_as_uint(Tf) + (tiecut ? 1 : 0); return; }
    if (!tiecut) {
#pragma unroll
        for (int i = 0; i < 32; ++i) if (i < nch) { const unsigned long long sm = __ballot(v[i] >= Tf);
            bmrow[2 * i] = (unsigned)sm; bmrow[2 * i + 1] = (unsigned)(sm >> 32); }
    } else {
        int ngt = 0;
#pragma unroll
        for (int i = 0; i < 32; ++i) if (i < nch) ngt += __popcll(__ballot(v[i] > Tf));
        const int need = 256 - ngt; int running = 0;
        const unsigned long long lt = (1ull << lane) - 1ull;
#pragma unroll
        for (int i = 0; i < 32; ++i) {
            unsigned long long sm = 0ull;
            if (i < nch) {
                const bool eq = v[i] == Tf; const unsigned long long bal = __ballot(eq);
                const int pre = running + __popcll(bal & lt);
                const bool sel = (v[i] > Tf) || (eq && pre < need);
                running += __popcll(bal);
                sm = __ballot(sel);
            }
            bmrow[2 * i] = (unsigned)sm; bmrow[2 * i + 1] = (unsigned)(sm >> 32);
        }
    }
}
DEV void dsa_index_unit(const Params& p, int b, int sb8, char* smem) {
    float* sc = (float*)smem;
    unsigned* hist = (unsigned*)(smem + 65536) + __builtin_amdgcn_readfirstlane(threadIdx.x >> 6) * TK_NB;
    int tid_ = threadIdx.x; OPAQUE_V(tid_); const int tid = tid_, lane = tid & 63, w = __builtin_amdgcn_readfirstlane(tid >> 6), r32 = lane & 31, h = lane >> 5;
    const bf16_t* H = (const bf16_t*)(p.ws + WS_H) + (size_t)b * S * HP;
    const float* IW = (const float*)(p.ws + WS_IW) + (size_t)b * S * 8;
    unsigned* BM = (unsigned*)(p.ws + WS_BM) + (size_t)b * S * 64;
    {
        const int ts = 8 * sb8, nkeys = ts + 8, nkt = ((nkeys + 63) >> 6) << 1;
        const int tl = 2 * ((r32 >> 2) & 1) + (r32 >> 4), head = ((r32 >> 3) & 1) * 4 + (r32 & 3);
        bf16x8 af[2][2]; f32x4 wv[2][4];
#pragma unroll
        for (int mt = 0; mt < 2; ++mt) {
#pragma unroll
            for (int ks = 0; ks < 2; ++ks) af[mt][ks] = *(const bf16x8*)(H + (size_t)(ts + 4 * mt + tl) * HP + C_IDXQ + 32 * head + 16 * ks + 8 * h);
#pragma unroll
            for (int a = 0; a < 4; ++a) wv[mt][a] = *(const f32x4*)(IW + (size_t)(ts + 4 * mt + 2 * h + (a >> 1)) * 8 + (a & 1) * 4);
        }
        bf16x8 bfn[2];
        if (w < nkt) {
#pragma unroll
            for (int ks = 0; ks < 2; ++ks) bfn[ks] = *(const bf16x8*)(H + (size_t)(32 * w + r32) * HP + C_IDXK + 16 * ks + 8 * h); }
        for (int kt = w; kt < nkt; kt += 4) {
            const int key = 32 * kt + r32;
            bf16x8 bf[2]; bf[0] = bfn[0]; bf[1] = bfn[1];
            if (kt + 4 < nkt) {
#pragma unroll
                for (int ks = 0; ks < 2; ++ks) bfn[ks] = *(const bf16x8*)(H + (size_t)(key + 128) * HP + C_IDXK + 16 * ks + 8 * h); }
#pragma unroll
            for (int mt = 0; mt < 2; ++mt) {
                f32x16 acc;
#pragma unroll
                for (int r = 0; r < 16; ++r) acc[r] = 0.f;
                acc = mfma(af[mt][0], bf[0], acc); acc = mfma(af[mt][1], bf[1], acc);
                float sA = 0.f, sB = 0.f;
#pragma unroll
                for (int a = 0; a < 2; ++a)
#pragma unroll
                    for (int k = 0; k < 4; ++k) { sA = fmaf(wv[mt][a][k], fmaxf(acc[4 * a + k], 0.f), sA); sB = fmaf(wv[mt][a + 2][k], fmaxf(acc[4 * (a + 2) + k], 0.f), sB); }
                const int rowA = 4 * mt + 2 * h, tokA = ts + rowA;
                sc[rowA * 2048 + key] = key <= tokA ? sA + 0.0f : NEG_INF;
                sc[(rowA + 1) * 2048 + key] = key <= tokA + 1 ? sB + 0.0f : NEG_INF;
            }
        }
        __syncthreads();
#pragma unroll 1
        for (int rr = 0; rr < 2; ++rr) { const int row = 2 * w + rr; topk_row<9>(sc + row * 2048, ts + row + 1, BM + (size_t)(ts + row) * 64, hist, lane); }
        __syncthreads();
    }
}
DEV void dsa_attn_unit(const Params& p, int b, int qb, char* smem) {
    char* ksm = smem; char* vsm = smem + KT_BYTES;
    unsigned* bm = (unsigned*)(smem + KT_BYTES + VT_BYTES);
    int tid_ = threadIdx.x; OPAQUE_V(tid_); const int tid = tid_, lane = tid & 63, w = __builtin_amdgcn_readfirstlane(tid >> 6), r32 = lane & 31, h = lane >> 5;
    const int t0 = qb * 32;
    const bf16_t* H = (const bf16_t*)(p.ws + WS_H) + (size_t)b * S * HP;
    {
        const unsigned* BM = (const unsigned*)(p.ws + WS_BM) + ((size_t)b * S + t0) * 64;
#pragma unroll
        for (int i = 0; i < 8; ++i) { const int e = tid + 256 * i; bm[(e >> 6) * BMP + (e & 63)] = BM[e]; }
    }
    const int tq = t0 + r32;
    bf16x8 qf[4]; load_qf(H + (size_t)tq * HP + C_DSAQ + 64 * w, h, qf);
    FlashSt st; flash_init(st);
    f32x16 negm; fill16(negm, 0.f);
    const int ntiles = ((t0 + 31) >> 6) + 1;
    KVRegs kvr; kv_load(kvr, H + C_DSAK, H + C_DSAV, HP, tid);
    for (int kt = 0; kt < ntiles; ++kt) {
        __syncthreads();
        kv_store(kvr, ksm, vsm, tid);
        __syncthreads();
        if (kt + 1 < ntiles) kv_load(kvr, H + (size_t)(kt + 1) * 64 * HP + C_DSAK, H + (size_t)(kt + 1) * 64 * HP + C_DSAV, HP, tid);
        f32x16 s0, s1; qk_tile_c(ksm, qf, r32, h, negm, negm, s0, s1);
        const unsigned w0 = bm[r32 * BMP + 2 * kt] >> (4 * h), w1 = bm[r32 * BMP + 2 * kt + 1] >> (4 * h);
#pragma unroll
        for (int r = 0; r < 16; ++r) { const int bit = (r & 3) + 8 * (r >> 2);
            s0[r] = ((w0 >> bit) & 1u) ? s0[r] : NEG_INF; s1[r] = ((w1 >> bit) & 1u) ? s1[r] : NEG_INF; }
        if (flash_lazy(s0, s1, st, vsm, lane)) fill16(negm, -st.mref);
    }
    float l = st.l; l += __shfl_xor(l, 32);
    const float inv = l > 0.f ? 1.0f / l : 0.f;
    f32x16 o0, o1;
#pragma unroll
    for (int r = 0; r < 16; ++r) { o0[r] = st.o0[r] * inv; o1[r] = st.o1[r] * inv; }
    write_mix(p, (size_t)b * S + tq, 64 * w, o0, o1, h);
    __syncthreads();
}

DEV void cmp_unit(const Params& p, int L, int kv, int b, int g, int cc, char* smem) {
    float* red = (float*)smem;
    float* hid = (float*)(smem + 32768);
    int tid_ = threadIdx.x; OPAQUE_V(tid_); const int tid = tid_, lane = tid & 63, w = __builtin_amdgcn_readfirstlane(tid >> 6), r32 = lane & 31, h = lane >> 5;
    const bf16_t* H = (const bf16_t*)(p.ws + WS_H) + (size_t)b * S * HP + (kv ? C_VC : C_KC) + 64 * g;
    const bf16_t* W1 = (const bf16_t*)(p.ws + WS_W1T) + (size_t)(L * 2 + kv) * 64 * W1P;
    const float* pe = p.cmp_pe + (size_t)(L * 2 + kv) * 32 * 64;
    int c = cc * 32 + r32; if (c > 126) c = 126;
    f32x16 acc[2];
#pragma unroll
    for (int r = 0; r < 16; ++r) { acc[0][r] = 0.f; acc[1][r] = 0.f; }
#pragma unroll 4
    for (int ks = w * 32; ks < w * 32 + 32; ++ks) {
        const int li = ks >> 2, d0 = (ks & 3) * 16 + 8 * h;
        const u32x4 raw = *(const u32x4*)(H + (size_t)(16 * c + li) * HP + d0);
        const f32x4 p0 = *(const f32x4*)(pe + li * 64 + d0), p1 = *(const f32x4*)(pe + li * 64 + d0 + 4);
        u32x4 t; t.x = cvt_pk(bf_lo(raw.x) + p0[0], bf_hi(raw.x) + p0[1]); t.y = cvt_pk(bf_lo(raw.y) + p0[2], bf_hi(raw.y) + p0[3]);
        t.z = cvt_pk(bf_lo(raw.z) + p1[0], bf_hi(raw.z) + p1[1]); t.w = cvt_pk(bf_lo(raw.w) + p1[2], bf_hi(raw.w) + p1[3]);
        const bf16x8 a = __builtin_bit_cast(bf16x8, t);
#pragma unroll
        for (int nt = 0; nt < 2; ++nt) { const bf16x8 bw = *(const bf16x8*)(W1 + (size_t)(32 * nt + r32) * W1P + 16 * ks + 8 * h); acc[nt] = mfma(a, bw, acc[nt]); }
    }
#pragma unroll
    for (int nt = 0; nt < 2; ++nt)
#pragma unroll
        for (int r = 0; r < 16; ++r) red[(w * 32 + crow(r, h)) * 64 + 32 * nt + r32] = acc[nt][r];
    __syncthreads();
#pragma unroll
    for (int i = 0; i < 8; ++i) { const int e = tid + 256 * i; const float v = red[e] + red[2048 + e] + red[4096 + e] + red[6144 + e]; hid[e] = v / (1.0f + __expf(-v)); }
    __syncthreads();
    {
        const int cl = tid >> 3, n2 = (tid & 7) * 8; const float* w2 = p.cmp_w2 + (size_t)(L * 2 + kv) * 64 * 64;
        float o[8];
#pragma unroll
        for (int e = 0; e < 8; ++e) o[e] = 0.f;
        for (int n = 0; n < 64; ++n) { const float hv = hid[cl * 64 + n]; const f32x4 wa = *(const f32x4*)(w2 + n * 64 + n2), wb = *(const f32x4*)(w2 + n * 64 + n2 + 4);
#pragma unroll
            for (int e = 0; e < 4; ++e) { o[e] = fmaf(hv, wa[e], o[e]); o[4 + e] = fmaf(hv, wb[e], o[4 + e]); } }
        const int cg_ = cc * 32 + cl;
        if (cg_ >= 127) {
#pragma unroll
            for (int e = 0; e < 8; ++e) o[e] = 0.f; }
        bf16_t* dst = (bf16_t*)(p.ws + (kv ? WS_VC : WS_KC)) + ((size_t)(b * 2 + g) * 128 + cg_) * 64 + n2;
        *(u32x4*)dst = pack8(o);
    }
    __syncthreads();
}

constexpr int KC_BYTES = 128 * KP * 2;
DEV void nsa_unit(const Params& p, int b, int g, int qb, int j, char* smem) {
    char* kcs = smem;
    char* vcs = smem + KC_BYTES;
    char* ksm = smem + KC_BYTES + 16384;
    char* vsm = ksm + KT_BYTES;
    float* scr = (float*)(vsm + VT_BYTES);
    unsigned* uni = (unsigned*)(scr + 4 * 32 * 33);
    int tid_ = threadIdx.x; OPAQUE_V(tid_); const int tid = tid_, lane = tid & 63, w = __builtin_amdgcn_readfirstlane(tid >> 6), r32 = lane & 31, h = lane >> 5;
    const int q0 = qb * 128, tq = q0 + 32 * w + r32;
    const bf16_t* H = (const bf16_t*)(p.ws + WS_H) + (size_t)b * S * HP;
    {
        const bf16_t* kc = (const bf16_t*)(p.ws + WS_KC) + (size_t)(b * 2 + g) * 128 * 64;
        const bf16_t* vc = (const bf16_t*)(p.ws + WS_VC) + (size_t)(b * 2 + g) * 128 * 64;
#pragma unroll
        for (int i = 0; i < 4; ++i) { const int c = tid + 256 * i, row = c >> 3, ch = c & 7;
            *(u32x4*)(kcs + (row * KP + ch * 8) * 2) = *(const u32x4*)(kc + row * 64 + ch * 8);
            *(u32x4*)(vcs + (ch >> 2) * 8192 + row * 64 + (ch & 3) * 16) = *(const u32x4*)(vc + row * 64 + ch * 8); }
    }
    __syncthreads();
    const int clim_ = tq >= 31 ? ((tq - 31) >> 4) : -1;
    const int climh = (clim_ > 126 ? 126 : clim_) - 4 * h;
    float B4[16], E[16];
#pragma unroll
    for (int i = 0; i < 16; ++i) { B4[i] = 0.f; E[i] = 0.f; }
#pragma unroll 1
    for (int jj = 0; jj < 3; ++jj) {
        bf16x8 qf[4]; load_qf(H + (size_t)tq * HP + C_NSAQ + 64 * (3 * g + jj), h, qf);
        float mrun = NEG_INF, lrun = 0.f;
#pragma unroll
        for (int n = 0; n < 4; ++n) {
            f32x16 st = qk32(kcs + n * 32 * KP * 2, qf, r32, h);
            float mx = NEG_INF;
            int lim = climh; OPAQUE_V(lim);
#pragma unroll
            for (int r = 0; r < 16; ++r) { st[r] = (32 * n + CR(r)) <= lim ? st[r] : NEG_INF; mx = fmaxf(mx, st[r]); }
            const float mn = fmaxf(mrun, mx), mu = mn == NEG_INF ? 0.f : mn;
            float ps = 0.f;
#pragma unroll
            for (int r = 0; r < 16; ++r) ps += fexp2(st[r] - mu);
            lrun = fmaf(lrun, fexp2(mrun - mu), ps); mrun = mn;
            __builtin_amdgcn_sched_barrier(0);
        }
        const float mo = __shfl_xor(mrun, 32), lo = __shfl_xor(lrun, 32);
        const float M = fmaxf(mrun, mo), Mu = M == NEG_INF ? 0.f : M;
        const float Lt = lrun * fexp2(mrun - Mu) + lo * fexp2(mo - Mu);
        const float inv = 1.0f / fmaxf(Lt, 1e-30f);
#pragma unroll
        for (int n = 0; n < 4; ++n) {
            f32x16 st = qk32(kcs + n * 32 * KP * 2, qf, r32, h);
            int lim = climh; OPAQUE_V(lim);
#pragma unroll
            for (int a = 0; a < 4; ++a) {
                float pr[4];
#pragma unroll
                for (int k = 0; k < 4; ++k) pr[k] = (32 * n + 8 * a + k) <= lim ? fexp2(st[4 * a + k] - Mu) * inv : 0.f;
                B4[4 * n + a] += (pr[0] + pr[1]) + (pr[2] + pr[3]); E[4 * n + a] += pr[3];
            }
            __builtin_amdgcn_sched_barrier(0);
        }
    }
    {
        float* my = scr + (w * 32 + r32) * 33;
#pragma unroll
        for (int i = 0; i < 16; ++i) { const float eo = __shfl_xor(E[i], 32); E[i] = eo; }
#pragma unroll
        for (int i = 0; i < 16; ++i) { const float prev = h ? E[i] : (i > 0 ? E[i - 1] : 0.f); my[2 * i + h] = B4[i] + prev; }
    }
    __builtin_amdgcn_wave_barrier();
    unsigned sel;
    {
        const float* my = scr + (w * 32 + r32) * 33; const int cur = tq >> 6;
        float v[32];
#pragma unroll
        for (int n = 0; n < 32; ++n) { float s_ = my[n]; const bool forced = (n == 0) || (n == cur) || (n == cur - 1); const bool fut = 64 * n > tq;
            v[n] = forced ? __builtin_huge_valf() : (fut ? NEG_INF : s_); }
        unsigned mk = 0u;
#pragma unroll
        for (int i = 0; i < 32; ++i) {
            int rank = 0;
#pragma unroll
            for (int n = 0; n < 32; ++n) { if (n < i) rank += (v[n] >= v[i]) ? 1 : 0; else if (n > i) rank += (v[n] > v[i]) ? 1 : 0; }
            if (rank < 16 && 64 * i <= tq) mk |= 1u << i;
        }
        sel = mk;
    }
    unsigned wsel = sel;
#pragma unroll
    for (int o = 16; o >= 1; o >>= 1) wsel |= __shfl_xor(wsel, o);
    if (lane == 0) uni[w] = wsel;
    __syncthreads();
    const unsigned bsel = uni[0] | uni[1] | uni[2] | uni[3];
    const float* gs = (const float*)(p.ws + WS_GSIG) + ((size_t)b * S + tq) * 20;
    const float g0 = gs[0 * 6 + g * 3 + j], g1 = gs[1 * 6 + g * 3 + j], g2 = gs[2 * 6 + g * 3 + j];
    f32x16 ot0, ot1;
    {
        bf16x8 qf[4]; load_qf(H + (size_t)tq * HP + C_NSAQ + 64 * (3 * g + j), h, qf);
        float m = NEG_INF, l = 0.f; f32x16 o0, o1;
#pragma unroll
        for (int r = 0; r < 16; ++r) { o0[r] = 0.f; o1[r] = 0.f; }
#pragma unroll 1
        for (int n = 0; n < 4; ++n) {
            f32x16 st = qk32(kcs + n * 32 * KP * 2, qf, r32, h);
            int lim = climh - 32 * n; OPAQUE_V(lim);
#pragma unroll
            for (int r = 0; r < 16; ++r) st[r] = CR(r) <= lim ? st[r] : NEG_INF;
            flash_update32(st, m, l, o0, o1, vcs, 32 * n, 8192, lane);
        }
        l += __shfl_xor(l, 32);
        const float sc_ = l > 0.f ? g0 / l : 0.f;
#pragma unroll
        for (int r = 0; r < 16; ++r) { ot0[r] = o0[r] * sc_; ot1[r] = o1[r] * sc_; }
    }
    bf16x8 qr[4]; load_qf((const bf16_t*)(p.ws + WS_QROT) + ((size_t)b * S + tq) * 384 + 64 * (3 * g + j), h, qr);
    {
        FlashSt st; flash_init(st);
        f32x16 negm; fill16(negm, 0.f);
        unsigned rem = bsel;
        KVRegs kvr; kv_load(kvr, H + C_KS + 64 * g, H + C_VS + 64 * g, HP, tid);
        const int wt0 = q0 + 32 * w;
        while (rem) {
            const int nb = __ffs(rem) - 1; rem &= rem - 1u;
            __syncthreads();
            kv_store(kvr, ksm, vsm, tid);
            __syncthreads();
            if (rem) { const int nx = __ffs(rem) - 1; kv_load(kvr, H + (size_t)nx * 64 * HP + C_KS + 64 * g, H + (size_t)nx * 64 * HP + C_VS + 64 * g, HP, tid); }
            if ((wsel >> nb) & 1u) {
                f32x16 s0, s1; qk_tile_c(ksm, qr, r32, h, negm, negm, s0, s1);
                int lim = ((sel >> nb) & 1u) ? tq - 64 * nb - 4 * h : -1; OPAQUE_V(lim);
#pragma unroll
                for (int r = 0; r < 16; ++r) { s0[r] = CR(r) <= lim ? s0[r] : NEG_INF; s1[r] = (CR(r) + 32) <= lim ? s1[r] : NEG_INF; }
                if (flash_lazy(s0, s1, st, vsm, lane)) fill16(negm, -st.mref);
            }
        }
        float l = st.l; l += __shfl_xor(l, 32);
        const float sc_ = l > 0.f ? g1 / l : 0.f;
#pragma unroll
        for (int r = 0; r < 16; ++r) { ot0[r] = fmaf(st.o0[r], sc_, ot0[r]); ot1[r] = fmaf(st.o1[r], sc_, ot1[r]); }
    }
    {
        FlashSt st; flash_init(st);
        f32x16 negm; fill16(negm, 0.f);
        const int kfirst = q0 >= 512 ? (q0 - 512) >> 6 : 0, klast = (q0 + 127) >> 6;
        const int wt0 = q0 + 32 * w;
        const int wfirst = wt0 >= 511 ? (wt0 - 511) >> 6 : 0, wlast = (wt0 + 31) >> 6;
        KVRegs kvr; kv_load(kvr, H + (size_t)kfirst * 64 * HP + C_KW + 64 * g, H + (size_t)kfirst * 64 * HP + C_VW + 64 * g, HP, tid);
        for (int kt = kfirst; kt <= klast; ++kt) {
            __syncthreads();
            kv_store(kvr, ksm, vsm, tid);
            __syncthreads();
            if (kt < klast) kv_load(kvr, H + (size_t)(kt + 1) * 64 * HP + C_KW + 64 * g, H + (size_t)(kt + 1) * 64 * HP + C_VW + 64 * g, HP, tid);
            if (kt >= wfirst && kt <= wlast) {
                f32x16 s0, s1; qk_tile_c(ksm, qr, r32, h, negm, negm, s0, s1);
                if (!(64 * kt + 63 <= wt0 && 64 * kt > wt0 + 31 - 512)) {
                    int lim = tq - 64 * kt - 4 * h; OPAQUE_V(lim);
#pragma unroll
                    for (int r = 0; r < 16; ++r) { s0[r] = (unsigned)(lim - CR(r)) < 512u ? s0[r] : NEG_INF; s1[r] = (unsigned)(lim - CR(r) - 32) < 512u ? s1[r] : NEG_INF; }
                }
                if (flash_lazy(s0, s1, st, vsm, lane)) fill16(negm, -st.mref);
            }
        }
        float l = st.l; l += __shfl_xor(l, 32);
        const float sc_ = l > 0.f ? g2 / l : 0.f;
#pragma unroll
        for (int r = 0; r < 16; ++r) { ot0[r] = fmaf(st.o0[r], sc_, ot0[r]); ot1[r] = fmaf(st.o1[r], sc_, ot1[r]); }
    }
    write_mix(p, (size_t)b * S + tq, 640 + 64 * (3 * g + j), ot0, ot1, h);
    __syncthreads();
}


#define XB_TMO      128
#define XB_XCNT(j)  (256  + 64 * (j))
#define XB_XSUB(j)  (1280 + 64 * (j))
#define XB_XGEN(j)  (2304 + 64 * (j))
#define XB_TOP      3328
#define XB_TOPGEN   3392
#define XCD_BAR_WORDS 3456
#define XB_SPIN_CAP (1u << 22)
DEV unsigned xb_ld(unsigned* p) { return __hip_atomic_load(p, __ATOMIC_RELAXED, __HIP_MEMORY_SCOPE_AGENT); }
DEV unsigned xb_add(unsigned* p, unsigned v) { return __hip_atomic_fetch_add(p, v, __ATOMIC_RELAXED, __HIP_MEMORY_SCOPE_AGENT); }
DEV unsigned xb_xcc_id() { return (unsigned)__builtin_amdgcn_s_getreg((3 << 11) | 20) & 0xFu; }
#define XB_SPIN(cond, bar) do { unsigned _sp = 0; while (cond) { __builtin_amdgcn_s_sleep(1); \
    if ((++_sp & 255u) == 0u) { if (xb_ld(&(bar)[XB_TMO])) break; if (_sp > XB_SPIN_CAP) { atomicAdd(&(bar)[XB_TMO], 1u); break; } } } } while (0)
struct XcdBarrier { unsigned* bar; unsigned x; volatile LDSAS unsigned* st; };
DEV XcdBarrier xcd_barrier_post(unsigned* bar, volatile LDSAS unsigned* st) {
    XcdBarrier b; b.bar = bar; b.x = xb_xcc_id(); b.st = st;
    if (threadIdx.x == 0) (void)xb_add(&bar[XB_XCNT(b.x)], 1u);
    return b;
}
DEV void xcd_barrier_complete(unsigned* bar, unsigned x, unsigned& nloc, unsigned& nx) {
    const unsigned G = gridDim.x * gridDim.y * gridDim.z;
    unsigned sum, cnt, mine, sp = 0u;
    for (;;) {
        sum = 0u; cnt = 0u; mine = 0u;
#pragma unroll
        for (unsigned j = 0; j < 16; ++j) { const unsigned c = xb_ld(&bar[XB_XCNT(j)]); sum += c; cnt += (c > 0u) ? 1u : 0u; mine = (j == x) ? c : mine; }
        if (sum == G) break;
        __builtin_amdgcn_s_sleep(1);
        if ((++sp & 255u) == 0u) { if (xb_ld(&bar[XB_TMO])) break; if (sp > XB_SPIN_CAP) { atomicAdd(&bar[XB_TMO], 1u); break; } }
    }
    nloc = mine > 0u ? mine : 1u; nx = cnt > 0u ? cnt : 1u;
}
DEV void xcd_barrier(const XcdBarrier& b) {
    asm volatile("s_waitcnt vmcnt(0)" ::: "memory");
    __syncthreads();
    if (threadIdx.x == 0) {
        unsigned* bar = b.bar;
        __builtin_amdgcn_s_waitcnt(0);
        unsigned nloc = b.st[0], nx = b.st[1];
        if (nloc == 0u) { xcd_barrier_complete(bar, b.x, nloc, nx); b.st[0] = nloc; b.st[1] = nx; }
        const unsigned old = xb_add(&bar[XB_XSUB(b.x)], 1u);
        const unsigned gen = old / nloc;
        if (old + 1u == (gen + 1u) * nloc) {
            __builtin_amdgcn_fence(__ATOMIC_RELEASE, "agent");
            asm volatile("s_waitcnt vmcnt(0)" ::: "memory");
            const unsigned og = xb_add(&bar[XB_TOP], 1u);
            const unsigned tg = og / nx;
            if (og + 1u == (tg + 1u) * nx) xb_add(&bar[XB_TOPGEN], 1u);
            else XB_SPIN(xb_ld(&bar[XB_TOPGEN]) == tg, bar);
            __builtin_amdgcn_fence(__ATOMIC_ACQUIRE, "agent");
            xb_add(&bar[XB_XGEN(b.x)], 1u);
            asm volatile("s_waitcnt vmcnt(0)" ::: "memory");
        } else {
            XB_SPIN(xb_ld(&bar[XB_XGEN(b.x)]) == gen, bar);
            __builtin_amdgcn_fence(__ATOMIC_ACQUIRE, "agent");
            asm volatile("s_waitcnt vmcnt(0)" ::: "memory");
        }
    }
    __syncthreads();
}
DEV int grab_unit(unsigned* ctr, char* smem) {
    volatile LDSAS unsigned* st = (volatile LDSAS unsigned*)(smem + SMEM_BYTES - 16);
    __syncthreads();
    if (threadIdx.x == 0) st[2] = __hip_atomic_fetch_add(ctr, 1u, __ATOMIC_RELAXED, __HIP_MEMORY_SCOPE_AGENT);
    __syncthreads();
    return (int)st[2];
}
DEV void phase_mid(const Params& p, int L, char* smem, unsigned* ctr, int tmask = 7) {
    constexpr int N_CMP = 128, N_FOX = 768, N_IDX = 2048;
    for (;;) {
        const int u = grab_unit(ctr, smem);
        if (u >= N_CMP + N_FOX + N_IDX) break;
        int v = u;
        if (v < N_CMP) { const int kv = v & 1, g = (v >> 1) & 1, cc = (v >> 2) & 3, b = v >> 4; if (tmask & 4) cmp_unit(p, L, kv, b, g, cc, smem); continue; }
        v -= N_CMP;
        if (v < N_FOX) { const int qb = 15 - v / 48, r = v % 48; if (tmask & 2) fox_unit(p, r / 6, r % 6, qb, smem); continue; }
        v -= N_FOX;
        { const int sb8 = 255 - (v >> 3), b = v & 7; if (tmask & 1) dsa_index_unit(p, b, sb8, smem); }
    }
}
DEV void phase_nsa(const Params& p, char* smem, unsigned* ctr) {
    for (;;) {
        const int u = grab_unit(ctr, smem);
        if (u >= 768 + 512) break;
        const int sI = 15 - u / 80, r = u % 80;
        if (r < 48) { const int b = r / 6, g = (r % 6) / 3, j = r % 3; nsa_unit(p, b, g, sI, j, smem); }
        else { const int r2 = r - 48, qb = 4 * sI + 3 - (r2 >> 3), b = r2 & 7; dsa_attn_unit(p, b, qb, smem); }
    }
}
#ifndef PHASE_MASK
#define PHASE_MASK 0xffff
#endif
DEV void run_phase(const Params& p, int ph, char* smem, int rep = 0) {
    unsigned* ctr = (unsigned*)(p.ws + WS_CTRL) + 3584 + 16 * (ph + 12 * rep);
    if (ph == 0) { if (PHASE_MASK & 1) phase_prep(p, smem); return; }
    if (ph == 1) { if (PHASE_MASK & 2) phase_u1(p, smem); return; }
    const int L = (ph - 2) / 5, k = (ph - 2) % 5;
    if (k == 0) { if (PHASE_MASK & 4) phase_gemm_in(p, L, smem); }
    else if (k == 1) { if (PHASE_MASK & 8) phase_mid(p, L, smem, ctr); }
    else if (k == 2) { if (PHASE_MASK & 16) phase_nsa(p, smem, ctr); }
    else if (k == 3) { if (PHASE_MASK & 32) phase_out(p, L, smem); }
    else { if (PHASE_MASK & 64) phase_ln(p, L); }
}
constexpr int N_PHASES = 12;

#ifndef REPEAT_KIND
#define REPEAT_KIND -1
#endif
DEV int phase_kind(int ph) { return ph < 2 ? ph : 2 + (ph - 2) % 5; }
template <bool COOP>
__global__ void __launch_bounds__(256, 2) mega(Params p, int ph_lo, int ph_hi) {
    extern __shared__ __attribute__((aligned(16))) char smem[];
    volatile LDSAS unsigned* st = (volatile LDSAS unsigned*)(smem + SMEM_BYTES - 16);
    XcdBarrier xb;
    if (COOP) {
        if (threadIdx.x == 0) { st[0] = 0u; st[1] = 0u; }
        __syncthreads();
        xb = xcd_barrier_post((unsigned*)(p.ws + WS_CTRL), st);
    }
    for (int ph = ph_lo; ph < ph_hi; ++ph) {
        run_phase(p, ph, smem);
        if (COOP) {
            if (REPEAT_KIND >= 0 && REPEAT_KIND < 7 && phase_kind(ph) == REPEAT_KIND) { xcd_barrier(xb); run_phase(p, ph, smem, 1); }
            if (REPEAT_KIND >= 7 && REPEAT_KIND <= 9 && phase_kind(ph) == 3) { xcd_barrier(xb); phase_mid(p, (ph - 2) / 5, smem, (unsigned*)(p.ws + WS_CTRL) + 3584 + 16 * (ph + 12), 1 << (REPEAT_KIND - 7)); }
            if (ph + 1 < ph_hi) xcd_barrier(xb);
        }
    }
}

#ifndef N_LAUNCH_MODE
#define N_LAUNCH_MODE 1
#endif

extern "C" void kernel_launch(void* const* d_in, const int* in_sizes, int n_in, void* d_out, int out_size, void* d_ws, size_t ws_size, hipStream_t stream) {
    static int grid = 0;
    if (grid == 0) {
        int dev = 0, cus = 0, per_cu = 0;
        hipGetDevice(&dev);
        hipDeviceGetAttribute(&cus, hipDeviceAttributeMultiprocessorCount, dev);
        hipFuncSetAttribute((const void*)mega<true>, hipFuncAttributeMaxDynamicSharedMemorySize, SMEM_BYTES);
        hipFuncSetAttribute((const void*)mega<false>, hipFuncAttributeMaxDynamicSharedMemorySize, SMEM_BYTES);
        hipOccupancyMaxActiveBlocksPerMultiprocessor(&per_cu, (const void*)mega<true>, 256, SMEM_BYTES);
        if (per_cu < 1) per_cu = 1;
        if (per_cu > 2) per_cu = 2;
        grid = cus * per_cu;
        if (ws_size < WS_END) { fprintf(stderr, "workspace too small: %zu < %zu\n", ws_size, (size_t)WS_END); grid = -1; }
    }
    if (grid < 0) return;
    Params p{};
    p.x = (const float*)d_in[0]; p.c = (const float*)d_in[1]; p.w_ada = (const float*)d_in[2]; p.b_ada = (const float*)d_in[3];
    p.w_in = (const float*)d_in[4]; p.b_f = (const float*)d_in[5]; p.cmp_pe = (const float*)d_in[6]; p.cmp_w1 = (const float*)d_in[7];
    p.cmp_w2 = (const float*)d_in[8]; p.w_out = (const float*)d_in[9]; p.ln_g = (const float*)d_in[10]; p.ln_b = (const float*)d_in[11];
    p.out = (float*)d_out; p.ws = (char*)d_ws;
    (void)hipMemsetAsync((char*)d_ws + WS_CTRL, 0, 16384, stream);
#if N_LAUNCH_MODE == 1
    hipLaunchKernelGGL(mega<true>, dim3(grid), dim3(256), SMEM_BYTES, stream, p, 0, N_PHASES);
#else
    for (int ph = 0; ph < N_PHASES; ++ph) hipLaunchKernelGGL(mega<false>, dim3(grid), dim3(256), SMEM_BYTES, stream, p, ph, ph + 1);
#endif
}
```
